# Optimizing an MI355X kernel written in HIP

```python
import math
import numpy as np
import jax, jax.numpy as jnp
from jax import lax

D_MODEL = 1024
BATCH = 4
SEQ = 8192
DEPTH = 1
DEC_BATCH = 32
DEC_SEQ = 8
PAST_LEN = 16384
PAGE_SIZE = 128

NSA_HEADS = 8
NSA_KV_HEADS = 2
NSA_GROUP = NSA_HEADS // NSA_KV_HEADS
HEAD_DIM = 64
NSA_WIDTH = NSA_HEADS * HEAD_DIM
CMP_STRIDE = 16
CMP_LEN = 2 * CMP_STRIDE
CMP_HID = 128
SEL_BLOCK = 64
SEL_TOPN = 16
WINDOW = 512
QBLOCK = 128
M_HEADS = 4
M_HEAD_DIM = 128
M_WIDTH = M_HEADS * M_HEAD_DIM
CONV_W = 4
M_CHUNK = 64
MIX_WIDTH = NSA_WIDTH + M_WIDTH
REL_BUCKETS = 32
REL_MAX_DIST = 1024
D_FF = ((-(-(8 * D_MODEL) // 3)) + 255) // 256 * 256
PROJ_SIZES = (NSA_WIDTH, 4 * NSA_KV_HEADS * HEAD_DIM, 2 * NSA_KV_HEADS * HEAD_DIM, 3 * NSA_HEADS,
              2 * M_WIDTH, M_WIDTH, 2 * M_HEADS, M_WIDTH)
PROJ_DIM = sum(PROJ_SIZES)
SPLIT_POINTS = tuple(int(s) for s in np.cumsum(PROJ_SIZES)[:-1])
F_GATE_OFF = sum(PROJ_SIZES[:6]) + M_HEADS
NEG = -1e30
BIG = 1e9

kernel_name = 'nsa_mlstm_parallel_heads_step'


def rmsnorm(x, g, eps=1e-6):
    xf = x.astype(jnp.float32)
    y = xf * lax.rsqrt(jnp.mean(xf * xf, axis=-1, keepdims=True) + eps)
    return (y * g.astype(jnp.float32)).astype(x.dtype)


def rel_bucket(dist):
    n = jnp.maximum(dist, 0)
    max_exact = REL_BUCKETS // 2
    nf = jnp.maximum(n, 1).astype(jnp.float32)
    large = max_exact + (jnp.log(nf / max_exact) / math.log(REL_MAX_DIST / max_exact)
                         * (REL_BUCKETS - max_exact)).astype(jnp.int32)
    large = jnp.minimum(large, REL_BUCKETS - 1)
    return jnp.where(n < max_exact, n, large)


def head_bias(rel_bias, dist):
    b = rel_bias.astype(jnp.float32)[rel_bucket(dist)]
    return jnp.moveaxis(b, -1, 0).reshape(NSA_KV_HEADS, NSA_GROUP, dist.shape[0], dist.shape[1])


def overlap_matrix(nc, nsb):
    i = np.arange(nc)[:, None] * CMP_STRIDE
    j = np.arange(nsb)[None, :] * SEL_BLOCK
    return ((i < j + SEL_BLOCK) & (i + CMP_LEN > j)).astype(np.float32)


def compress(k, pos, w1, b1, w2, b2):
    B, L = k.shape[0], k.shape[1]
    nch = L // CMP_STRIDE
    kc = k[:, :nch * CMP_STRIDE].reshape(B, nch, CMP_STRIDE, NSA_KV_HEADS, HEAD_DIM)
    w1r = w1.reshape(CMP_LEN, HEAD_DIM, CMP_HID)
    a_lo = jnp.einsum('bcjhd,jde->bche', kc + pos[None, None, :CMP_STRIDE, None, :], w1r[:CMP_STRIDE])
    a_hi = jnp.einsum('bcjhd,jde->bche', kc + pos[None, None, CMP_STRIDE:, None, :], w1r[CMP_STRIDE:])
    hid = jax.nn.gelu(a_lo[:, :-1] + a_hi[:, 1:] + b1)
    return hid @ w2 + b2


def nsa_attend(q, gates, k_cmp, v_cmp, ks_blk, vs_blk, k_win, v_win, win_p0, pos0, rel_bias):
    B, T = q.shape[0], q.shape[1]
    qb = QBLOCK if T % QBLOCK == 0 else T
    nqb = T // qb
    nc = k_cmp.shape[1]
    nsb = ks_blk.shape[2]
    n_sel = min(SEL_TOPN, nsb)
    kw_len = qb + WINDOW - 1
    cmp_end = jnp.arange(nc, dtype=jnp.int32) * CMP_STRIDE + (CMP_LEN - 1)
    blk_ids = jnp.arange(nsb, dtype=jnp.int32)
    overlap = jnp.asarray(overlap_matrix(nc, nsb))
    tab = rel_bias.astype(jnp.float32).reshape(REL_BUCKETS, NSA_KV_HEADS, NSA_GROUP).transpose(1, 0, 2)
    b_ix = jnp.arange(B)[:, None, None, None]
    h_ix = jnp.arange(NSA_KV_HEADS)[None, :, None, None]
    h_ix5 = jnp.arange(NSA_KV_HEADS)[None, :, None, None, None]
    scale = HEAD_DIM ** -0.5
    q_blocks = q.reshape(B, nqb, qb, NSA_KV_HEADS, NSA_GROUP, HEAD_DIM).swapaxes(0, 1)
    g_blocks = gates.reshape(B, nqb, qb, NSA_KV_HEADS, NSA_GROUP, 3).swapaxes(0, 1)

    def one_block(args):
        qi, gi, i = args
        q0 = pos0 + i * qb
        t = q0 + jnp.arange(qb, dtype=jnp.int32)
        qs = qi * scale
        d_c = t[:, None] - cmp_end[None, :]
        valid_c = d_c >= 0
        s_c = jnp.einsum('bqhgd,bchd->bhgqc', qs, k_cmp, preferred_element_type=jnp.float32) + head_bias(rel_bias, d_c)
        p_c = jnp.where(valid_c, jax.nn.softmax(jnp.where(valid_c, s_c, NEG), axis=-1), 0.0)
        o_c = jnp.einsum('bhgqc,bchd->bqhgd', p_c.astype(v_cmp.dtype), v_cmp)
        imp = jnp.einsum('bhgqc,cj->bhqj', p_c, overlap)
        forced = (blk_ids[None, :] == t[:, None] // SEL_BLOCK) | (blk_ids[None, :] == 0)
        causal_b = blk_ids[None, :] * SEL_BLOCK <= t[:, None]
        score = jnp.where(forced, BIG, jnp.where(causal_b, imp, -BIG))
        _, idx = lax.top_k(score, n_sel)
        k_sel = ks_blk[b_ix, h_ix, idx]
        v_sel = vs_blk[b_ix, h_ix, idx]
        k_pos = idx[..., None] * SEL_BLOCK + jnp.arange(SEL_BLOCK, dtype=jnp.int32)
        d_s = t[None, None, :, None, None] - k_pos
        bias_s = jnp.moveaxis(tab[h_ix5, rel_bucket(d_s)], -1, 2)
        s_s = jnp.einsum('bqhgd,bhqnsd->bhgqns', qs, k_sel, preferred_element_type=jnp.float32) + bias_s
        s_s = jnp.where((d_s >= 0)[:, :, None], s_s, NEG).reshape(B, NSA_KV_HEADS, NSA_GROUP, qb, n_sel * SEL_BLOCK)
        p_s = jax.nn.softmax(s_s, axis=-1)
        o_s = jnp.einsum('bhgqk,bhqkd->bqhgd', p_s.astype(v_sel.dtype),
                         v_sel.reshape(B, NSA_KV_HEADS, qb, n_sel * SEL_BLOCK, HEAD_DIM))
        k0 = q0 - WINDOW + 1
        kwb = lax.dynamic_slice_in_dim(k_win, k0 - win_p0, kw_len, axis=1)
        vwb = lax.dynamic_slice_in_dim(v_win, k0 - win_p0, kw_len, axis=1)
        kp = k0 + jnp.arange(kw_len, dtype=jnp.int32)
        d_w = t[:, None] - kp[None, :]
        valid_w = (d_w >= 0) & (d_w < WINDOW) & (kp[None, :] >= 0)
        s_w = jnp.einsum('bqhgd,bkhd->bhgqk', qs, kwb, preferred_element_type=jnp.float32) + head_bias(rel_bias, d_w)
        p_w = jax.nn.softmax(jnp.where(valid_w, s_w, NEG), axis=-1)
        o_w = jnp.einsum('bhgqk,bkhd->bqhgd', p_w.astype(vwb.dtype), vwb)
        o = gi[..., 0:1] * o_c + gi[..., 1:2] * o_s + gi[..., 2:3] * o_w
        return o.reshape(B, qb, NSA_WIDTH).astype(q.dtype)

    out = lax.map(one_block, (q_blocks, g_blocks, jnp.arange(nqb, dtype=jnp.int32)))
    return out.swapaxes(0, 1).reshape(B, T, NSA_WIDTH)


def mlstm_chunkwise(q, k, v, ig, logf, C0, n0, m0):
    B, T, NH, DK = q.shape
    cl = M_CHUNK if T % M_CHUNK == 0 else T
    nck = T // cl
    f32 = jnp.float32

    def to_chunks(a):
        return a.astype(f32).reshape((B, nck, cl) + a.shape[2:]).swapaxes(0, 1)

    tri = jnp.tril(jnp.ones((cl, cl), dtype=bool))

    def step(carry, inp):
        C, n, m = carry
        qc, kc, vc, ic, fc = inp
        b = jnp.cumsum(fc, axis=1)
        dlog = b[:, :, None, :] - b[:, None, :, :] + ic[:, None, :, :]
        dlog = jnp.where(tri[None, :, :, None], dlog, -jnp.inf)
        a = b + m[:, None, :]
        mt = jnp.maximum(a, jnp.max(dlog, axis=2))
        w = jnp.exp(dlog - mt[:, :, None, :])
        s = jnp.einsum('bthd,bshd->btsh', qc, kc) * w
        inter = jnp.exp(a - mt)
        num = jnp.einsum('btsh,bshv->bthv', s, vc) + inter[..., None] * jnp.einsum('bthd,bhdv->bthv', qc, C)
        den = jnp.sum(s, axis=2) + inter * jnp.einsum('bthd,bhd->bth', qc, n)
        h = num / jnp.maximum(jnp.abs(den), jnp.exp(-mt))[..., None]
        m_new = mt[:, -1]
        decay = jnp.exp(b[:, -1] + m - m_new)
        wk = jnp.exp(b[:, -1:, :] - b + ic - m_new[:, None, :])
        C_new = decay[..., None, None] * C + jnp.einsum('bsh,bshd,bshv->bhdv', wk, kc, vc)
        n_new = decay[..., None] * n + jnp.einsum('bsh,bshd->bhd', wk, kc)
        return (C_new, n_new, m_new), h

    (C, n, m), hs = lax.scan(step, (C0.astype(f32), n0.astype(f32), m0.astype(f32)),
                             (to_chunks(q), to_chunks(k), to_chunks(v), to_chunks(ig), to_chunks(logf)))
    h = hs.swapaxes(0, 1).reshape(B, T, NH, v.shape[-1])
    return h, C, n, m


def layer(x, pos0, past_kv, past_win, conv0, C0, n0, m0, rel_bias,
          g_attn_pre, w_in, b_in, cmp_pos, cmp_w1, cmp_b1, cmp_w2, cmp_b2,
          conv_w, conv_b, g_mnorm, w_out, g_attn_post, g_ffn_pre, w_gate, w_up, w_down, g_ffn_post):
    B, T, _ = x.shape
    h = rmsnorm(x, g_attn_pre)
    proj = h @ w_in + b_in
    q_n, kv_p, kv_w, gate_n, m_qk, m_v, m_if, m_o = jnp.split(proj, SPLIT_POINTS, axis=-1)
    q_n = q_n.reshape(B, T, NSA_HEADS, HEAD_DIM)
    kv_p = kv_p.reshape(B, T, 4, NSA_KV_HEADS, HEAD_DIM)
    kv_w = kv_w.reshape(B, T, 2, NSA_KV_HEADS, HEAD_DIM)
    gates = jax.nn.sigmoid(gate_n).reshape(B, T, NSA_KV_HEADS, NSA_GROUP, 3)
    kv_all = kv_p if past_kv is None else jnp.concatenate([past_kv.astype(x.dtype), kv_p], axis=1)
    L = kv_all.shape[1]
    k_cmp = compress(kv_all[:, :, 0], cmp_pos[0], cmp_w1[0], cmp_b1[0], cmp_w2[0], cmp_b2[0])
    v_cmp = compress(kv_all[:, :, 1], cmp_pos[1], cmp_w1[1], cmp_b1[1], cmp_w2[1], cmp_b2[1])
    nsb = -(-L // SEL_BLOCK)

    def to_blocks(a):
        a = jnp.pad(a, ((0, 0), (0, nsb * SEL_BLOCK - L), (0, 0), (0, 0)))
        return a.reshape(B, nsb, SEL_BLOCK, NSA_KV_HEADS, HEAD_DIM).transpose(0, 3, 1, 2, 4)

    ks_blk = to_blocks(kv_all[:, :, 2])
    vs_blk = to_blocks(kv_all[:, :, 3])
    parts = [jnp.zeros((B, WINDOW, 2, NSA_KV_HEADS, HEAD_DIM), x.dtype)]
    if past_win is not None:
        parts.append(past_win.astype(x.dtype))
    parts.append(kv_w)
    kv_win_all = jnp.concatenate(parts, axis=1)
    win_p0 = pos0 + T - kv_win_all.shape[1]
    buf_len = min(WINDOW, T) if past_win is None else past_win.shape[1]
    new_win = kv_win_all[:, -buf_len:]
    o_nsa = nsa_attend(q_n, gates, k_cmp, v_cmp, ks_blk, vs_blk, kv_win_all[:, :, 0], kv_win_all[:, :, 1],
                       win_p0, pos0, rel_bias)
    xp = jnp.concatenate([conv0.astype(x.dtype), m_qk], axis=1)
    acc = conv_b
    for j in range(CONV_W):
        acc = acc + xp[:, j:j + T] * conv_w[j]
    qk = jax.nn.silu(acc)
    new_conv = xp[:, T:]
    q_m, k_m = jnp.split(qk, 2, axis=-1)
    q_m = q_m.reshape(B, T, M_HEADS, M_HEAD_DIM)
    k_m = k_m.reshape(B, T, M_HEADS, M_HEAD_DIM) * (M_HEAD_DIM ** -0.5)
    v_m = m_v.reshape(B, T, M_HEADS, M_HEAD_DIM)
    ig = m_if[..., :M_HEADS]
    logf = jax.nn.log_sigmoid(m_if[..., M_HEADS:])
    h_t, C, n, m = mlstm_chunkwise(q_m, k_m, v_m, ig, logf, C0, n0, m0)
    hm = jax.nn.sigmoid(m_o).reshape(B, T, M_HEADS, M_HEAD_DIM) * h_t.astype(x.dtype)
    hm = rmsnorm(hm, g_mnorm.reshape(M_HEADS, M_HEAD_DIM)).reshape(B, T, M_WIDTH)
    mix = jnp.concatenate([o_nsa, hm], axis=-1) @ w_out
    x1 = x + rmsnorm(mix, g_attn_post)
    h2 = rmsnorm(x1, g_ffn_pre)
    f = (jax.nn.silu(h2 @ w_gate) * (h2 @ w_up)) @ w_down
    y = x1 + rmsnorm(f, g_ffn_post)
    return y, kv_p, new_win, new_conv, C.astype(x.dtype), n.astype(x.dtype), m.astype(x.dtype)


def setup_inputs(seed: int = 0) -> dict:
    key = jax.random.key(seed)
    ks = jax.random.split(key, 32)
    n_pages = PAST_LEN // PAGE_SIZE
    n_pool = (DEC_BATCH * n_pages * 5 + 3) // 4
    w_buf = min(WINDOW, PAST_LEN)

    def nrm(k, shape, s=1.0):
        return s * jax.random.normal(k, shape, jnp.float32)

    def gain(k, n):
        return 1.0 + nrm(k, (DEPTH, n), 0.05)

    x_prompt = nrm(ks[0], (BATCH, SEQ, D_MODEL))
    x_sample = nrm(ks[1], (DEC_BATCH, DEC_SEQ, D_MODEL))
    cache_kv = nrm(ks[2], (DEPTH, n_pool, PAGE_SIZE, 4, NSA_KV_HEADS, HEAD_DIM))
    cache_win = nrm(ks[3], (DEPTH, DEC_BATCH, w_buf, 2, NSA_KV_HEADS, HEAD_DIM))
    state_conv = nrm(ks[4], (DEPTH, DEC_BATCH, CONV_W - 1, 2 * M_WIDTH))
    state_C = nrm(ks[5], (DEPTH, DEC_BATCH, M_HEADS, M_HEAD_DIM, M_HEAD_DIM), 0.2)
    state_n = nrm(ks[6], (DEPTH, DEC_BATCH, M_HEADS, M_HEAD_DIM), 0.2)
    state_m = nrm(ks[7], (DEPTH, DEC_BATCH, M_HEADS))
    page_table = jax.random.permutation(ks[8], n_pool)[:DEC_BATCH * n_pages].reshape(DEC_BATCH, n_pages).astype(jnp.int32)
    rel_bias = nrm(ks[9], (REL_BUCKETS, NSA_HEADS), 0.5)
    g_attn_pre = gain(ks[10], D_MODEL)
    w_in = nrm(ks[11], (DEPTH, D_MODEL, PROJ_DIM), D_MODEL ** -0.5)
    b_in = nrm(ks[12], (DEPTH, PROJ_DIM), 0.01).at[:, F_GATE_OFF:F_GATE_OFF + M_HEADS].add(3.0)
    cmp_pos = nrm(ks[13], (DEPTH, 2, CMP_LEN, HEAD_DIM), 0.2)
    cmp_w1 = nrm(ks[14], (DEPTH, 2, CMP_LEN * HEAD_DIM, CMP_HID), (CMP_LEN * HEAD_DIM) ** -0.5)
    cmp_b1 = nrm(ks[15], (DEPTH, 2, CMP_HID), 0.01)
    cmp_w2 = nrm(ks[16], (DEPTH, 2, CMP_HID, HEAD_DIM), CMP_HID ** -0.5)
    cmp_b2 = nrm(ks[17], (DEPTH, 2, HEAD_DIM), 0.01)
    conv_w = nrm(ks[18], (DEPTH, CONV_W, 2 * M_WIDTH), CONV_W ** -0.5)
    conv_b = nrm(ks[19], (DEPTH, 2 * M_WIDTH), 0.01)
    g_mnorm = gain(ks[20], M_WIDTH)
    w_out = nrm(ks[21], (DEPTH, MIX_WIDTH, D_MODEL), MIX_WIDTH ** -0.5)
    g_attn_post = gain(ks[22], D_MODEL)
    g_ffn_pre = gain(ks[23], D_MODEL)
    w_gate = nrm(ks[24], (DEPTH, D_MODEL, D_FF), D_MODEL ** -0.5)
    w_up = nrm(ks[25], (DEPTH, D_MODEL, D_FF), D_MODEL ** -0.5)
    w_down = nrm(ks[26], (DEPTH, D_FF, D_MODEL), D_FF ** -0.5)
    g_ffn_post = gain(ks[27], D_MODEL)
    return {'x_prompt': x_prompt, 'x_sample': x_sample, 'cache_kv': cache_kv, 'cache_win': cache_win,
            'state_conv': state_conv, 'state_C': state_C, 'state_n': state_n, 'state_m': state_m,
            'page_table': page_table, 'rel_bias': rel_bias, 'g_attn_pre': g_attn_pre, 'w_in': w_in,
            'b_in': b_in, 'cmp_pos': cmp_pos, 'cmp_w1': cmp_w1, 'cmp_b1': cmp_b1, 'cmp_w2': cmp_w2,
            'cmp_b2': cmp_b2, 'conv_w': conv_w, 'conv_b': conv_b, 'g_mnorm': g_mnorm, 'w_out': w_out,
            'g_attn_post': g_attn_post, 'g_ffn_pre': g_ffn_pre, 'w_gate': w_gate, 'w_up': w_up,
            'w_down': w_down, 'g_ffn_post': g_ffn_post}


def reference(x_prompt, x_sample, cache_kv, cache_win, state_conv, state_C, state_n, state_m, page_table,
              rel_bias, g_attn_pre, w_in, b_in, cmp_pos, cmp_w1, cmp_b1, cmp_w2, cmp_b2, conv_w, conv_b,
              g_mnorm, w_out, g_attn_post, g_ffn_pre, w_gate, w_up, w_down, g_ffn_post):
    n_pages = page_table.shape[1]
    bp = x_prompt.shape[0]
    bs = x_sample.shape[0]
    yp, ys = x_prompt, x_sample
    outs_p, outs_s = [], []
    for l in range(DEPTH):
        lw = (g_attn_pre[l], w_in[l], b_in[l], cmp_pos[l], cmp_w1[l], cmp_b1[l], cmp_w2[l], cmp_b2[l],
              conv_w[l], conv_b[l], g_mnorm[l], w_out[l], g_attn_post[l], g_ffn_pre[l],
              w_gate[l], w_up[l], w_down[l], g_ffn_post[l])
        zc = jnp.zeros((bp, CONV_W - 1, 2 * M_WIDTH), yp.dtype)
        zC = jnp.zeros((bp, M_HEADS, M_HEAD_DIM, M_HEAD_DIM), jnp.float32)
        zn = jnp.zeros((bp, M_HEADS, M_HEAD_DIM), jnp.float32)
        zm = jnp.zeros((bp, M_HEADS), jnp.float32)
        yp, *sp = layer(yp, 0, None, None, zc, zC, zn, zm, rel_bias, *lw)
        past_kv = cache_kv[l][page_table].reshape(bs, n_pages * PAGE_SIZE, 4, NSA_KV_HEADS, HEAD_DIM)
        ys, *ss = layer(ys, PAST_LEN, past_kv, cache_win[l], state_conv[l], state_C[l], state_n[l], state_m[l],
                        rel_bias, *lw)
        outs_p.append(sp)
        outs_s.append(ss)
    kv_p = jnp.stack([o[0] for o in outs_p])
    kv_s = jnp.stack([o[0] for o in outs_s])
    win_p = jnp.stack([o[1] for o in outs_p])
    win_s = jnp.stack([o[1] for o in outs_s])
    conv_p = jnp.stack([o[2] for o in outs_p])
    conv_s = jnp.stack([o[2] for o in outs_s])
    C_p = jnp.stack([o[3] for o in outs_p])
    C_s = jnp.stack([o[3] for o in outs_s])
    n_p = jnp.stack([o[4] for o in outs_p])
    n_s = jnp.stack([o[4] for o in outs_s])
    m_p = jnp.stack([o[5] for o in outs_p])
    m_s = jnp.stack([o[5] for o in outs_s])
    return (yp, ys, kv_p, kv_s, win_p, win_s, conv_p, conv_s, C_p, C_s, n_p, n_s, m_p, m_s)
```

```cpp
#ifndef CPU_EMU
#include <hip/hip_runtime.h>
#else
#include <cmath>
#include <cstddef>
#define __device__
#define __forceinline__ inline
typedef void* hipStream_t;
#endif
#include <stdint.h>

#ifndef CFG_D_MODEL
#define CFG_D_MODEL 1024
#define CFG_BATCH 4
#define CFG_SEQ 8192
#define CFG_DEC_BATCH 32
#define CFG_PAST_LEN 16384
#endif

namespace {
constexpr int D = CFG_D_MODEL, BATCH = CFG_BATCH, SEQ = CFG_SEQ, DB = CFG_DEC_BATCH, DS = 8, PAST = CFG_PAST_LEN;
constexpr int PAGE = 128, NPAGES = PAST / PAGE;
constexpr int TOKP = BATCH * SEQ, TOKS = DB * DS, TOK = TOKP + TOKS;
constexpr int PROJ = 3360;
constexpr int DFF = ((-(-(8 * D) / 3)) + 255) / 256 * 256;
constexpr int C_Q = 0, C_KVP = 512, C_KVW = 1024, C_GATE = 1280, C_MQK = 1304, C_MV = 2328, C_MIF = 2840, C_MO = 2848;
constexpr int NC_P = SEQ / 16 - 1, NC_S = (PAST + DS) / 16 - 1;
constexpr int NSB_P = SEQ / 64, NSB_S = (PAST + DS + 63) / 64;
constexpr int NSB_MAX = NSB_P > NSB_S ? NSB_P : NSB_S;
constexpr int WBP = SEQ < 512 ? SEQ : 512, WBS = PAST < 512 ? PAST : 512;
constexpr int CLP = 64, NCKP = SEQ / CLP;
constexpr int NSEQ = BATCH + DB;
constexpr int NCHUNK = BATCH * NCKP + DB;
static_assert(SEQ % 128 == 0 && PAST % 128 == 0 && PAST >= 512 && DS == 8, "shape assumptions");
constexpr float NEGBIG = -1e9f, POSBIG = 1e9f;

struct P {
    const float *x_prompt, *x_sample, *cache_kv, *cache_win, *state_conv, *state_C, *state_n, *state_m;
    const int* page_table;
    const float *rel_bias, *g_attn_pre, *w_in, *b_in, *cmp_pos, *cmp_w1, *cmp_b1, *cmp_w2, *cmp_b2, *conv_w, *conv_b, *g_mnorm, *w_out,
        *g_attn_post, *g_ffn_pre, *w_gate, *w_up, *w_down, *g_ffn_post;
    float *o_yp, *o_ys, *o_kvp, *o_kvs, *o_winp, *o_wins, *o_convp, *o_convs, *o_Cp, *o_Cs, *o_np, *o_ns, *o_mp, *o_ms;
    float *h, *proj, *hid, *kcmp, *oc, *ml, *imp, *mixin, *qk, *gb, *gm, *dC, *dn, *S, *hm_pre, *mix, *x1, *h2, *gate, *up, *f;
    int* idx;
};

#define DEV __device__ __forceinline__

struct Row { int path, b, t, pos; };
DEV Row row_info(int row) {
    Row r;
    if (row < TOKP) { r.path = 0; r.b = row / SEQ; r.t = row % SEQ; r.pos = r.t; }
    else { int q = row - TOKP; r.path = 1; r.b = q / DS; r.t = q % DS; r.pos = PAST + r.t; }
    return r;
}
DEV const float* xrow(const P& p, int row) { return row < TOKP ? p.x_prompt + (size_t)row * D : p.x_sample + (size_t)(row - TOKP) * D; }
DEV int seq_row0(int path, int b) { return path == 0 ? b * SEQ : TOKP + b * DS; }
DEV const float* kv_ptr(const P& p, int path, int b, int tpos, int which, int h) {
    if (path == 0) return p.proj + (size_t)(b * SEQ + tpos) * PROJ + C_KVP + which * 128 + h * 64;
    if (tpos < PAST) { int pg = p.page_table[b * NPAGES + tpos / PAGE]; return p.cache_kv + (((size_t)pg * PAGE + tpos % PAGE) * 4 + which) * 128 + h * 64; }
    return p.proj + (size_t)(TOKP + b * DS + (tpos - PAST)) * PROJ + C_KVP + which * 128 + h * 64;
}
DEV int rel_bucket(int n) {
    if (n < 16) return n;
    return 16 + (n >= 21) + (n >= 27) + (n >= 35) + (n >= 46) + (n >= 59) + (n >= 77) + (n >= 99) + (n >= 128) + (n >= 166) + (n >= 216) + (n >= 280) +
           (n >= 363) + (n >= 470) + (n >= 609) + (n >= 790);
}
DEV float sigmoidf_(float x) { return 1.0f / (1.0f + expf(-x)); }
DEV float siluf_(float x) { return x * sigmoidf_(x); }
DEV float logsigmoidf_(float x) { return fminf(x, 0.0f) - log1pf(expf(-fabsf(x))); }
DEV float gelu_tanh(float x) { return 0.5f * x * (1.0f + tanhf(0.7978845608028654f * (x + 0.044715f * x * x * x))); }
DEV float dot64(const float* q, const float* k) {
    float s = 0.f;
#pragma unroll
    for (int d = 0; d < 64; ++d) s += q[d] * k[d];
    return s;
}
DEV size_t kcmp_off(int path, int tensor) {
    size_t o = 0;
    if (path == 1) o += (size_t)2 * BATCH * NC_P * 128;
    o += (size_t)tensor * (path == 0 ? (size_t)BATCH * NC_P * 128 : (size_t)DB * NC_S * 128);
    return o;
}
DEV size_t hid_off(int path, int tensor) {
    size_t o = 0;
    if (path == 1) o += (size_t)2 * BATCH * NC_P * 256;
    o += (size_t)tensor * (path == 0 ? (size_t)BATCH * NC_P * 256 : (size_t)DB * NC_S * 256);
    return o;
}

DEV void b_rmsnorm_in(const P& p, long gid) {
    const int row = (int)gid; const float* x = xrow(p, row);
    float ss = 0.f; for (int k = 0; k < D; ++k) ss += x[k] * x[k];
    const float r = 1.0f / sqrtf(ss / D + 1e-6f);
    for (int k = 0; k < D; ++k) p.h[(size_t)row * D + k] = x[k] * r * p.g_attn_pre[k];
}
DEV void b_out_kv(const P& p, long gid) {
    const int row = (int)(gid / 512), c = (int)(gid % 512);
    const float v = p.proj[(size_t)row * PROJ + C_KVP + c];
    if (row < TOKP) p.o_kvp[(size_t)row * 512 + c] = v; else p.o_kvs[(size_t)(row - TOKP) * 512 + c] = v;
}
DEV void b_out_winp(const P& p, long gid) {
    const int c = (int)(gid % 256), r = (int)((gid / 256) % WBP), b = (int)(gid / (256 * WBP));
    p.o_winp[gid] = p.proj[(size_t)(b * SEQ + SEQ - WBP + r) * PROJ + C_KVW + c];
}
DEV void b_out_wins(const P& p, long gid) {
    const int c = (int)(gid % 256), r = (int)((gid / 256) % WBS), b = (int)(gid / (256 * WBS));
    const int pr = DS + r;
    p.o_wins[gid] = pr < WBS ? p.cache_win[((size_t)b * WBS + pr) * 256 + c] : p.proj[(size_t)(TOKP + b * DS + pr - WBS) * PROJ + C_KVW + c];
}
DEV void b_out_conv(const P& p, long gid) {
    const int c = (int)(gid % 1024), j = (int)((gid / 1024) % 3), sq = (int)(gid / 3072);
    if (sq < BATCH) p.o_convp[gid] = p.proj[(size_t)(sq * SEQ + SEQ - 3 + j) * PROJ + C_MQK + c];
    else p.o_convs[gid - (size_t)BATCH * 3072] = p.proj[(size_t)(TOKP + (sq - BATCH) * DS + DS - 3 + j) * PROJ + C_MQK + c];
}
constexpr long CMPROWS_P = (long)2 * BATCH * NC_P * 2, CMPROWS_S = (long)2 * DB * NC_S * 2;
DEV void cmp_decode(long r, int& path, int& tensor, int& b, int& c, int& h) {
    if (r < CMPROWS_P) { path = 0; h = (int)(r % 2); c = (int)((r / 2) % NC_P); b = (int)((r / (2 * NC_P)) % BATCH); tensor = (int)(r / ((long)2 * NC_P * BATCH)); }
    else { r -= CMPROWS_P; path = 1; h = (int)(r % 2); c = (int)((r / 2) % NC_S); b = (int)((r / (2 * NC_S)) % DB); tensor = (int)(r / ((long)2 * NC_S * DB)); }
}
DEV void b_cmp_hid(const P& p, long gid) {
    const int e = (int)(gid % 128); int path, tensor, b, c, h; cmp_decode(gid / 128, path, tensor, b, c, h);
    const float* w1 = p.cmp_w1 + (size_t)tensor * 2048 * 128; const float* pos = p.cmp_pos + tensor * 2048;
    float acc = p.cmp_b1[tensor * 128 + e];
    for (int j = 0; j < 32; ++j) {
        const float* kr = kv_ptr(p, path, b, c * 16 + j, tensor, h);
        for (int d = 0; d < 64; ++d) acc += (kr[d] + pos[j * 64 + d]) * w1[(size_t)(j * 64 + d) * 128 + e];
    }
    const int nc = path ? NC_S : NC_P;
    p.hid[hid_off(path, tensor) + ((size_t)(b * nc + c) * 2 + h) * 128 + e] = gelu_tanh(acc);
}
DEV void b_cmp_out(const P& p, long gid) {
    const int d = (int)(gid % 64); int path, tensor, b, c, h; cmp_decode(gid / 64, path, tensor, b, c, h);
    const int nc = path ? NC_S : NC_P;
    const float* hid = p.hid + hid_off(path, tensor) + ((size_t)(b * nc + c) * 2 + h) * 128;
    const float* w2 = p.cmp_w2 + (size_t)tensor * 128 * 64;
    float acc = p.cmp_b2[tensor * 64 + d];
    for (int e = 0; e < 128; ++e) acc += hid[e] * w2[e * 64 + d];
    p.kcmp[kcmp_off(path, tensor) + ((size_t)(b * nc + c) * 2 + h) * 64 + d] = acc;
}
DEV void b_cmp_attn(const P& p, long gid) {
    const int row = (int)(gid % TOK), head = (int)(gid / TOK), kvh = head >> 2; const Row r = row_info(row);
    const int nc = r.path ? NC_S : NC_P;
    float q[64];
#pragma unroll
    for (int d = 0; d < 64; ++d) q[d] = p.proj[(size_t)row * PROJ + C_Q + head * 64 + d] * 0.125f;
    int nv = r.pos >= 31 ? (r.pos - 31) / 16 + 1 : 0; if (nv > nc) nv = nc;
    const float* kc = p.kcmp + kcmp_off(r.path, 0) + (size_t)r.b * nc * 128 + kvh * 64;
    const float* vc = p.kcmp + kcmp_off(r.path, 1) + (size_t)r.b * nc * 128 + kvh * 64;
    float m = -3.0e38f;
    for (int c = 0; c < nv; ++c) { const float s = dot64(q, kc + (size_t)c * 128) + p.rel_bias[rel_bucket(r.pos - (c * 16 + 31)) * 8 + head]; m = fmaxf(m, s); }
    float l = 0.f; float acc[64];
#pragma unroll
    for (int d = 0; d < 64; ++d) acc[d] = 0.f;
    for (int c = 0; c < nv; ++c) {
        const float s = dot64(q, kc + (size_t)c * 128) + p.rel_bias[rel_bucket(r.pos - (c * 16 + 31)) * 8 + head];
        const float e = expf(s - m); l += e; const float* vr = vc + (size_t)c * 128;
#pragma unroll
        for (int d = 0; d < 64; ++d) acc[d] += e * vr[d];
    }
    const float inv = nv > 0 ? 1.0f / l : 0.f;
#pragma unroll
    for (int d = 0; d < 64; ++d) p.oc[(size_t)row * 512 + head * 64 + d] = acc[d] * inv;
    p.ml[((size_t)row * 8 + head) * 2 + 0] = m; p.ml[((size_t)row * 8 + head) * 2 + 1] = inv;
}
DEV void b_imp(const P& p, long gid) {
    const int j = (int)(gid % NSB_MAX), kvh = (int)((gid / NSB_MAX) % 2), row = (int)(gid / (2 * NSB_MAX)); const Row r = row_info(row);
    const int nc = r.path ? NC_S : NC_P, nsb = r.path ? NSB_S : NSB_P;
    if (j >= nsb) return;
    float sc;
    if (j == r.pos / 64 || j == 0) sc = POSBIG;
    else if (j * 64 > r.pos) sc = NEGBIG;
    else {
        sc = 0.f;
        const float* kc = p.kcmp + kcmp_off(r.path, 0) + (size_t)r.b * nc * 128 + kvh * 64;
        for (int g = 0; g < 4; ++g) {
            const int head = kvh * 4 + g;
            const float m = p.ml[((size_t)row * 8 + head) * 2], inv = p.ml[((size_t)row * 8 + head) * 2 + 1];
            const float* qp = p.proj + (size_t)row * PROJ + C_Q + head * 64;
            for (int c = 4 * j - 1; c <= 4 * j + 3; ++c) {
                if (c < 0 || c >= nc || c * 16 + 31 > r.pos) continue;
                float s = 0.f; for (int d = 0; d < 64; ++d) s += qp[d] * 0.125f * kc[(size_t)c * 128 + d];
                s += p.rel_bias[rel_bucket(r.pos - (c * 16 + 31)) * 8 + head];
                sc += expf(s - m) * inv;
            }
        }
    }
    p.imp[((size_t)row * 2 + kvh) * NSB_MAX + j] = sc;
}
DEV void b_topk(const P& p, long gid) {
    const int kvh = (int)(gid % 2), row = (int)(gid / 2); const Row r = row_info(row);
    const int ncb = r.pos / 64 + 1;
    const float* sc = p.imp + ((size_t)row * 2 + kvh) * NSB_MAX;
    float pv = 3.0e38f; int pj = -1;
    for (int it = 0; it < 16; ++it) {
        float bv = -3.0e38f; int bj = -1;
        for (int j = 0; j < ncb; ++j) {
            const float v = sc[j];
            const bool after = (v < pv) || (v == pv && j > pj);
            if (after && (bj < 0 || v > bv)) { bv = v; bj = j; }
        }
        p.idx[((size_t)row * 2 + kvh) * 16 + it] = bj;
        if (bj < 0) { pv = -3.0e38f; pj = 1 << 30; } else { pv = bv; pj = bj; }
    }
}
DEV void b_sel_win(const P& p, long gid) {
    const int row = (int)(gid % TOK), head = (int)(gid / TOK), kvh = head >> 2; const Row r = row_info(row);
    float q[64];
#pragma unroll
    for (int d = 0; d < 64; ++d) q[d] = p.proj[(size_t)row * PROJ + C_Q + head * 64 + d] * 0.125f;
    float m = -3.0e38f, l = 0.f; float acc[64];
#pragma unroll
    for (int d = 0; d < 64; ++d) acc[d] = 0.f;
    for (int it = 0; it < 16; ++it) {
        const int j = p.idx[((size_t)row * 2 + kvh) * 16 + it];
        if (j < 0) continue;
        for (int s = 0; s < 64; ++s) {
            const int kpos = j * 64 + s; if (kpos > r.pos) break;
            const float* kr = kv_ptr(p, r.path, r.b, kpos, 2, kvh); const float* vr = kv_ptr(p, r.path, r.b, kpos, 3, kvh);
            const float sc = dot64(q, kr) + p.rel_bias[rel_bucket(r.pos - kpos) * 8 + head];
            const float mn = fmaxf(m, sc), a = expf(m - mn), e = expf(sc - mn);
            l = l * a + e; m = mn;
#pragma unroll
            for (int d = 0; d < 64; ++d) acc[d] = acc[d] * a + e * vr[d];
        }
    }
    const float g0 = sigmoidf_(p.proj[(size_t)row * PROJ + C_GATE + head * 3 + 0]), g1 = sigmoidf_(p.proj[(size_t)row * PROJ + C_GATE + head * 3 + 1]),
                g2 = sigmoidf_(p.proj[(size_t)row * PROJ + C_GATE + head * 3 + 2]);
    float o[64];
    { const float inv = 1.0f / l;
#pragma unroll
      for (int d = 0; d < 64; ++d) o[d] = g0 * p.oc[(size_t)row * 512 + head * 64 + d] + g1 * acc[d] * inv; }
    m = -3.0e38f; l = 0.f;
#pragma unroll
    for (int d = 0; d < 64; ++d) acc[d] = 0.f;
    int k0 = r.pos - 511; if (r.path == 0 && k0 < 0) k0 = 0;
    for (int kp = k0; kp <= r.pos; ++kp) {
        const float* kr;
        if (r.path == 0) kr = p.proj + (size_t)(r.b * SEQ + kp) * PROJ + C_KVW + kvh * 64;
        else if (kp < PAST) kr = p.cache_win + ((size_t)r.b * WBS + (kp - (PAST - WBS))) * 256 + kvh * 64;
        else kr = p.proj + (size_t)(TOKP + r.b * DS + (kp - PAST)) * PROJ + C_KVW + kvh * 64;
        const float* vr = kr + 128;
        const float sc = dot64(q, kr) + p.rel_bias[rel_bucket(r.pos - kp) * 8 + head];
        const float mn = fmaxf(m, sc), a = expf(m - mn), e = expf(sc - mn);
        l = l * a + e; m = mn;
#pragma unroll
        for (int d = 0; d < 64; ++d) acc[d] = acc[d] * a + e * vr[d];
    }
    { const float inv = 1.0f / l;
#pragma unroll
      for (int d = 0; d < 64; ++d) p.mixin[(size_t)row * 1024 + head * 64 + d] = o[d] + g2 * acc[d] * inv; }
}
DEV void b_conv(const P& p, long gid) {
    const int c = (int)(gid % 1024), row = (int)(gid / 1024); const Row r = row_info(row);
    float acc = p.conv_b[c];
#pragma unroll
    for (int j = 0; j < 4; ++j) {
        const int tt = r.t - 3 + j; float v;
        if (tt >= 0) v = p.proj[(size_t)(row - 3 + j) * PROJ + C_MQK + c];
        else v = r.path ? p.state_conv[((size_t)r.b * 3 + (r.t + j)) * 1024 + c] : 0.f;
        acc += v * p.conv_w[j * 1024 + c];
    }
    float o = siluf_(acc); if (c >= 512) o *= 0.08838834764831845f;
    p.qk[(size_t)row * 1024 + c] = o;
}
DEV void b_gates(const P& p, long gid) {
    const int h = (int)(gid % 4), sq = (int)(gid / 4); const int path = sq < BATCH ? 0 : 1, b = path ? sq - BATCH : sq;
    const int T = path ? DS : SEQ, CL = path ? DS : CLP, r0 = seq_row0(path, b);
    float m = path ? p.state_m[b * 4 + h] : 0.f, bs = 0.f;
    for (int t = 0; t < T; ++t) {
        if (t % CL == 0) bs = 0.f;
        const size_t row = r0 + t;
        const float ig = p.proj[row * PROJ + C_MIF + h], lf = logsigmoidf_(p.proj[row * PROJ + C_MIF + 4 + h]);
        bs += lf; m = fmaxf(lf + m, ig);
        p.gb[row * 4 + h] = bs; p.gm[row * 4 + h] = m;
    }
    if (path) p.o_ms[b * 4 + h] = m; else p.o_mp[b * 4 + h] = m;
}
DEV void chunk_info(int ch, int& path, int& b, int& c, int& r0, int& cl) {
    if (ch < BATCH * NCKP) { path = 0; b = ch / NCKP; c = ch % NCKP; r0 = b * SEQ + c * CLP; cl = CLP; }
    else { path = 1; b = ch - BATCH * NCKP; c = 0; r0 = TOKP + b * DS; cl = DS; }
}
DEV float chunk_mprev(const P& p, int path, int b, int c, int r0, int h) {
    if (c > 0) return p.gm[(size_t)(r0 - 1) * 4 + h];
    return path ? p.state_m[b * 4 + h] : 0.f;
}
DEV void b_dC(const P& p, long gid) {
    const int v = (int)(gid % 128), d = (int)((gid / 128) % 128), h = (int)((gid / 16384) % 4), ch = (int)(gid / 65536);
    int path, b, c, r0, cl; chunk_info(ch, path, b, c, r0, cl);
    const float bend = p.gb[(size_t)(r0 + cl - 1) * 4 + h], mnew = p.gm[(size_t)(r0 + cl - 1) * 4 + h];
    float acc = 0.f, accn = 0.f;
    for (int s = 0; s < cl; ++s) {
        const size_t row = r0 + s;
        const float wk = expf(bend - p.gb[row * 4 + h] + p.proj[row * PROJ + C_MIF + h] - mnew);
        const float kk = p.qk[row * 1024 + 512 + h * 128 + d];
        acc += wk * kk * p.proj[row * PROJ + C_MV + h * 128 + v]; accn += wk * kk;
    }
    p.dC[gid] = acc;
    if (v == 0) p.dn[((size_t)ch * 4 + h) * 128 + d] = accn;
}
DEV void b_scan(const P& p, long gid) {
    const int v = (int)(gid % 128), d = (int)((gid / 128) % 128), h = (int)((gid / 16384) % 4), sq = (int)(gid / 65536);
    const int path = sq < BATCH ? 0 : 1, b = path ? sq - BATCH : sq, nck = path ? 1 : NCKP;
    float C = path ? p.state_C[(((size_t)b * 4 + h) * 128 + d) * 128 + v] : 0.f;
    float n = path ? p.state_n[((size_t)b * 4 + h) * 128 + d] : 0.f;
    for (int c = 0; c < nck; ++c) {
        const int ch = path ? BATCH * NCKP + b : b * NCKP + c; int pp, bb, cc, r0, cl; chunk_info(ch, pp, bb, cc, r0, cl);
        const float bend = p.gb[(size_t)(r0 + cl - 1) * 4 + h], mnew = p.gm[(size_t)(r0 + cl - 1) * 4 + h], mprev = chunk_mprev(p, path, b, c, r0, h);
        const float decay = expf(bend + mprev - mnew);
        const size_t ci = (((size_t)ch * 4 + h) * 128 + d) * 128 + v;
        const float t = p.dC[ci]; p.dC[ci] = C; C = decay * C + t;
        if (v == 0) { const size_t ni = ((size_t)ch * 4 + h) * 128 + d; const float tn = p.dn[ni]; p.dn[ni] = n; n = decay * n + tn; }
    }
    const size_t oi = (((size_t)b * 4 + h) * 128 + d) * 128 + v;
    if (path) p.o_Cs[oi] = C; else p.o_Cp[oi] = C;
    if (v == 0) { const size_t ni = ((size_t)b * 4 + h) * 128 + d; if (path) p.o_ns[ni] = n; else p.o_np[ni] = n; }
}
DEV void b_S(const P& p, long gid) {
    const int s = (int)(gid % 64), h = (int)((gid / 64) % 4), row = (int)(gid / 256); const Row r = row_info(row);
    const int cl = r.path ? DS : CLP, tl = r.t % cl, rs = row - tl + s;
    float o = 0.f;
    if (s <= tl) {
        const float* qp = p.qk + (size_t)row * 1024 + h * 128; const float* kp = p.qk + (size_t)rs * 1024 + 512 + h * 128;
        float dt = 0.f; for (int d = 0; d < 128; ++d) dt += qp[d] * kp[d];
        o = dt * expf(p.gb[(size_t)row * 4 + h] - p.gb[(size_t)rs * 4 + h] + p.proj[(size_t)rs * PROJ + C_MIF + h] - p.gm[(size_t)row * 4 + h]);
    }
    p.S[gid] = o;
}
DEV void b_hout(const P& p, long gid) {
    const int v = (int)(gid % 128), h = (int)((gid / 128) % 4), row = (int)(gid / 512); const Row r = row_info(row);
    const int cl = r.path ? DS : CLP, tl = r.t % cl, c = r.t / cl, r0 = row - tl;
    const int ch = r.path ? BATCH * NCKP + r.b : r.b * NCKP + c;
    const float mt = p.gm[(size_t)row * 4 + h], inter = expf(p.gb[(size_t)row * 4 + h] + chunk_mprev(p, r.path, r.b, c, r0, h) - mt);
    const float* Sr = p.S + ((size_t)row * 4 + h) * 64;
    float num = 0.f, den = 0.f;
    for (int s = 0; s <= tl; ++s) { num += Sr[s] * p.proj[(size_t)(r0 + s) * PROJ + C_MV + h * 128 + v]; den += Sr[s]; }
    const float* qp = p.qk + (size_t)row * 1024 + h * 128;
    const float* Cp = p.dC + ((size_t)ch * 4 + h) * 16384; const float* np_ = p.dn + ((size_t)ch * 4 + h) * 128;
    float qc = 0.f, qn = 0.f;
    for (int d = 0; d < 128; ++d) { qc += qp[d] * Cp[d * 128 + v]; qn += qp[d] * np_[d]; }
    num += inter * qc; den += inter * qn;
    const float hv = num / fmaxf(fabsf(den), expf(-mt));
    p.hm_pre[(size_t)row * 512 + h * 128 + v] = sigmoidf_(p.proj[(size_t)row * PROJ + C_MO + h * 128 + v]) * hv;
}
DEV void b_hnorm(const P& p, long gid) {
    const int h = (int)(gid % 4), row = (int)(gid / 4);
    const float* x = p.hm_pre + (size_t)row * 512 + h * 128;
    float ss = 0.f; for (int k = 0; k < 128; ++k) ss += x[k] * x[k];
    const float rr = 1.0f / sqrtf(ss / 128 + 1e-6f);
    for (int k = 0; k < 128; ++k) p.mixin[(size_t)row * 1024 + 512 + h * 128 + k] = x[k] * rr * p.g_mnorm[h * 128 + k];
}
DEV void b_post1(const P& p, long gid) {
    const int row = (int)gid; const float* x = xrow(p, row); const float* mx = p.mix + (size_t)row * D;
    float ss = 0.f; for (int k = 0; k < D; ++k) ss += mx[k] * mx[k];
    const float r1 = 1.0f / sqrtf(ss / D + 1e-6f);
    float s2 = 0.f;
    for (int k = 0; k < D; ++k) { const float v = x[k] + mx[k] * r1 * p.g_attn_post[k]; p.x1[(size_t)row * D + k] = v; s2 += v * v; }
    const float r2 = 1.0f / sqrtf(s2 / D + 1e-6f);
    for (int k = 0; k < D; ++k) p.h2[(size_t)row * D + k] = p.x1[(size_t)row * D + k] * r2 * p.g_ffn_pre[k];
}
DEV void b_swiglu(const P& p, long gid) { p.gate[gid] = siluf_(p.gate[gid]) * p.up[gid]; }
DEV void b_post2(const P& p, long gid) {
    const int row = (int)gid; const float* fx = p.f + (size_t)row * D;
    float ss = 0.f; for (int k = 0; k < D; ++k) ss += fx[k] * fx[k];
    const float r1 = 1.0f / sqrtf(ss / D + 1e-6f);
    float* y = row < TOKP ? p.o_yp + (size_t)row * D : p.o_ys + (size_t)(row - TOKP) * D;
    for (int k = 0; k < D; ++k) y[k] = p.x1[(size_t)row * D + k] + fx[k] * r1 * p.g_ffn_post[k];
}

#ifndef CPU_EMU
template <void (*F)(const P&, long)> __global__ void __launch_bounds__(256) k_run(P p, long total) {
    for (long gid = (long)blockIdx.x * 256 + threadIdx.x; gid < total; gid += (long)gridDim.x * 256) F(p, gid);
}
__global__ void __launch_bounds__(256) k_gemm(const float* __restrict__ A, const float* __restrict__ B, const float* __restrict__ bias, float* __restrict__ C, int M, int N, int K) {
    __shared__ float sA[16][64 + 4], sB[16][64 + 4];
    const int tx = threadIdx.x % 16, ty = threadIdx.x / 16, m0 = blockIdx.y * 64, n0 = blockIdx.x * 64;
    float acc[4][4] = {};
    for (int k0 = 0; k0 < K; k0 += 16) {
        for (int e = threadIdx.x; e < 64 * 16; e += 256) {
            const int r = e / 16, kk = e % 16; sA[kk][r] = (m0 + r < M) ? A[(size_t)(m0 + r) * K + k0 + kk] : 0.f;
            const int kb = e / 64, c = e % 64; sB[kb][c] = (n0 + c < N) ? B[(size_t)(k0 + kb) * N + n0 + c] : 0.f;
        }
        __syncthreads();
#pragma unroll
        for (int kk = 0; kk < 16; ++kk) {
            float a[4], b[4];
#pragma unroll
            for (int i = 0; i < 4; ++i) { a[i] = sA[kk][ty * 4 + i]; b[i] = sB[kk][tx * 4 + i]; }
#pragma unroll
            for (int i = 0; i < 4; ++i)
#pragma unroll
                for (int j = 0; j < 4; ++j) acc[i][j] += a[i] * b[j];
        }
        __syncthreads();
    }
#pragma unroll
    for (int i = 0; i < 4; ++i)
#pragma unroll
        for (int j = 0; j < 4; ++j) { const int r = m0 + ty * 4 + i, c = n0 + tx * 4 + j; if (r < M && c < N) C[(size_t)r * N + c] = acc[i][j] + (bias ? bias[c] : 0.f); }
}
#define RUN(F, total) do { long _t = (total); long _b = (_t + 255) / 256; if (_b > 65536) _b = 65536; hipLaunchKernelGGL(k_run<F>, dim3((unsigned)_b), dim3(256), 0, stream, p, _t); } while (0)
#define GEMM(A, B, bias, C, M, N, K) hipLaunchKernelGGL(k_gemm, dim3(((N) + 63) / 64, ((M) + 63) / 64), dim3(256), 0, stream, A, B, bias, C, M, N, K)
#else
#define RUN(F, total) do { long _t = (total); _Pragma("omp parallel for schedule(dynamic, 64)") for (long g = 0; g < _t; ++g) F(p, g); } while (0)
static void cpu_gemm(const float* A, const float* B, const float* bias, float* C, int M, int N, int K) {
#pragma omp parallel for
    for (int m = 0; m < M; ++m) {
        for (int n = 0; n < N; ++n) C[(size_t)m * N + n] = bias ? bias[n] : 0.f;
        for (int k = 0; k < K; ++k) { const float a = A[(size_t)m * K + k]; for (int n = 0; n < N; ++n) C[(size_t)m * N + n] += a * B[(size_t)k * N + n]; }
    }
}
#define GEMM(A, B, bias, C, M, N, K) cpu_gemm(A, B, bias, C, M, N, K)
#endif
}

extern "C" void kernel_launch(void* const* d_in, const int* in_sizes, int n_in, void* d_out, int out_size, void* d_ws, size_t ws_size, hipStream_t stream) {
    P p{};
    p.x_prompt = (const float*)d_in[0]; p.x_sample = (const float*)d_in[1]; p.cache_kv = (const float*)d_in[2]; p.cache_win = (const float*)d_in[3];
    p.state_conv = (const float*)d_in[4]; p.state_C = (const float*)d_in[5]; p.state_n = (const float*)d_in[6]; p.state_m = (const float*)d_in[7];
    p.page_table = (const int*)d_in[8]; p.rel_bias = (const float*)d_in[9]; p.g_attn_pre = (const float*)d_in[10]; p.w_in = (const float*)d_in[11];
    p.b_in = (const float*)d_in[12]; p.cmp_pos = (const float*)d_in[13]; p.cmp_w1 = (const float*)d_in[14]; p.cmp_b1 = (const float*)d_in[15];
    p.cmp_w2 = (const float*)d_in[16]; p.cmp_b2 = (const float*)d_in[17]; p.conv_w = (const float*)d_in[18]; p.conv_b = (const float*)d_in[19];
    p.g_mnorm = (const float*)d_in[20]; p.w_out = (const float*)d_in[21]; p.g_attn_post = (const float*)d_in[22]; p.g_ffn_pre = (const float*)d_in[23];
    p.w_gate = (const float*)d_in[24]; p.w_up = (const float*)d_in[25]; p.w_down = (const float*)d_in[26]; p.g_ffn_post = (const float*)d_in[27];
    float* o = (float*)d_out;
    p.o_yp = o; o += (size_t)TOKP * D; p.o_ys = o; o += (size_t)TOKS * D; p.o_kvp = o; o += (size_t)TOKP * 512; p.o_kvs = o; o += (size_t)TOKS * 512;
    p.o_winp = o; o += (size_t)BATCH * WBP * 256; p.o_wins = o; o += (size_t)DB * WBS * 256; p.o_convp = o; o += (size_t)BATCH * 3072; p.o_convs = o; o += (size_t)DB * 3072;
    p.o_Cp = o; o += (size_t)BATCH * 65536; p.o_Cs = o; o += (size_t)DB * 65536; p.o_np = o; o += (size_t)BATCH * 512; p.o_ns = o; o += (size_t)DB * 512;
    p.o_mp = o; o += BATCH * 4; p.o_ms = o; o += DB * 4;
    float* w = (float*)d_ws;
    auto take = [&](size_t n) { float* r = w; w += (n + 63) / 64 * 64; return r; };
    p.h = take((size_t)TOK * D); p.proj = take((size_t)TOK * PROJ); p.hid = take((size_t)(CMPROWS_P + CMPROWS_S) * 128); p.kcmp = take((size_t)(CMPROWS_P + CMPROWS_S) * 64);
    p.oc = take((size_t)TOK * 512); p.ml = take((size_t)TOK * 16); p.imp = take((size_t)TOK * 2 * NSB_MAX); p.idx = (int*)take((size_t)TOK * 32);
    p.mixin = take((size_t)TOK * 1024); p.qk = take((size_t)TOK * 1024); p.gb = take((size_t)TOK * 4); p.gm = take((size_t)TOK * 4);
    p.dC = take((size_t)NCHUNK * 65536); p.dn = take((size_t)NCHUNK * 512); p.S = take((size_t)TOK * 256); p.hm_pre = take((size_t)TOK * 512);
    p.mix = take((size_t)TOK * D); p.x1 = take((size_t)TOK * D); p.h2 = take((size_t)TOK * D); p.gate = take((size_t)TOK * DFF); p.up = take((size_t)TOK * DFF); p.f = take((size_t)TOK * D);

    RUN(b_rmsnorm_in, TOK);
    GEMM(p.h, p.w_in, p.b_in, p.proj, TOK, PROJ, D);
    RUN(b_out_kv, (long)TOK * 512); RUN(b_out_winp, (long)BATCH * WBP * 256); RUN(b_out_wins, (long)DB * WBS * 256); RUN(b_out_conv, (long)NSEQ * 3072);
    RUN(b_cmp_hid, (CMPROWS_P + CMPROWS_S) * 128); RUN(b_cmp_out, (CMPROWS_P + CMPROWS_S) * 64);
    RUN(b_cmp_attn, (long)8 * TOK); RUN(b_imp, (long)TOK * 2 * NSB_MAX); RUN(b_topk, (long)TOK * 2); RUN(b_sel_win, (long)8 * TOK);
    RUN(b_conv, (long)TOK * 1024); RUN(b_gates, (long)NSEQ * 4); RUN(b_dC, (long)NCHUNK * 65536); RUN(b_scan, (long)NSEQ * 65536);
    RUN(b_S, (long)TOK * 256); RUN(b_hout, (long)TOK * 512); RUN(b_hnorm, (long)TOK * 4);
    GEMM(p.mixin, p.w_out, (const float*)nullptr, p.mix, TOK, D, 1024);
    RUN(b_post1, TOK);
    GEMM(p.h2, p.w_gate, (const float*)nullptr, p.gate, TOK, DFF, D);
    GEMM(p.h2, p.w_up, (const float*)nullptr, p.up, TOK, DFF, D);
    RUN(b_swiglu, (long)TOK * DFF);
    GEMM(p.gate, p.w_down, (const float*)nullptr, p.f, TOK, D, DFF);
    RUN(b_post2, TOK);
}
```

```cpp
#ifndef CPU_EMU
#include <hip/hip_runtime.h>
#else
#include <cmath>
#include <cstddef>
#include <vector>
#define __device__
#define __forceinline__ inline
typedef void* hipStream_t;
#endif
#include <stdint.h>

#ifndef CFG_D_MODEL
#define CFG_D_MODEL 1024
#define CFG_BATCH 4
#define CFG_SEQ 8192
#define CFG_DEC_BATCH 32
#define CFG_PAST_LEN 16384
#endif

namespace {
#ifdef CPU_EMU
typedef float act_t;
static inline act_t to_act(float f) { return f; }
#else
typedef unsigned short act_t;
typedef __bf16 hbf16v2_ __attribute__((ext_vector_type(2)));
typedef float hf32v2_ __attribute__((ext_vector_type(2)));
__device__ __forceinline__ unsigned pkbf(float lo, float hi) { hf32v2_ v = {lo, hi}; hbf16v2_ r = __builtin_convertvector(v, hbf16v2_); return __builtin_bit_cast(unsigned, r); }
__device__ __forceinline__ act_t to_act(float f) { return (act_t)(pkbf(f, 0.f) & 0xffffu); }
#endif
constexpr int D = CFG_D_MODEL, BATCH = CFG_BATCH, SEQ = CFG_SEQ, DB = CFG_DEC_BATCH, DS = 8, PAST = CFG_PAST_LEN;
constexpr int PAGE = 128, NPAGES = PAST / PAGE;
constexpr int TOKP = BATCH * SEQ, TOKS = DB * DS, TOK = TOKP + TOKS;
constexpr int PROJ = 3360, PROJP = 3584;
constexpr int DFF = ((-(-(8 * D) / 3)) + 255) / 256 * 256;
constexpr int C_Q = 0, C_KVP = 512, C_KVW = 1024, C_GATE = 1280, C_MQK = 1304, C_MV = 2328, C_MIF = 2840, C_MO = 2848;
constexpr int NC_P = SEQ / 16 - 1, NC_S = (PAST + DS) / 16 - 1;
constexpr int NSB_P = SEQ / 64, NSB_S = (PAST + DS + 63) / 64;
constexpr int NSB_MAX = NSB_P > NSB_S ? NSB_P : NSB_S;
constexpr int WBP = SEQ < 512 ? SEQ : 512, WBS = PAST < 512 ? PAST : 512;
constexpr int CLP = 64, NCKP = SEQ / CLP;
constexpr int NSEQ = BATCH + DB;
constexpr int NCHUNK = BATCH * NCKP + DB;
static_assert(SEQ % 128 == 0 && PAST % 128 == 0 && PAST >= 512 && DS == 8, "shape assumptions");
constexpr float NEGBIG = -1e9f, POSBIG = 1e9f;

struct P {
    const float *x_prompt, *x_sample, *cache_kv, *cache_win, *state_conv, *state_C, *state_n, *state_m;
    const int* page_table;
    const float *rel_bias, *g_attn_pre, *w_in, *b_in, *cmp_pos, *cmp_w1, *cmp_b1, *cmp_w2, *cmp_b2, *conv_w, *conv_b, *g_mnorm, *w_out,
        *g_attn_post, *g_ffn_pre, *w_gate, *w_up, *w_down, *g_ffn_post;
    float *o_yp, *o_ys, *o_kvp, *o_kvs, *o_winp, *o_wins, *o_convp, *o_convs, *o_Cp, *o_Cs, *o_np, *o_ns, *o_mp, *o_ms;
    float *h, *proj, *hid, *kcmp, *oc, *ml, *imp, *mixin, *qk, *gb, *gm, *dC, *dn, *S, *hm_pre, *mix, *x1, *h2, *gate, *up, *f;
    int* idx;
    float *cmap, *mprev, *cprev, *nprev, *spart;
    act_t *hb, *mixb, *h2b, *actb, *bt_in, *bt_out, *bt_gu, *bt_down;
    act_t *qb, *ks, *vst, *kw, *vwt, *kc, *vct, *kcs, *vcts;
    act_t *qkb, *dct, *cpt;
    act_t *kvb, *kwb, *mqkb, *mvb, *mob; float *kvwf, *gatef, *mif;
    act_t *mixh, *fh, *fh2;
    act_t *w2t;
    act_t *cas, *cap, *btc, *ccs, *ccp; float *cmpc;
};

#define DEV __device__ __forceinline__

struct Row { int path, b, t, pos; };
DEV Row row_info(int row) {
    Row r;
    if (row < TOKP) { r.path = 0; r.b = row / SEQ; r.t = row % SEQ; r.pos = r.t; }
    else { int q = row - TOKP; r.path = 1; r.b = q / DS; r.t = q % DS; r.pos = PAST + r.t; }
    return r;
}
DEV const float* xrow(const P& p, int row) { return row < TOKP ? p.x_prompt + (size_t)row * D : p.x_sample + (size_t)(row - TOKP) * D; }
DEV int seq_row0(int path, int b) { return path == 0 ? b * SEQ : TOKP + b * DS; }
DEV const float* kv_ptr(const P& p, int path, int b, int tpos, int which, int h) {
    if (path == 0) return p.proj + (size_t)(b * SEQ + tpos) * PROJ + C_KVP + which * 128 + h * 64;
    if (tpos < PAST) { int pg = p.page_table[b * NPAGES + tpos / PAGE]; return p.cache_kv + (((size_t)pg * PAGE + tpos % PAGE) * 4 + which) * 128 + h * 64; }
    return p.proj + (size_t)(TOKP + b * DS + (tpos - PAST)) * PROJ + C_KVP + which * 128 + h * 64;
}
DEV int rel_bucket(int n) {
    if (n < 16) return n;
    return 16 + (n >= 21) + (n >= 27) + (n >= 35) + (n >= 46) + (n >= 59) + (n >= 77) + (n >= 99) + (n >= 128) + (n >= 166) + (n >= 216) + (n >= 280) +
           (n >= 363) + (n >= 470) + (n >= 609) + (n >= 790);
}
DEV float sigmoidf_(float x) { return 1.0f / (1.0f + expf(-x)); }
DEV float siluf_(float x) { return x * sigmoidf_(x); }
DEV float fsigmoid_(float x) { return __builtin_amdgcn_rcpf(1.0f + __builtin_amdgcn_exp2f(x * -1.4426950408889634f)); }
DEV float logsigmoidf_(float x) { return fminf(x, 0.0f) - log1pf(expf(-fabsf(x))); }
#ifdef CPU_EMU
DEV float gelu_tanh(float x) { return 0.5f * x * (1.0f + tanhf(0.7978845608028654f * (x + 0.044715f * x * x * x))); }
#else
DEV float gelu_tanh(float x) { return x * fsigmoid_(1.5957691216057308f * (x + 0.044715f * x * x * x)); }
#endif
#ifdef CPU_EMU
#define SCHED_FENCE()
#else
#define SCHED_FENCE() __builtin_amdgcn_sched_barrier(0)
#endif
DEV float dot64(const float* q, const float* k) {
    float s = 0.f;
#pragma unroll
    for (int c = 0; c < 4; ++c) {
#pragma unroll
        for (int d = 0; d < 16; ++d) s += q[c * 16 + d] * k[c * 16 + d];
        SCHED_FENCE();
    }
    return s;
}
DEV void axpy64(float* acc, float a, float e, const float* v) {
#pragma unroll
    for (int c = 0; c < 4; ++c) {
#pragma unroll
        for (int d = 0; d < 16; ++d) acc[c * 16 + d] = acc[c * 16 + d] * a + e * v[c * 16 + d];
        SCHED_FENCE();
    }
}
DEV size_t kcmp_off(int path, int tensor) {
    size_t o = 0;
    if (path == 1) o += (size_t)2 * BATCH * NC_P * 128;
    o += (size_t)tensor * (path == 0 ? (size_t)BATCH * NC_P * 128 : (size_t)DB * NC_S * 128);
    return o;
}
DEV size_t hid_off(int path, int tensor) {
    size_t o = 0;
    if (path == 1) o += (size_t)2 * BATCH * NC_P * 256;
    o += (size_t)tensor * (path == 0 ? (size_t)BATCH * NC_P * 256 : (size_t)DB * NC_S * 256);
    return o;
}

DEV void b_rmsnorm_in(const P& p, long gid) {
    const int row = (int)gid; const float* x = xrow(p, row);
    float ss = 0.f; for (int k = 0; k < D; ++k) ss += x[k] * x[k];
    const float r = 1.0f / sqrtf(ss / D + 1e-6f);
    for (int k = 0; k < D; ++k) p.hb[(size_t)row * D + k] = to_act(x[k] * r * p.g_attn_pre[k]);
}
DEV void b_out_kv(const P& p, long gid) {
    const int row = (int)(gid / 512), c = (int)(gid % 512);
    const float v = p.proj[(size_t)row * PROJ + C_KVP + c];
    if (row < TOKP) p.o_kvp[(size_t)row * 512 + c] = v; else p.o_kvs[(size_t)(row - TOKP) * 512 + c] = v;
}
DEV void b_out_winp(const P& p, long gid) {
    const int c = (int)(gid % 256), r = (int)((gid / 256) % WBP), b = (int)(gid / (256 * WBP));
    p.o_winp[gid] = p.proj[(size_t)(b * SEQ + SEQ - WBP + r) * PROJ + C_KVW + c];
}
DEV void b_out_wins(const P& p, long gid) {
    const int c = (int)(gid % 256), r = (int)((gid / 256) % WBS), b = (int)(gid / (256 * WBS));
    const int pr = DS + r;
    p.o_wins[gid] = pr < WBS ? p.cache_win[((size_t)b * WBS + pr) * 256 + c] : p.proj[(size_t)(TOKP + b * DS + pr - WBS) * PROJ + C_KVW + c];
}
DEV void b_out_conv(const P& p, long gid) {
    const int c = (int)(gid % 1024), j = (int)((gid / 1024) % 3), sq = (int)(gid / 3072);
    if (sq < BATCH) p.o_convp[gid] = p.proj[(size_t)(sq * SEQ + SEQ - 3 + j) * PROJ + C_MQK + c];
    else p.o_convs[gid - (size_t)BATCH * 3072] = p.proj[(size_t)(TOKP + (sq - BATCH) * DS + DS - 3 + j) * PROJ + C_MQK + c];
}
constexpr long CMPROWS_P = (long)2 * BATCH * NC_P * 2, CMPROWS_S = (long)2 * DB * NC_S * 2;
DEV void cmp_decode(long r, int& path, int& tensor, int& b, int& c, int& h) {
    if (r < CMPROWS_P) { path = 0; h = (int)(r % 2); c = (int)((r / 2) % NC_P); b = (int)((r / (2 * NC_P)) % BATCH); tensor = (int)(r / ((long)2 * NC_P * BATCH)); }
    else { r -= CMPROWS_P; path = 1; h = (int)(r % 2); c = (int)((r / 2) % NC_S); b = (int)((r / (2 * NC_S)) % DB); tensor = (int)(r / ((long)2 * NC_S * DB)); }
}
DEV void b_cmp_hid(const P& p, long gid) {
    const int e = (int)(gid % 128); int path, tensor, b, c, h; cmp_decode(gid / 128, path, tensor, b, c, h);
    const float* w1 = p.cmp_w1 + (size_t)tensor * 2048 * 128; const float* pos = p.cmp_pos + tensor * 2048;
    float acc = p.cmp_b1[tensor * 128 + e];
    for (int j = 0; j < 32; ++j) {
        const float* kr = kv_ptr(p, path, b, c * 16 + j, tensor, h);
        for (int d = 0; d < 64; ++d) acc += (kr[d] + pos[j * 64 + d]) * w1[(size_t)(j * 64 + d) * 128 + e];
    }
    const int nc = path ? NC_S : NC_P;
    p.hid[hid_off(path, tensor) + ((size_t)(b * nc + c) * 2 + h) * 128 + e] = gelu_tanh(acc);
}
DEV void b_cmp_out(const P& p, long gid) {
    const int d = (int)(gid % 64); int path, tensor, b, c, h; cmp_decode(gid / 64, path, tensor, b, c, h);
    const int nc = path ? NC_S : NC_P;
    const float* hid = p.hid + hid_off(path, tensor) + ((size_t)(b * nc + c) * 2 + h) * 128;
    const float* w2 = p.cmp_w2 + (size_t)tensor * 128 * 64;
    float acc = p.cmp_b2[tensor * 64 + d];
    for (int e = 0; e < 128; ++e) acc += hid[e] * w2[e * 64 + d];
    p.kcmp[kcmp_off(path, tensor) + ((size_t)(b * nc + c) * 2 + h) * 64 + d] = acc;
}
DEV void b_cmp_attn(const P& p, long gid) {
    const int row = (int)(gid % TOK), head = (int)(gid / TOK), kvh = head >> 2; const Row r = row_info(row);
    const int nc = r.path ? NC_S : NC_P;
    float q[64];
#pragma unroll
    for (int d = 0; d < 64; ++d) q[d] = p.proj[(size_t)row * PROJ + C_Q + head * 64 + d] * 0.125f;
    int nv = r.pos >= 31 ? (r.pos - 31) / 16 + 1 : 0; if (nv > nc) nv = nc;
    const float* kc = p.kcmp + kcmp_off(r.path, 0) + (size_t)r.b * nc * 128 + kvh * 64;
    const float* vc = p.kcmp + kcmp_off(r.path, 1) + (size_t)r.b * nc * 128 + kvh * 64;
    float m = -3.0e38f;
    for (int c = 0; c < nv; ++c) { const float s = dot64(q, kc + (size_t)c * 128) + p.rel_bias[rel_bucket(r.pos - (c * 16 + 31)) * 8 + head]; m = fmaxf(m, s); }
    float l = 0.f; float acc[64];
#pragma unroll
    for (int d = 0; d < 64; ++d) acc[d] = 0.f;
    for (int c = 0; c < nv; ++c) {
        const float s = dot64(q, kc + (size_t)c * 128) + p.rel_bias[rel_bucket(r.pos - (c * 16 + 31)) * 8 + head];
        const float e = expf(s - m); l += e; axpy64(acc, 1.0f, e, vc + (size_t)c * 128);
    }
    const float inv = nv > 0 ? 1.0f / l : 0.f;
#pragma unroll
    for (int d = 0; d < 64; ++d) p.oc[(size_t)row * 512 + head * 64 + d] = acc[d] * inv;
    p.ml[((size_t)row * 8 + head) * 2 + 0] = m; p.ml[((size_t)row * 8 + head) * 2 + 1] = inv;
}
DEV void b_imp(const P& p, long gid) {
    const int j = (int)(gid % NSB_MAX), kvh = (int)((gid / NSB_MAX) % 2), row = (int)(gid / (2 * NSB_MAX)); const Row r = row_info(row);
    const int nc = r.path ? NC_S : NC_P, nsb = r.path ? NSB_S : NSB_P;
    if (j >= nsb) return;
    float sc;
    if (j == r.pos / 64 || j == 0) sc = POSBIG;
    else if (j * 64 > r.pos) sc = NEGBIG;
    else {
        sc = 0.f;
        const float* kc = p.kcmp + kcmp_off(r.path, 0) + (size_t)r.b * nc * 128 + kvh * 64;
        for (int g = 0; g < 4; ++g) {
            const int head = kvh * 4 + g;
            const float m = p.ml[((size_t)row * 8 + head) * 2], inv = p.ml[((size_t)row * 8 + head) * 2 + 1];
            const float* qp = p.proj + (size_t)row * PROJ + C_Q + head * 64;
            for (int c = 4 * j - 1; c <= 4 * j + 3; ++c) {
                if (c < 0 || c >= nc || c * 16 + 31 > r.pos) continue;
                float s = 0.f; for (int d = 0; d < 64; ++d) s += qp[d] * 0.125f * kc[(size_t)c * 128 + d];
                s += p.rel_bias[rel_bucket(r.pos - (c * 16 + 31)) * 8 + head];
                sc += expf(s - m) * inv;
            }
        }
    }
    p.imp[((size_t)row * 2 + kvh) * NSB_MAX + j] = sc;
}
DEV void b_topk(const P& p, long gid) {
    const int kvh = (int)(gid % 2), row = (int)(gid / 2); const Row r = row_info(row);
    const int ncb = r.pos / 64 + 1;
    const float* sc = p.imp + ((size_t)row * 2 + kvh) * NSB_MAX;
    float pv = 3.0e38f; int pj = -1;
    for (int it = 0; it < 16; ++it) {
        float bv = -3.0e38f; int bj = -1;
        for (int j = 0; j < ncb; ++j) {
            const float v = sc[j];
            const bool after = (v < pv) || (v == pv && j > pj);
            if (after && (bj < 0 || v > bv)) { bv = v; bj = j; }
        }
        p.idx[((size_t)row * 2 + kvh) * 16 + it] = bj;
        if (bj < 0) { pv = -3.0e38f; pj = 1 << 30; } else { pv = bv; pj = bj; }
    }
}
DEV void b_sel_win(const P& p, long gid) {
    const int row = (int)(gid % TOK), head = (int)(gid / TOK), kvh = head >> 2; const Row r = row_info(row);
    float q[64];
#pragma unroll
    for (int d = 0; d < 64; ++d) q[d] = p.proj[(size_t)row * PROJ + C_Q + head * 64 + d] * 0.125f;
    float m = -3.0e38f, l = 0.f; float acc[64];
#pragma unroll
    for (int d = 0; d < 64; ++d) acc[d] = 0.f;
    for (int it = 0; it < 16; ++it) {
        const int j = p.idx[((size_t)row * 2 + kvh) * 16 + it];
        if (j < 0) continue;
        for (int s = 0; s < 64; ++s) {
            const int kpos = j * 64 + s; if (kpos > r.pos) break;
            const float* kr = kv_ptr(p, r.path, r.b, kpos, 2, kvh); const float* vr = kv_ptr(p, r.path, r.b, kpos, 3, kvh);
            const float sc = dot64(q, kr) + p.rel_bias[rel_bucket(r.pos - kpos) * 8 + head];
            const float mn = fmaxf(m, sc), a = expf(m - mn), e = expf(sc - mn);
            l = l * a + e; m = mn; axpy64(acc, a, e, vr);
        }
    }
    const float g0 = sigmoidf_(p.proj[(size_t)row * PROJ + C_GATE + head * 3 + 0]), g1 = sigmoidf_(p.proj[(size_t)row * PROJ + C_GATE + head * 3 + 1]),
                g2 = sigmoidf_(p.proj[(size_t)row * PROJ + C_GATE + head * 3 + 2]);
    { const float inv = 1.0f / l;
#pragma unroll
      for (int d = 0; d < 64; ++d) p.mixin[(size_t)row * 1024 + head * 64 + d] = g0 * p.oc[(size_t)row * 512 + head * 64 + d] + g1 * acc[d] * inv; }
    m = -3.0e38f; l = 0.f;
#pragma unroll
    for (int d = 0; d < 64; ++d) acc[d] = 0.f;
    int k0 = r.pos - 511; if (r.path == 0 && k0 < 0) k0 = 0;
    for (int kp = k0; kp <= r.pos; ++kp) {
        const float* kr;
        if (r.path == 0) kr = p.proj + (size_t)(r.b * SEQ + kp) * PROJ + C_KVW + kvh * 64;
        else if (kp < PAST) kr = p.cache_win + ((size_t)r.b * WBS + (kp - (PAST - WBS))) * 256 + kvh * 64;
        else kr = p.proj + (size_t)(TOKP + r.b * DS + (kp - PAST)) * PROJ + C_KVW + kvh * 64;
        const float* vr = kr + 128;
        const float sc = dot64(q, kr) + p.rel_bias[rel_bucket(r.pos - kp) * 8 + head];
        const float mn = fmaxf(m, sc), a = expf(m - mn), e = expf(sc - mn);
        l = l * a + e; m = mn; axpy64(acc, a, e, vr);
    }
    { const float inv = 1.0f / l;
#pragma unroll
      for (int d = 0; d < 64; ++d) p.mixb[(size_t)row * 1024 + head * 64 + d] = to_act(p.mixin[(size_t)row * 1024 + head * 64 + d] + g2 * acc[d] * inv); }
}
DEV void b_conv(const P& p, long gid) {
    const int c = (int)(gid % 1024), row = (int)(gid / 1024); const Row r = row_info(row);
    float acc = p.conv_b[c];
#pragma unroll
    for (int j = 0; j < 4; ++j) {
        const int tt = r.t - 3 + j; float v;
        if (tt >= 0) v = p.proj[(size_t)(row - 3 + j) * PROJ + C_MQK + c];
        else v = r.path ? p.state_conv[((size_t)r.b * 3 + (r.t + j)) * 1024 + c] : 0.f;
        acc += v * p.conv_w[j * 1024 + c];
    }
    float o = siluf_(acc); if (c >= 512) o *= 0.08838834764831845f;
    p.qk[(size_t)row * 1024 + c] = o;
#ifndef CPU_EMU
    p.qkb[(size_t)row * 1024 + c] = to_act(o);
#endif
}
DEV void b_gates(const P& p, long gid) {
    const int h = (int)(gid % 4), sq = (int)(gid / 4); const int path = sq < BATCH ? 0 : 1, b = path ? sq - BATCH : sq;
    const int T = path ? DS : SEQ, CL = path ? DS : CLP, r0 = seq_row0(path, b);
    float m = path ? p.state_m[b * 4 + h] : 0.f, bs = 0.f;
    for (int t = 0; t < T; ++t) {
        if (t % CL == 0) bs = 0.f;
        const size_t row = r0 + t;
        const float ig = p.proj[row * PROJ + C_MIF + h], lf = logsigmoidf_(p.proj[row * PROJ + C_MIF + 4 + h]);
        bs += lf; m = fmaxf(lf + m, ig);
        p.gb[row * 4 + h] = bs; p.gm[row * 4 + h] = m;
    }
    if (path) p.o_ms[b * 4 + h] = m; else p.o_mp[b * 4 + h] = m;
}
DEV void chunk_info(int ch, int& path, int& b, int& c, int& r0, int& cl) {
    if (ch < BATCH * NCKP) { path = 0; b = ch / NCKP; c = ch % NCKP; r0 = b * SEQ + c * CLP; cl = CLP; }
    else { path = 1; b = ch - BATCH * NCKP; c = 0; r0 = TOKP + b * DS; cl = DS; }
}
DEV float chunk_mprev(const P& p, int path, int b, int c, int r0, int h) {
    if (c > 0) return p.gm[(size_t)(r0 - 1) * 4 + h];
    return path ? p.state_m[b * 4 + h] : 0.f;
}
DEV void b_scan2(const P& p, long gid) {
    const int v = (int)(gid % 128), d = (int)((gid / 128) % 128), h = (int)((gid / 16384) % 4), sq = (int)(gid / 65536);
    const int path = sq < BATCH ? 0 : 1, b = path ? sq - BATCH : sq, nck = path ? 1 : NCKP, ch0 = path ? BATCH * NCKP + b : b * NCKP;
    float C = path ? p.state_C[(((size_t)b * 4 + h) * 128 + d) * 128 + v] : 0.f;
    float n = path ? p.state_n[((size_t)b * 4 + h) * 128 + d] : 0.f;
    const float* __restrict__ dC = p.dC + (((size_t)ch0 * 4 + h) * 128 + d) * 128 + v; float* __restrict__ cp = p.cprev + (((size_t)ch0 * 4 + h) * 128 + d) * 128 + v;
    const float* __restrict__ dn = p.dn + ((size_t)ch0 * 4 + h) * 128 + d; float* __restrict__ np_ = p.nprev + ((size_t)ch0 * 4 + h) * 128 + d;
    const float* __restrict__ cm = p.cmap + ((size_t)ch0 * 4 + h) * 2; const float* __restrict__ mp = p.mprev + (size_t)ch0 * 4 + h;
    float mpv = mp[0];
#pragma unroll 8
    for (int c = 0; c < nck; ++c) {
        const float L = cm[(size_t)c * 8], I = cm[(size_t)c * 8 + 1], mnew = fmaxf(mpv + L, I), decay = expf(L + mpv - mnew);
        const float t = dC[(size_t)c * 65536]; cp[(size_t)c * 65536] = C; C = decay * C + t;
        if (v == 0) { const float tn = dn[(size_t)c * 512]; np_[(size_t)c * 512] = n; n = decay * n + tn; }
        mpv = mnew;
    }
    const size_t oi = (((size_t)b * 4 + h) * 128 + d) * 128 + v;
    if (path) p.o_Cs[oi] = C; else p.o_Cp[oi] = C;
    if (v == 0) { const size_t ni = ((size_t)b * 4 + h) * 128 + d; if (path) p.o_ns[ni] = n; else p.o_np[ni] = n; }
}
DEV void b_dC(const P& p, long gid) {
    const int v = (int)(gid % 128), d = (int)((gid / 128) % 128), h = (int)((gid / 16384) % 4), ch = (int)(gid / 65536);
    int path, b, c, r0, cl; chunk_info(ch, path, b, c, r0, cl);
    const float bend = p.gb[(size_t)(r0 + cl - 1) * 4 + h], mnew = p.gm[(size_t)(r0 + cl - 1) * 4 + h];
    float acc = 0.f, accn = 0.f;
    for (int s = 0; s < cl; ++s) {
        const size_t row = r0 + s;
        const float wk = expf(bend - p.gb[row * 4 + h] + p.proj[row * PROJ + C_MIF + h] - mnew);
        const float kk = p.qk[row * 1024 + 512 + h * 128 + d];
        acc += wk * kk * p.proj[row * PROJ + C_MV + h * 128 + v]; accn += wk * kk;
    }
    p.dC[gid] = acc;
    if (v == 0) p.dn[((size_t)ch * 4 + h) * 128 + d] = accn;
}
DEV void b_scan(const P& p, long gid) {
    const int v = (int)(gid % 128), d = (int)((gid / 128) % 128), h = (int)((gid / 16384) % 4), sq = (int)(gid / 65536);
    const int path = sq < BATCH ? 0 : 1, b = path ? sq - BATCH : sq, nck = path ? 1 : NCKP;
    float C = path ? p.state_C[(((size_t)b * 4 + h) * 128 + d) * 128 + v] : 0.f;
    float n = path ? p.state_n[((size_t)b * 4 + h) * 128 + d] : 0.f;
    for (int c = 0; c < nck; ++c) {
        const int ch = path ? BATCH * NCKP + b : b * NCKP + c; int pp, bb, cc, r0, cl; chunk_info(ch, pp, bb, cc, r0, cl);
        const float bend = p.gb[(size_t)(r0 + cl - 1) * 4 + h], mnew = p.gm[(size_t)(r0 + cl - 1) * 4 + h], mprev = chunk_mprev(p, path, b, c, r0, h);
        const float decay = expf(bend + mprev - mnew);
        const size_t ci = (((size_t)ch * 4 + h) * 128 + d) * 128 + v;
        const float t = p.dC[ci]; p.dC[ci] = C; C = decay * C + t;
        if (v == 0) { const size_t ni = ((size_t)ch * 4 + h) * 128 + d; const float tn = p.dn[ni]; p.dn[ni] = n; n = decay * n + tn; }
    }
    const size_t oi = (((size_t)b * 4 + h) * 128 + d) * 128 + v;
    if (path) p.o_Cs[oi] = C; else p.o_Cp[oi] = C;
    if (v == 0) { const size_t ni = ((size_t)b * 4 + h) * 128 + d; if (path) p.o_ns[ni] = n; else p.o_np[ni] = n; }
}
DEV void b_S(const P& p, long gid) {
    const int s = (int)(gid % 64), h = (int)((gid / 64) % 4), row = (int)(gid / 256); const Row r = row_info(row);
    const int cl = r.path ? DS : CLP, tl = r.t % cl, rs = row - tl + s;
    float o = 0.f;
    if (s <= tl) {
        const float* qp = p.qk + (size_t)row * 1024 + h * 128; const float* kp = p.qk + (size_t)rs * 1024 + 512 + h * 128;
        float dt = 0.f; for (int d = 0; d < 128; ++d) dt += qp[d] * kp[d];
        o = dt * expf(p.gb[(size_t)row * 4 + h] - p.gb[(size_t)rs * 4 + h] + p.proj[(size_t)rs * PROJ + C_MIF + h] - p.gm[(size_t)row * 4 + h]);
    }
    p.S[gid] = o;
}
DEV void b_hout(const P& p, long gid) {
    const int v = (int)(gid % 128), h = (int)((gid / 128) % 4), row = (int)(gid / 512); const Row r = row_info(row);
    const int cl = r.path ? DS : CLP, tl = r.t % cl, c = r.t / cl, r0 = row - tl;
    const int ch = r.path ? BATCH * NCKP + r.b : r.b * NCKP + c;
    const float mt = p.gm[(size_t)row * 4 + h], inter = expf(p.gb[(size_t)row * 4 + h] + chunk_mprev(p, r.path, r.b, c, r0, h) - mt);
    const float* Sr = p.S + ((size_t)row * 4 + h) * 64;
    float num = 0.f, den = 0.f;
    for (int s = 0; s <= tl; ++s) { num += Sr[s] * p.proj[(size_t)(r0 + s) * PROJ + C_MV + h * 128 + v]; den += Sr[s]; }
    const float* qp = p.qk + (size_t)row * 1024 + h * 128;
    const float* Cp = p.cprev + ((size_t)ch * 4 + h) * 16384; const float* np_ = p.nprev + ((size_t)ch * 4 + h) * 128;
    float qc = 0.f, qn = 0.f;
    for (int d = 0; d < 128; ++d) { qc += qp[d] * Cp[d * 128 + v]; qn += qp[d] * np_[d]; }
    num += inter * qc; den += inter * qn;
    const float hv = num / fmaxf(fabsf(den), expf(-mt));
    p.hm_pre[(size_t)row * 512 + h * 128 + v] = sigmoidf_(p.proj[(size_t)row * PROJ + C_MO + h * 128 + v]) * hv;
}
DEV void b_hnorm(const P& p, long gid) {
    const int h = (int)(gid % 4), row = (int)(gid / 4);
    const float* x = p.hm_pre + (size_t)row * 512 + h * 128;
    float ss = 0.f; for (int k = 0; k < 128; ++k) ss += x[k] * x[k];
    const float rr = 1.0f / sqrtf(ss / 128 + 1e-6f);
    for (int k = 0; k < 128; ++k) p.mixb[(size_t)row * 1024 + 512 + h * 128 + k] = to_act(x[k] * rr * p.g_mnorm[h * 128 + k]);
}
DEV void b_post1(const P& p, long gid) {
    const int row = (int)gid; const float* x = xrow(p, row); const float* mx = p.mix + (size_t)row * D;
    float ss = 0.f; for (int k = 0; k < D; ++k) ss += mx[k] * mx[k];
    const float r1 = 1.0f / sqrtf(ss / D + 1e-6f);
    float s2 = 0.f;
    for (int k = 0; k < D; ++k) { const float v = x[k] + mx[k] * r1 * p.g_attn_post[k]; p.x1[(size_t)row * D + k] = v; s2 += v * v; }
    const float r2 = 1.0f / sqrtf(s2 / D + 1e-6f);
    for (int k = 0; k < D; ++k) p.h2b[(size_t)row * D + k] = to_act(p.x1[(size_t)row * D + k] * r2 * p.g_ffn_pre[k]);
}
DEV void b_swiglu(const P& p, long gid) {
    const long row = gid / DFF, c = gid % DFF; p.actb[gid] = to_act(siluf_(p.gate[row * 2 * DFF + c]) * p.gate[row * 2 * DFF + DFF + c]);
}
DEV void b_wt(const float* w, act_t* bt, int K, int N, int col0, long gid) { const int n = (int)(gid % N), k = (int)(gid / N); bt[(size_t)(col0 + n) * K + k] = to_act(w[gid]); }
DEV void b_wt_in(const P& p, long gid) { b_wt(p.w_in, p.bt_in, D, PROJ, 0, gid); }
DEV void b_wt_inpad(const P& p, long gid) { p.bt_in[(size_t)PROJ * D + gid] = to_act(0.f); }
DEV void b_wt_out(const P& p, long gid) { b_wt(p.w_out, p.bt_out, 1024, D, 0, gid); }
DEV void b_wt_gate(const P& p, long gid) { b_wt(p.w_gate, p.bt_gu, D, DFF, 0, gid); }
DEV void b_wt_up(const P& p, long gid) { b_wt(p.w_up, p.bt_gu, D, DFF, DFF, gid); }
DEV void b_wt_down(const P& p, long gid) { b_wt(p.w_down, p.bt_down, DFF, D, 0, gid); }
DEV void b_post2(const P& p, long gid) {
    const int row = (int)gid; const float* fx = p.f + (size_t)row * D;
    float ss = 0.f; for (int k = 0; k < D; ++k) ss += fx[k] * fx[k];
    const float r1 = 1.0f / sqrtf(ss / D + 1e-6f);
    float* y = row < TOKP ? p.o_yp + (size_t)row * D : p.o_ys + (size_t)(row - TOKP) * D;
    for (int k = 0; k < D; ++k) y[k] = p.x1[(size_t)row * D + k] + fx[k] * r1 * p.g_ffn_post[k];
}


constexpr float LOG2E = 1.4426950408889634f;
DEV int clampi3(int x, int lo, int hi) { return x < lo ? lo : (x > hi ? hi : x); }
DEV int perm16(int t) { return (t & ~15) | (t & 3) | ((t & 4) << 1) | ((t & 8) >> 1); }
DEV void b_prep_q(const P& p, long gid) {
    p.qb[gid] = to_act(p.proj[(size_t)(gid / 512) * PROJ + C_Q + (gid % 512)] * (0.125f * LOG2E));
}
DEV void b_prep_kv(const P& p, long gid) {
    const int d = (int)(gid % 64), kvh = (int)((gid / 64) % 2), t = (int)((gid / 128) % SEQ), b = (int)(gid / (128 * (long)SEQ));
    const float* pr = p.proj + (size_t)(b * SEQ + t) * PROJ;
    const size_t bh = (size_t)b * 2 + kvh;
    p.ks[(bh * SEQ + t) * 64 + d] = to_act(pr[C_KVP + 2 * 128 + kvh * 64 + d]);
    p.vst[(bh * 64 + d) * SEQ + perm16(t)] = to_act(pr[C_KVP + 3 * 128 + kvh * 64 + d]);
    p.kw[(bh * SEQ + t) * 64 + d] = to_act(pr[C_KVW + kvh * 64 + d]);
    p.vwt[(bh * 64 + d) * SEQ + perm16(t)] = to_act(pr[C_KVW + 128 + kvh * 64 + d]);
}
constexpr int NCPAD = (NC_P + 64) / 64 * 64, NCSPAD = (NC_S + 64) / 64 * 64;
DEV void b_prep_c(const P& p, long gid) {
    const int d = (int)(gid % 64), c = (int)((gid / 64) % NCPAD), kvh = (int)((gid / (64 * NCPAD)) % 2), b = (int)(gid / (128 * (long)NCPAD));
    const size_t bh = (size_t)b * 2 + kvh;
    float kv = 0.f, vv = 0.f;
    if (c < NC_P) { kv = p.kcmp[kcmp_off(0, 0) + ((size_t)(b * NC_P + c) * 2 + kvh) * 64 + d]; vv = p.kcmp[kcmp_off(0, 1) + ((size_t)(b * NC_P + c) * 2 + kvh) * 64 + d]; }
    p.kc[(bh * NCPAD + c) * 64 + d] = to_act(kv);
    p.vct[(bh * 64 + d) * NCPAD + perm16(c)] = to_act(vv);
}
DEV void b_prep_cs(const P& p, long gid) {
    const int d = (int)(gid % 64), c = (int)((gid / 64) % NCSPAD), kvh = (int)((gid / (64 * NCSPAD)) % 2), b = (int)(gid / (128 * (long)NCSPAD));
    const size_t bh = (size_t)b * 2 + kvh;
    float kv = 0.f, vv = 0.f;
    if (c < NC_S) { kv = p.kcmp[kcmp_off(1, 0) + ((size_t)(b * NC_S + c) * 2 + kvh) * 64 + d]; vv = p.kcmp[kcmp_off(1, 1) + ((size_t)(b * NC_S + c) * 2 + kvh) * 64 + d]; }
    p.kcs[(bh * NCSPAD + c) * 64 + d] = to_act(kv);
    p.vcts[(bh * 64 + d) * NCSPAD + perm16(c)] = to_act(vv);
}


DEV void b_scan3(const P& p, long gid) {
    typedef float f32x4 __attribute__((ext_vector_type(4))); typedef unsigned u32x2 __attribute__((ext_vector_type(2)));
    const int dq = (int)(gid % 32), v = (int)((gid / 32) % 128), h = (int)((gid / 4096) % 4), sq = (int)(gid / 16384);
    const int path = sq < BATCH ? 0 : 1, b = path ? sq - BATCH : sq, nck = path ? 1 : NCKP, ch0 = path ? BATCH * NCKP + b : b * NCKP;
    float C[4], n[4] = {0.f, 0.f, 0.f, 0.f};
#pragma unroll
    for (int e = 0; e < 4; ++e) C[e] = path ? p.state_C[(((size_t)b * 4 + h) * 128 + dq * 4 + e) * 128 + v] : 0.f;
    const bool don = (v == 0);
    if (don && path) { const f32x4 t = *(const f32x4*)(p.state_n + ((size_t)b * 4 + h) * 128 + dq * 4); n[0] = t[0]; n[1] = t[1]; n[2] = t[2]; n[3] = t[3]; }
    const act_t* __restrict__ dC = p.dct + ((size_t)ch0 * 4 + h) * 16384 + v * 128 + dq * 4; act_t* __restrict__ cp = p.cpt + ((size_t)ch0 * 4 + h) * 16384 + v * 128 + dq * 4;
    const float* __restrict__ dn = p.dn + ((size_t)ch0 * 4 + h) * 128 + dq * 4; float* __restrict__ np_ = p.nprev + ((size_t)ch0 * 4 + h) * 128 + dq * 4;
    const float* __restrict__ cm = p.cmap + ((size_t)ch0 * 4 + h) * 2;
    float mpv = p.mprev[(size_t)ch0 * 4 + h];
    constexpr int BT = 8;
    float Lc[BT], Ic[BT], Ln[BT], In[BT]; u32x2 tc[BT], tn_[BT];
#pragma unroll
    for (int i = 0; i < BT; ++i) { const int c = i < nck ? i : nck - 1; Lc[i] = cm[(size_t)c * 8]; Ic[i] = cm[(size_t)c * 8 + 1]; tc[i] = *(const u32x2*)(dC + (size_t)c * 65536); Ln[i] = Lc[i]; In[i] = Ic[i]; tn_[i] = tc[i]; }
    for (int cb = 0; cb < nck; cb += BT) {
        if (cb + BT < nck) {
#pragma unroll
            for (int i = 0; i < BT; ++i) { const int c = cb + BT + i < nck ? cb + BT + i : nck - 1; Ln[i] = cm[(size_t)c * 8]; In[i] = cm[(size_t)c * 8 + 1]; tn_[i] = *(const u32x2*)(dC + (size_t)c * 65536); }
        }
#pragma unroll
        for (int i = 0; i < BT; ++i) {
            const int c = cb + i;
            if (c < nck) {
                const float L = Lc[i], I = Ic[i], mnew = fmaxf(mpv + L, I), decay = expf(L + mpv - mnew);
                const u32x2 t = tc[i];
                u32x2 o; o[0] = pkbf(C[0], C[1]); o[1] = pkbf(C[2], C[3]);
                *(u32x2*)(cp + (size_t)c * 65536) = o;
                C[0] = decay * C[0] + __uint_as_float(t[0] << 16); C[1] = decay * C[1] + __uint_as_float(t[0] & 0xffff0000u);
                C[2] = decay * C[2] + __uint_as_float(t[1] << 16); C[3] = decay * C[3] + __uint_as_float(t[1] & 0xffff0000u);
                if (don) { const f32x4 tn = *(const f32x4*)(dn + (size_t)c * 512); *(f32x4*)(np_ + (size_t)c * 512) = (f32x4){n[0], n[1], n[2], n[3]};
#pragma unroll
                    for (int e = 0; e < 4; ++e) n[e] = decay * n[e] + tn[e]; }
                mpv = mnew;
            }
        }
#pragma unroll
        for (int i = 0; i < BT; ++i) { Lc[i] = Ln[i]; Ic[i] = In[i]; tc[i] = tn_[i]; }
    }
    float* oC = path ? p.o_Cs : p.o_Cp; float* on = path ? p.o_ns : p.o_np;
#pragma unroll
    for (int e = 0; e < 4; ++e) oC[(((size_t)b * 4 + h) * 128 + dq * 4 + e) * 128 + v] = C[e];
    if (don) *(f32x4*)(on + ((size_t)b * 4 + h) * 128 + dq * 4) = (f32x4){n[0], n[1], n[2], n[3]};
}

constexpr int NCH_P = SEQ / 16, NCH_S = PAST / 16;
constexpr int CROWS_P = BATCH * 2 * NCH_P, CROWS_S = DB * 2 * NCH_S;
static_assert(CROWS_P % 256 == 0 && CROWS_S % 256 == 0 && NCH_P == NCPAD && NCH_S == NCSPAD, "compression GEMM shapes");
DEV void b_cmp_const(const P& p, long gid) {
    const int e = (int)(gid % 128), tensor = (int)(gid / 128);
    float acc = p.cmp_b1[tensor * 128 + e];
    for (int k = 0; k < 2048; ++k) acc += p.cmp_pos[tensor * 2048 + k] * p.cmp_w1[((size_t)tensor * 2048 + k) * 128 + e];
    p.cmpc[gid] = acc;
}
DEV void b_w2t(const P& p, long gid) {
    const int e = (int)(gid % 128), d = (int)((gid / 128) % 64), tensor = (int)(gid / 8192);
    p.w2t[gid] = to_act(p.cmp_w2[((size_t)tensor * 128 + e) * 64 + d]);
}
DEV void cmpA_store(act_t* dst, const float* src) {
    typedef float f32x4 __attribute__((ext_vector_type(4))); typedef unsigned u32x4 __attribute__((ext_vector_type(4)));
    const f32x4 a = *(const f32x4*)src, b = *(const f32x4*)(src + 4);
    u32x4 o; o[0] = pkbf(a[0], a[1]); o[1] = pkbf(a[2], a[3]);
    o[2] = pkbf(b[0], b[1]); o[3] = pkbf(b[2], b[3]);
    *(u32x4*)dst = o;
}
DEV void b_cmpA_s(const P& p, long gid) {
    const int q = (int)(gid % 128), cidx = (int)((gid / 128) % NCH_S), h = (int)((gid / (128L * NCH_S)) % 2), b = (int)((gid / (256L * NCH_S)) % DB), tensor = (int)(gid / (256L * NCH_S * DB));
    const int T = 16 * cidx + (q >> 3);
    const float* src = p.cache_kv + ((((size_t)p.page_table[b * NPAGES + T / PAGE] * PAGE + T % PAGE) * 4 + tensor) * 128) + h * 64 + (q & 7) * 8;
    cmpA_store(p.cas + ((size_t)tensor * CROWS_S + (size_t)(b * 2 + h) * NCH_S + cidx) * 1024 + q * 8, src);
}
DEV void b_cmpA_p(const P& p, long gid) {
    const int q = (int)(gid % 128), cidx = (int)((gid / 128) % NCH_P), h = (int)((gid / (128L * NCH_P)) % 2), b = (int)((gid / (256L * NCH_P)) % BATCH), tensor = (int)(gid / (256L * NCH_P * BATCH));
    const int T = 16 * cidx + (q >> 3);
#ifdef CPU_EMU
    const float* src = p.proj + (size_t)(b * SEQ + T) * PROJ + C_KVP + tensor * 128 + h * 64 + (q & 7) * 8;
    cmpA_store(p.cap + ((size_t)tensor * CROWS_P + (size_t)(b * 2 + h) * NCH_P + cidx) * 1024 + q * 8, src);
#else
    typedef unsigned u32x4 __attribute__((ext_vector_type(4)));
    *(u32x4*)(p.cap + ((size_t)tensor * CROWS_P + (size_t)(b * 2 + h) * NCH_P + cidx) * 1024 + q * 8) = *(const u32x4*)(p.kvb + (size_t)(b * SEQ + T) * 512 + tensor * 128 + h * 64 + (q & 7) * 8);
#endif
}

DEV void g_out_winp(const P& p, long gid) {
    typedef float f32x4 __attribute__((ext_vector_type(4)));
    const int c = (int)(gid % 64) * 4, r = (int)((gid / 64) % WBP), b = (int)(gid / (64 * WBP));
    *(f32x4*)(p.o_winp + gid * 4) = *(const f32x4*)(p.kvwf + (size_t)(b * SEQ + SEQ - WBP + r) * 256 + c);
}
DEV void g_out_wins(const P& p, long gid) {
    typedef float f32x4 __attribute__((ext_vector_type(4)));
    const int c = (int)(gid % 64) * 4, r = (int)((gid / 64) % WBS), b = (int)(gid / (64 * WBS));
    const int pr = DS + r;
    *(f32x4*)(p.o_wins + gid * 4) = pr < WBS ? *(const f32x4*)(p.cache_win + ((size_t)b * WBS + pr) * 256 + c) : *(const f32x4*)(p.kvwf + (size_t)(TOKP + b * DS + pr - WBS) * 256 + c);
}
DEV void g_out_conv(const P& p, long gid) {
    const int c = (int)(gid % 1024), j = (int)((gid / 1024) % 3), sq = (int)(gid / 3072);
    (void)c; (void)j; (void)sq;
}
DEV void b_cmp_attn_s(const P& p, long gid) { b_cmp_attn(p, (gid / TOKS) * TOK + TOKP + gid % TOKS); }
DEV void b_imp_s(const P& p, long gid) { b_imp(p, (long)TOKP * 2 * NSB_MAX + gid); }
DEV void b_topk_s(const P& p, long gid) { b_topk(p, (long)TOKP * 2 + gid); }
DEV void b_sel_win_s(const P& p, long gid) { b_sel_win(p, (gid / TOKS) * TOK + TOKP + gid % TOKS); }

#ifndef CPU_EMU
#define XB_TMO      128
#define XB_XCNT(j)  (256  + 64 * (j))
#define XB_XSUB(j)  (1280 + 64 * (j))
#define XB_XGEN(j)  (2304 + 64 * (j))
#define XB_TOP      3328
#define XB_TOPGEN   3392
#define XCD_BAR_WORDS 3456
constexpr int CMPS_CNT_WORD = 3584, WS_ZERO_BYTES = 16384;
#define XB_SPIN_CAP (1u << 22)
#define LAS __attribute__((address_space(3)))
__device__ __forceinline__ unsigned xb_ld(unsigned* p)              { return __hip_atomic_load(p, __ATOMIC_RELAXED, __HIP_MEMORY_SCOPE_AGENT); }
__device__ __forceinline__ unsigned xb_add(unsigned* p, unsigned v) { return __hip_atomic_fetch_add(p, v, __ATOMIC_RELAXED, __HIP_MEMORY_SCOPE_AGENT); }
__device__ __forceinline__ unsigned xb_xcc_id() { return (unsigned)__builtin_amdgcn_s_getreg((3 << 11) | 20) & 0xFu; }
#define XB_SPIN(cond, bar) do { unsigned _sp = 0; while (cond) { __builtin_amdgcn_s_sleep(1); \
    if ((++_sp & 255u) == 0u) { if (xb_ld(&(bar)[XB_TMO])) break; if (_sp > XB_SPIN_CAP) { atomicAdd(&(bar)[XB_TMO], 1u); break; } } } } while (0)
struct XcdBarrier { unsigned* bar; unsigned x; volatile LAS unsigned* st; };
__device__ __forceinline__ XcdBarrier xcd_barrier_post(unsigned* bar, volatile LAS unsigned* st) {
    XcdBarrier b; b.bar = bar; b.x = xb_xcc_id(); b.st = st;
    if (threadIdx.x == 0) (void)xb_add(&bar[XB_XCNT(b.x)], 1u);
    return b;
}
__device__ __forceinline__ void xcd_barrier_complete(unsigned* bar, unsigned x, unsigned& nloc, unsigned& nx) {
    const unsigned G = gridDim.x * gridDim.y * gridDim.z;
    unsigned sum, cnt, mine, sp = 0u;
    for (;;) {
        sum = 0u; cnt = 0u; mine = 0u;
#pragma unroll
        for (unsigned j = 0; j < 16; ++j) { const unsigned c = xb_ld(&bar[XB_XCNT(j)]); sum += c; cnt += (c > 0u) ? 1u : 0u; mine = (j == x) ? c : mine; }
        if (sum == G) break;
        __builtin_amdgcn_s_sleep(1);
        if ((++sp & 255u) == 0u) { if (xb_ld(&bar[XB_TMO])) break; if (sp > XB_SPIN_CAP) { atomicAdd(&bar[XB_TMO], 1u); break; } }
    }
    nloc = mine > 0u ? mine : 1u; nx = cnt > 0u ? cnt : 1u;
}
__device__ __forceinline__ void xcd_barrier(const XcdBarrier& b) {
    asm volatile("s_waitcnt vmcnt(0)" ::: "memory");
    __syncthreads();
    if (threadIdx.x == 0) {
        unsigned* bar = b.bar;
        __builtin_amdgcn_s_waitcnt(0);
        unsigned nloc = b.st[0], nx = b.st[1];
        if (nloc == 0u) { xcd_barrier_complete(bar, b.x, nloc, nx); b.st[0] = nloc; b.st[1] = nx; }
        const unsigned old = xb_add(&bar[XB_XSUB(b.x)], 1u);
        const unsigned gen = old / nloc;
        if (old + 1u == (gen + 1u) * nloc) {
            __builtin_amdgcn_fence(__ATOMIC_RELEASE, "agent");
            asm volatile("s_waitcnt vmcnt(0)" ::: "memory");
            const unsigned og = xb_add(&bar[XB_TOP], 1u);
            const unsigned tg = og / nx;
            if (og + 1u == (tg + 1u) * nx) xb_add(&bar[XB_TOPGEN], 1u);
            else XB_SPIN(xb_ld(&bar[XB_TOPGEN]) == tg, bar);
            __builtin_amdgcn_fence(__ATOMIC_ACQUIRE, "agent");
            xb_add(&bar[XB_XGEN(b.x)], 1u);
            asm volatile("s_waitcnt vmcnt(0)" ::: "memory");
        } else {
            XB_SPIN(xb_ld(&bar[XB_XGEN(b.x)]) == gen, bar);
            __builtin_amdgcn_fence(__ATOMIC_ACQUIRE, "agent");
            asm volatile("s_waitcnt vmcnt(0)" ::: "memory");
        }
    }
    __syncthreads();
}

DEV int fresh_tid() { int t = threadIdx.x; asm volatile("" : "+v"(t)); return t; }
namespace pg8 {
#define PG8_LAS __attribute__((address_space(3)))
typedef unsigned short bf16_t;
typedef short bf16x8 __attribute__((ext_vector_type(8)));
typedef float f32x4 __attribute__((ext_vector_type(4)));
constexpr int BM = 256, BK = 64, HALF = 128, HTB = HALF * BK * 2, STAGE_BYTES = 8 * HTB, NXCD = 8, WGM = 8;
__host__ __device__ __forceinline__ int lds_byte(int r, int c) { const int st = (r >> 4) * 2 + (c >> 5), rr = r & 15, cc = c & 31, ob = rr * 64 + cc * 2; return st * 1024 + (ob ^ (((ob >> 9) & 1) << 5)); }
__host__ __device__ __forceinline__ void stage_rc(int b, int& R, int& C) { const int st = b / 1024, sb = b % 1024, swz = sb ^ (((sb >> 9) & 1) << 5); R = (st >> 1) * 16 + swz / 64; C = (st & 1) * 32 + (swz % 64) / 2; }
__host__ __device__ __forceinline__ int perm32(int rho) { const int n = rho >> 4, i = rho & 15; return 8 * (i >> 2) + 4 * n + (i & 3); }
struct Unit { int pm, pn; };
struct Gemm { const bf16_t* A; const bf16_t* Bt; int M, N, K; int ld = 0; };
struct StaticOrder {
    int nM, nN, nwg, G, c;
    __host__ __device__ void init(int M, int N, int G_, int c_) { nM = M / BM; nN = N / BM; nwg = nM * nN; G = G_; c = c_; }
    __host__ __device__ bool next(int i, Unit& u) const {
        const long L = (long)i * G + c; if (L >= nwg) return false;
        int wgid = (int)L; { const int q = nwg / NXCD, r = nwg % NXCD, xcd = wgid % NXCD, off = wgid / NXCD; wgid = (xcd < r ? xcd * (q + 1) : r * (q + 1) + (xcd - r) * q) + off; }
        const int nig = WGM * nN, gid = wgid / nig, fm = gid * WGM, gsz = (nM - fm) < WGM ? (nM - fm) : WGM;
        u.pm = fm + ((wgid % nig) % gsz); u.pn = (wgid % nig) / gsz; return true;
    }
    __device__ __forceinline__ void a_ready(const Unit&) const {}
    __device__ __forceinline__ void done(const Unit&) const {}
};
struct EpiF32 {
    static constexpr bool PERM = false, AFTER_DRAIN = false;
    float* C; int ldc; const float* bias; int ncols;
    __device__ __forceinline__ void operator()(const f32x4 (&acc)[2][2][4][2], const Unit& u, int wr, int wc, int fr, int fq) const {
        const int row0 = u.pm * BM + wr * 64 + fr, col0 = u.pn * BM + wc * 32 + 4 * fq;
        f32x4 bv[2][2];
#pragma unroll
        for (int bj = 0; bj < 2; ++bj)
#pragma unroll
            for (int n = 0; n < 2; ++n) { const int c = col0 + bj * HALF + n * 16; bv[bj][n] = (bias && c < ncols) ? *(const f32x4*)(bias + c) : (f32x4){0.f, 0.f, 0.f, 0.f}; }
#pragma unroll
        for (int ai = 0; ai < 2; ++ai)
#pragma unroll
            for (int m = 0; m < 4; ++m) { float* rowp = C + (size_t)(row0 + ai * HALF + m * 16) * ldc + col0;
#pragma unroll
                for (int bj = 0; bj < 2; ++bj)
#pragma unroll
                    for (int n = 0; n < 2; ++n) if (col0 + bj * HALF + n * 16 < ncols) *(f32x4*)(rowp + bj * HALF + n * 16) = acc[ai][bj][m][n] + bv[bj][n]; }
    }
};
__host__ __device__ __forceinline__ int remap_in(int n) { return n < 1280 ? n : n < 1304 ? n + 2048 : n < 2840 ? n - 24 : n < 2848 ? n + 512 : n - 32; }
struct EpiProj {
    static constexpr bool PERM = true, AFTER_DRAIN = false;
    const float* bias; bf16_t *qb, *kvb, *kwb, *mqkb, *mvb, *mob; float *okvp, *okvs, *kvwf, *gatef, *mif, *oconvp, *oconvs; float qscale;
    __device__ __forceinline__ static void st8b(bf16_t* d, f32x4 a, f32x4 b) { typedef unsigned u32x4 __attribute__((ext_vector_type(4))); u32x4 o;
        o[0] = pkbf(a[0], a[1]); o[1] = pkbf(a[2], a[3]);
        o[2] = pkbf(b[0], b[1]); o[3] = pkbf(b[2], b[3]); *(u32x4*)d = o; }
    __device__ __forceinline__ static void st8f(float* d, f32x4 a, f32x4 b) { *(f32x4*)d = a; *(f32x4*)(d + 4) = b; }
    __device__ __forceinline__ void operator()(const f32x4 (&acc)[2][2][4][2], const Unit& u, int wr, int wc, int fr, int fq) const {
        static_assert(TOKP % BM == 0 && SEQ % BM == 0 && WBP % BM == 0 && WBP >= 3, "EpiProj panel tests");
        const unsigned row0 = (unsigned)(u.pm * BM + wr * 64 + fr); const int cl = wc * 32 + 8 * fq, pn = u.pn;
        const bool sp = u.pm * BM >= TOKP, winp = sp || ((u.pm * BM) % SEQ) >= SEQ - WBP, convp = sp || ((u.pm * BM) % SEQ) == SEQ - BM;
#define EP_LOOP(BJ, DELTA, ...) { const int c = pn * BM + (BJ) * HALF + cl; const f32x4 b0 = *(const f32x4*)(bias + c + (DELTA)), b1 = *(const f32x4*)(bias + c + (DELTA) + 4); \
        _Pragma("unroll") for (int ai = 0; ai < 2; ++ai) _Pragma("unroll") for (int m = 0; m < 4; ++m) { const unsigned r = row0 + ai * HALF + m * 16; const f32x4 v0 = acc[ai][BJ][m][0] + b0, v1 = acc[ai][BJ][m][1] + b1; __VA_ARGS__ } }
        if (pn < 2) {
            EP_LOOP(0, 0, st8b(qb + (size_t)r * 512 + c, v0 * qscale, v1 * qscale);) EP_LOOP(1, 0, st8b(qb + (size_t)r * 512 + c, v0 * qscale, v1 * qscale);)
        } else if (pn < 4) {
            float* okv = sp ? okvs - (size_t)TOKP * 512 : okvp;
            const bool hb0 = !sp, hb1 = !sp && pn == 2;
            EP_LOOP(0, 0, st8f(okv + (size_t)r * 512 + (c - 512), v0, v1); if (hb0) st8b(kvb + (size_t)r * 512 + (c - 512), v0, v1);)
            EP_LOOP(1, 0, st8f(okv + (size_t)r * 512 + (c - 512), v0, v1); if (hb1) st8b(kvb + (size_t)r * 512 + (c - 512), v0, v1);)
        } else if (pn == 4) {
            EP_LOOP(0, 0, if (!sp) st8b(kwb + (size_t)r * 256 + (c - 1024), v0, v1); if (winp) st8f(kvwf + (size_t)r * 256 + (c - 1024), v0, v1);)
            EP_LOOP(1, 0, st8f(kvwf + (size_t)r * 256 + (c - 1024), v0, v1);)
        } else if (pn < 9) {
#define EP_MQK(BJ) EP_LOOP(BJ, 24, st8b(mqkb + (size_t)r * 1024 + (c - 1280), v0, v1); \
            if (convp) { const int ri = (int)r; const int len = sp ? DS : SEQ, loc = sp ? (ri - TOKP) % DS : ri % SEQ, sq = sp ? (ri - TOKP) / DS : ri / SEQ;     \
                if (loc >= len - 3) st8f((sp ? oconvs : oconvp) + ((size_t)sq * 3 + (loc - (len - 3))) * 1024 + (c - 1280), v0, v1); })
            EP_MQK(0) EP_MQK(1)
#undef EP_MQK
        } else if (pn < 11) {
            EP_LOOP(0, 24, st8b(mvb + (size_t)r * 512 + (c - 2304), v0, v1);) EP_LOOP(1, 24, st8b(mvb + (size_t)r * 512 + (c - 2304), v0, v1);)
        } else if (pn < 13) {
            EP_LOOP(0, 32, st8b(mob + (size_t)r * 512 + (c - 2816), v0, v1);) EP_LOOP(1, 32, st8b(mob + (size_t)r * 512 + (c - 2816), v0, v1);)
        } else if (wc == 0) {
            const int dl = fq < 3 ? -2048 : -512;
            EP_LOOP(0, dl, st8f(fq < 3 ? gatef + (size_t)r * 32 + (c - 3328) : mif + (size_t)r * 8, v0, v1);)
        }
#undef EP_LOOP
    }
};
struct EpiB16 {
    static constexpr bool PERM = true, AFTER_DRAIN = false;
    bf16_t* O; int ldo;
    __device__ __forceinline__ void operator()(const f32x4 (&acc)[2][2][4][2], const Unit& u, int wr, int wc, int fr, int fq) const {
        const int row0 = u.pm * BM + wr * 64 + fr, col0 = u.pn * BM + wc * 32 + 8 * fq;
#pragma unroll
        for (int ai = 0; ai < 2; ++ai)
#pragma unroll
            for (int m = 0; m < 4; ++m) { bf16_t* rowp = O + (size_t)(row0 + ai * HALF + m * 16) * ldo + col0;
#pragma unroll
                for (int bj = 0; bj < 2; ++bj) { const f32x4 a = acc[ai][bj][m][0], b = acc[ai][bj][m][1]; typedef unsigned u32x4 __attribute__((ext_vector_type(4))); u32x4 o;
                    o[0] = pkbf(a[0], a[1]); o[1] = pkbf(a[2], a[3]);
                    o[2] = pkbf(b[0], b[1]); o[3] = pkbf(b[2], b[3]);
                    *(u32x4*)(rowp + bj * HALF) = o; }
            }
    }
};
struct EpiSwiglu {
    static constexpr bool PERM = true, AFTER_DRAIN = false;
    bf16_t* O; int ldo;
    __device__ __forceinline__ void operator()(const f32x4 (&acc)[2][2][4][2], const Unit& u, int wr, int wc, int fr, int fq) const {
        const int row0 = u.pm * BM + wr * 64 + fr, col0 = u.pn * HALF + wc * 32 + 8 * fq;
#pragma unroll
        for (int ai = 0; ai < 2; ++ai)
#pragma unroll
            for (int m = 0; m < 4; ++m) {
                float a[8];
#pragma unroll
                for (int n = 0; n < 2; ++n)
#pragma unroll
                    for (int e = 0; e < 4; ++e) { const float g = acc[ai][0][m][n][e]; a[4 * n + e] = g * fsigmoid_(g) * acc[ai][1][m][n][e]; }
                typedef unsigned u32x4 __attribute__((ext_vector_type(4))); u32x4 o;
#pragma unroll
                for (int e = 0; e < 4; ++e) o[e] = pkbf(a[2 * e], a[2 * e + 1]);
                *(u32x4*)(O + (size_t)(row0 + ai * HALF + m * 16) * ldo + col0) = o;
            }
    }
};
template <class Epi, class Sched>
__device__ __forceinline__ void gemm_phase(PG8_LAS unsigned char* lds, const Gemm g, const Sched& S, const Epi& E) {
    const int tid = fresh_tid(), wid = __builtin_amdgcn_readfirstlane(tid >> 6), lane = tid & 63, wr = wid >> 2, wc = wid & 3, fr = lane & 15, fq = lane >> 4;
    const int K = g.K, nt = K / BK, ld = g.ld ? g.ld : K;
    unsigned voffA[2], voffB[2];
#pragma unroll
    for (int i = 0; i < 2; ++i) { int R, C; stage_rc(tid * 16 + i * 8192, R, C); const int Rb = Epi::PERM ? ((R & ~31) + perm32(R & 31)) : R;
        voffA[i] = (unsigned)(R * ld + C) * 2u; voffB[i] = (unsigned)(Rb * ld + C) * 2u; }
    const size_t kstep = (size_t)(BK * 2);
    const size_t hstep = (size_t)HALF * ld * 2;
    const size_t tstep = 2 * hstep;
    const unsigned ldsw = (unsigned)wid * 1024u;
    const int aoff = lds_byte(wr * 64 + fr, fq * 8), boff = lds_byte(wc * 32 + fr, fq * 8);
#define PG8_SA(b, h) (((b) * 2 + (h)) * HTB)
#define PG8_SB(b, h) ((4 + (b) * 2 + (h)) * HTB)
#define PG8_STAGE(bufoff, gbase, voff) do { _Pragma("unroll") for (int _i = 0; _i < 2; ++_i) \
        __builtin_amdgcn_global_load_lds((const unsigned*)((const char*)(gbase) + (voff)[_i]), (PG8_LAS unsigned*)(lds + (bufoff) + ldsw + _i * 8192), 16, 0, 0); } while (0)
#define PG8_LDA(dst, b, h) do { _Pragma("unroll") for (int m = 0; m < 4; ++m) _Pragma("unroll") for (int k = 0; k < 2; ++k) dst[m][k] = *(const PG8_LAS bf16x8*)(lds + PG8_SA(b, h) + aoff + m * 2048 + k * 1024); } while (0)
#define PG8_LDB(dst, b, h) do { _Pragma("unroll") for (int n = 0; n < 2; ++n) _Pragma("unroll") for (int k = 0; k < 2; ++k) dst[n][k] = *(const PG8_LAS bf16x8*)(lds + PG8_SB(b, h) + boff + n * 2048 + k * 1024); } while (0)
#define PG8_MMA(ai, bj, At, Bt) do { __builtin_amdgcn_s_setprio(1); _Pragma("unroll") for (int m = 0; m < 4; ++m) _Pragma("unroll") for (int n = 0; n < 2; ++n) _Pragma("unroll") for (int k = 0; k < 2; ++k) \
        acc[ai][bj][m][n] = __builtin_amdgcn_mfma_f32_16x16x32_bf16(Bt[n][k], At[m][k], acc[ai][bj][m][n], 0, 0, 0); __builtin_amdgcn_s_setprio(0); } while (0)
#define PG8_WAIT_V(n) asm volatile("s_waitcnt vmcnt(" #n ")" ::: "memory")
#define PG8_WAIT_L(n) asm volatile("s_waitcnt lgkmcnt(" #n ")" ::: "memory")
#define PG8_BAR __builtin_amdgcn_s_barrier()
#define PG8_SCHED __builtin_amdgcn_sched_barrier(0)
    Unit cur, nxt; int ui = 0;
    if (!S.next(0, cur)) return;
    f32x4 acc[2][2][4][2];
#pragma unroll
    for (int a = 0; a < 2; ++a)
#pragma unroll
        for (int b = 0; b < 2; ++b)
#pragma unroll
            for (int m = 0; m < 4; ++m)
#pragma unroll
                for (int n = 0; n < 2; ++n) acc[a][b][m][n] = (f32x4){0.f, 0.f, 0.f, 0.f};
    bf16x8 At[4][2], B0[2][2], B1[2][2];
    const char* cA = (const char*)g.A + (size_t)cur.pm * tstep; const char* cB = (const char*)g.Bt + (size_t)cur.pn * tstep;
    S.a_ready(cur);
    PG8_STAGE(PG8_SB(0, 0), cB, voffB); PG8_STAGE(PG8_SA(0, 0), cA, voffA); PG8_STAGE(PG8_SB(0, 1), cB + hstep, voffB); PG8_STAGE(PG8_SA(0, 1), cA + hstep, voffA);
    if (wr == 1) PG8_BAR;
    PG8_WAIT_V(4); PG8_BAR;
    PG8_STAGE(PG8_SB(1, 0), cB + kstep, voffB); PG8_STAGE(PG8_SA(1, 0), cA + kstep, voffA); PG8_STAGE(PG8_SB(1, 1), cB + hstep + kstep, voffB);
    PG8_WAIT_V(6); PG8_BAR;
    for (;;) {
        const bool has_next = S.next(ui + 1, nxt);
        const char* nA = has_next ? (const char*)g.A + (size_t)nxt.pm * tstep : cA; const char* nB = has_next ? (const char*)g.Bt + (size_t)nxt.pn * tstep : cB;
        for (int t = 0; t < nt; t += 2) {
            const bool last = (t == nt - 2);
            const char* a1 = cA + (size_t)(t + 1) * kstep;
            const char* a2 = last ? nA : cA + (size_t)(t + 2) * kstep; const char* b2 = last ? nB : cB + (size_t)(t + 2) * kstep;
            const char* a3 = a2 + kstep; const char* b3 = b2 + kstep;
            if (last && has_next) S.a_ready(nxt);
            PG8_LDB(B0, 0, 0); PG8_SCHED; PG8_LDA(At, 0, 0); PG8_STAGE(PG8_SA(1, 1), a1 + hstep, voffA);
            PG8_WAIT_L(8); PG8_BAR; PG8_WAIT_L(0); PG8_MMA(0, 0, At, B0); PG8_BAR; PG8_SCHED;
            PG8_LDB(B1, 0, 1); PG8_STAGE(PG8_SB(0, 0), b2, voffB);
            PG8_BAR; PG8_WAIT_L(0); PG8_MMA(0, 1, At, B1); PG8_BAR;
            PG8_LDA(At, 0, 1); PG8_STAGE(PG8_SA(0, 0), a2, voffA);
            PG8_BAR; PG8_WAIT_L(0); PG8_MMA(1, 0, At, B0); PG8_BAR; PG8_SCHED;
            PG8_STAGE(PG8_SB(0, 1), b2 + hstep, voffB);
            PG8_WAIT_V(6); PG8_BAR; PG8_MMA(1, 1, At, B1); PG8_BAR;
            PG8_LDB(B0, 1, 0); PG8_SCHED; PG8_LDA(At, 1, 0); PG8_STAGE(PG8_SA(0, 1), a2 + hstep, voffA);
            PG8_WAIT_L(8); PG8_BAR; PG8_WAIT_L(0); PG8_MMA(0, 0, At, B0); PG8_BAR; PG8_SCHED;
            PG8_LDB(B1, 1, 1); PG8_STAGE(PG8_SB(1, 0), b3, voffB);
            PG8_BAR; PG8_WAIT_L(0); PG8_MMA(0, 1, At, B1); PG8_BAR;
            PG8_LDA(At, 1, 1); PG8_STAGE(PG8_SA(1, 0), a3, voffA);
            PG8_BAR; PG8_WAIT_L(0); PG8_MMA(1, 0, At, B0); PG8_BAR; PG8_SCHED;
            PG8_STAGE(PG8_SB(1, 1), b3 + hstep, voffB);
            PG8_WAIT_V(6); PG8_BAR; PG8_MMA(1, 1, At, B1); PG8_BAR;
        }
        E(acc, cur, wr, wc, fr, fq); S.done(cur);
        if (!has_next) break;
#pragma unroll
        for (int a = 0; a < 2; ++a)
#pragma unroll
            for (int b = 0; b < 2; ++b)
#pragma unroll
                for (int m = 0; m < 4; ++m)
#pragma unroll
                    for (int n = 0; n < 2; ++n) acc[a][b][m][n] = (f32x4){0.f, 0.f, 0.f, 0.f};
        cur = nxt; cA = nA; cB = nB; ++ui;
    }
    PG8_WAIT_V(0);
    if (wr == 0) PG8_BAR;
    PG8_BAR;
#undef PG8_SA
#undef PG8_SB
#undef PG8_STAGE
#undef PG8_LDA
#undef PG8_LDB
#undef PG8_MMA
#undef PG8_WAIT_V
#undef PG8_WAIT_L
#undef PG8_BAR
#undef PG8_SCHED
}
}


constexpr int NTHR_ = 512;
namespace att {
typedef short bf16x8 __attribute__((ext_vector_type(8)));
typedef float f32x16 __attribute__((ext_vector_type(16)));
typedef __bf16 bf16v2 __attribute__((ext_vector_type(2)));
typedef float f32v2 __attribute__((ext_vector_type(2)));
constexpr int PADF = 64, TS = PADF + 1024, TW = PADF + 512 + 64;
constexpr int IMPS = 129;
constexpr int L_TAB = 0, L_TABW = 17408, L_IMP = 27648, L_MASK = 60672, L_K = 61696, L_V = 78080, L_ML = 94464;
#define MFMA32(a, b, c) __builtin_amdgcn_mfma_f32_32x32x16_bf16((a), (b), (c), 0, 0, 0)
DEV unsigned pk2(float lo, float hi) { f32v2 v = {lo, hi}; bf16v2 r = __builtin_convertvector(v, bf16v2); return __builtin_bit_cast(unsigned, r); }
DEV bf16x8 pack8(const f32x16& x, int s) {
    typedef unsigned u32x4 __attribute__((ext_vector_type(4)));
    u32x4 q; q[0] = pk2(x[8 * s], x[8 * s + 1]); q[1] = pk2(x[8 * s + 2], x[8 * s + 3]); q[2] = pk2(x[8 * s + 4], x[8 * s + 5]); q[3] = pk2(x[8 * s + 6], x[8 * s + 7]);
    return __builtin_bit_cast(bf16x8, q);
}
DEV float xmax32(float x) { const auto r = __builtin_amdgcn_permlane32_swap(__float_as_uint(x), __float_as_uint(x), false, false); return fmaxf(__uint_as_float(r[0]), __uint_as_float(r[1])); }
constexpr float DEFER_THR = 8.0f;
struct Ctx {
    PG8_LAS unsigned char* lds; int tid, lane, l32, h, g, half, xr; int t, t0, tok; bf16x8 qf[4];
};
struct Acc { f32x16 o0, o1; float m, l; };
DEV void acc_init(Acc& a) {
#pragma unroll
    for (int i = 0; i < 16; ++i) { a.o0[i] = 0.f; a.o1[i] = 0.f; }
    a.m = -1e30f; a.l = 0.f;
}
typedef unsigned u32x4 __attribute__((ext_vector_type(4)));
DEV u32x4 tile_load(const act_t* base, size_t row_stride, int tid) { const int row = tid >> 3, ch = tid & 7; return *(const u32x4*)(base + (size_t)row * row_stride + ch * 8); }
DEV void tile_store(PG8_LAS unsigned char* buf, u32x4 v, int tid) { const int row = tid >> 3, ch = tid & 7; *(PG8_LAS u32x4*)(buf + row * 128 + ((ch ^ (row & 7)) << 4)) = v; }
DEV bf16x8 frag(const PG8_LAS unsigned char* buf, int row, int ch, int xr) { return *(const PG8_LAS bf16x8*)(buf + row * 128 + ((ch ^ xr) << 4)); }

template <int MODE>
DEV void attend(const Ctx& c, Acc& a, const act_t* Kb, size_t kstride, const act_t* Vtb, size_t vstride, int jlo, int jhi, int jd, unsigned m0, unsigned m1, unsigned m2, unsigned m3, float mfin, float invl) {
    PG8_LAS unsigned char* lds = c.lds;
    const PG8_LAS float* tab = (MODE == 3) ? (const PG8_LAS float*)(lds + L_TABW) + c.g * TW : (const PG8_LAS float*)(lds + L_TAB) + c.g * TS;
    u32x4 kreg = tile_load(Kb + (size_t)jlo * 64 * kstride, kstride, c.tid), vreg = {0u, 0u, 0u, 0u};
    if (MODE != 0) vreg = tile_load(Vtb + (size_t)jlo * 64, vstride, c.tid);
    tile_store(lds + L_K, kreg, c.tid); if (MODE != 0) tile_store(lds + L_V, vreg, c.tid);
    __syncthreads();
    int cur = 0;
    for (int j = jlo; j <= jhi; ++j) {
        const bool more = j < jhi;
        if (more) { kreg = tile_load(Kb + (size_t)(j + 1) * 64 * kstride, kstride, c.tid); if (MODE != 0) vreg = tile_load(Vtb + (size_t)(j + 1) * 64, vstride, c.tid); }
        const PG8_LAS unsigned char* kb = lds + L_K + cur * 8192; const PG8_LAS unsigned char* vb = lds + L_V + cur * 8192;
        f32x16 s0, s1;
#pragma unroll
        for (int i = 0; i < 16; ++i) { s0[i] = 0.f; s1[i] = 0.f; }
#pragma unroll
        for (int ks = 0; ks < 4; ++ks) { s0 = MFMA32(frag(kb, c.l32, 2 * ks + c.h, c.xr), c.qf[ks], s0); s1 = MFMA32(frag(kb, 32 + c.l32, 2 * ks + c.h, c.xr), c.qf[ks], s1); }
        bool sel = true;
        if (MODE == 2) { const unsigned w = (j < 32) ? m0 : (j < 64) ? m1 : (j < 96) ? m2 : m3; sel = (w >> (j & 31)) & 1u; }
        const bool far = (MODE == 2) ? (64 * j <= c.t0 - 853) : (MODE <= 1) ? (16 * (64 * j + 63) + 31 + 790 <= c.t0) : false;
        float cf = 0.f;
        if (far) cf = tab[PADF + 1023];
        else if (MODE >= 2) {
            const PG8_LAS float* tp = tab + (PADF + c.t - j * 64 - 4 * c.h);
            float tb[32];
#pragma unroll
            for (int i = 0; i < 32; ++i) tb[i] = tp[-((i >> 4) * 32 + (i & 3) + 8 * ((i & 15) >> 2))];
#pragma unroll
            for (int i = 0; i < 16; ++i) { s0[i] += tb[i]; s1[i] += tb[16 + i]; }
        } else {
#pragma unroll
            for (int kt = 0; kt < 2; ++kt)
#pragma unroll
                for (int i = 0; i < 16; ++i) {
                    const int kidx = j * 64 + kt * 32 + (i & 3) + 8 * (i >> 2) + 4 * c.h;
                    const int dist = c.t - 16 * kidx - 31;
                    const int ix = PADF + clampi3(dist, -1, 1023);
                    if (kt) s1[i] += tab[ix]; else s0[i] += tab[ix];
                }
        }
        if (MODE == 1) {
            const float mr = mfin - cf;
#pragma unroll
            for (int i = 0; i < 16; ++i) { s0[i] = __builtin_amdgcn_exp2f(s0[i] - mr) * invl; s1[i] = __builtin_amdgcn_exp2f(s1[i] - mr) * invl; }
            PG8_LAS float* imp = (PG8_LAS float*)(lds + L_IMP) + c.tok * IMPS;
#pragma unroll
            for (int kt = 0; kt < 2; ++kt)
#pragma unroll
                for (int i = 0; i < 4; ++i) {
                    const float p0 = kt ? s1[4 * i] : s0[4 * i], p1 = kt ? s1[4 * i + 1] : s0[4 * i + 1], p2 = kt ? s1[4 * i + 2] : s0[4 * i + 2], p3 = kt ? s1[4 * i + 3] : s0[4 * i + 3];
                    float gs = (p0 + p1) + (p2 + p3), ps = p3;
                    gs += __shfl_xor(gs, 8); ps += __shfl_xor(ps, 8); gs += __shfl_xor(gs, 16); ps += __shfl_xor(ps, 16);
                    const int jb = (j * 64 + kt * 32 + 8 * i + 4 * c.h) >> 2;
                    if (c.l32 < 8) { imp[jb] += gs; }
                    if (c.l32 < 8 && jb + 1 < 128) { imp[jb + 1] += ps; }
                }
        } else {
            float mx = s0[0];
#pragma unroll
            for (int i = 1; i < 16; ++i) mx = fmaxf(mx, s0[i]);
#pragma unroll
            for (int i = 0; i < 16; ++i) mx = fmaxf(mx, s1[i]);
            mx = xmax32(mx) + cf;
            if (MODE == 2 && !sel) mx = -INFINITY;
            const bool grow = mx > a.m + DEFER_THR;
            if (__any(grow)) {
                const float mn = grow ? mx : a.m, alpha = __builtin_amdgcn_exp2f(a.m - mn);
                a.m = mn; a.l *= alpha;
                if (MODE != 0) {
#pragma unroll
                    for (int i = 0; i < 16; ++i) { a.o0[i] *= alpha; a.o1[i] *= alpha; }
                }
            }
            const float mref = (MODE == 2 && !sel) ? 1e30f : a.m - cf;
            float ls = 0.f;
#pragma unroll
            for (int i = 0; i < 16; ++i) { s0[i] = __builtin_amdgcn_exp2f(s0[i] - mref); s1[i] = __builtin_amdgcn_exp2f(s1[i] - mref); ls += s0[i] + s1[i]; }
            a.l += ls;
        }
        if (MODE != 0) {
#pragma unroll
            for (int kt = 0; kt < 2; ++kt)
#pragma unroll
                for (int sp = 0; sp < 2; ++sp) {
                    const bf16x8 pf = pack8(kt ? s1 : s0, sp);
                    a.o0 = MFMA32(frag(vb, c.l32, kt * 4 + 2 * sp + c.h, c.xr), pf, a.o0);
                    a.o1 = MFMA32(frag(vb, 32 + c.l32, kt * 4 + 2 * sp + c.h, c.xr), pf, a.o1);
                }
        }
        if (more) { tile_store(lds + L_K + (cur ^ 1) * 8192, kreg, c.tid); if (MODE != 0) tile_store(lds + L_V + (cur ^ 1) * 8192, vreg, c.tid); }
        __syncthreads();
        cur ^= 1;
    }
}

DEV void topk_pair(PG8_LAS unsigned char* lds, int tokL, int jd, int lane) {
    const int hf = lane >> 5, l = lane & 31, tk = tokL + hf;
    const PG8_LAS float* imp = (const PG8_LAS float*)(lds + L_IMP) + tk * IMPS;
    PG8_LAS unsigned* mk = (PG8_LAS unsigned*)(lds + L_MASK) + tk * 4;
    const unsigned hsh = hf * 32;
    if (jd + 1 <= 16) { const unsigned bb = (unsigned)(__ballot(l <= jd) >> hsh); if (l == 0) { mk[0] = bb; mk[1] = 0u; mk[2] = 0u; mk[3] = 0u; } return; }
    unsigned v[4]; bool cd[4];
#pragma unroll
    for (int k = 0; k < 4; ++k) { const int j = l + 32 * k; cd[k] = j >= 1 && j < jd; v[k] = cd[k] ? __float_as_uint(imp[j]) : 0u; }
    const int K = 14; unsigned thr = 0u;
    for (int bit = 30; bit >= 0; --bit) {
        const unsigned cand = thr | (1u << bit); int cnt = 0;
#pragma unroll
        for (int k = 0; k < 4; ++k) cnt += __popc((unsigned)(__ballot(cd[k] && v[k] >= cand) >> hsh));
        if (cnt >= K) thr = cand;
    }
    int ngt = 0;
#pragma unroll
    for (int k = 0; k < 4; ++k) ngt += __popc((unsigned)(__ballot(cd[k] && v[k] > thr) >> hsh));
    const int need = K - ngt; const unsigned below = (1u << l) - 1u; int before = 0;
#pragma unroll
    for (int k = 0; k < 4; ++k) { const int j = l + 32 * k; const unsigned eq = (unsigned)(__ballot(cd[k] && v[k] == thr) >> hsh);
        const bool sl = (j == 0) || (j == jd) || (cd[k] && (v[k] > thr || (v[k] == thr && before + __popc(eq & below) < need)));
        before += __popc(eq);
        const unsigned bb = (unsigned)(__ballot(sl) >> hsh);
        if (l == 0) mk[k] = bb; }
}

DEV void topk_oct(PG8_LAS unsigned char* lds, int tok0, int jd, int lane) {
    const int hf = lane >> 5, l = lane & 31; const unsigned hsh = hf * 32;
    PG8_LAS unsigned* mk0 = (PG8_LAS unsigned*)(lds + L_MASK) + (tok0 + hf) * 4;
    if (jd + 1 <= 16) { const unsigned bb = (unsigned)(__ballot(l <= jd) >> hsh);
        if (l == 0) {
#pragma unroll
            for (int pr = 0; pr < 4; ++pr) { mk0[pr * 8] = bb; mk0[pr * 8 + 1] = 0u; mk0[pr * 8 + 2] = 0u; mk0[pr * 8 + 3] = 0u; } }
        return; }
    bool cd[4]; unsigned v[4][4];
#pragma unroll
    for (int k = 0; k < 4; ++k) { const int j = l + 32 * k; cd[k] = j >= 1 && j < jd; }
#pragma unroll
    for (int pr = 0; pr < 4; ++pr) { const PG8_LAS float* imp = (const PG8_LAS float*)(lds + L_IMP) + (tok0 + 2 * pr + hf) * IMPS;
#pragma unroll
        for (int k = 0; k < 4; ++k) v[pr][k] = cd[k] ? __float_as_uint(imp[l + 32 * k]) : 0u; }
    const int K = 14; unsigned thr[4] = {0u, 0u, 0u, 0u};
    for (int bit = 30; bit >= 0; --bit) {
#pragma unroll
        for (int pr = 0; pr < 4; ++pr) {
            const unsigned cand = thr[pr] | (1u << bit); int cnt = 0;
#pragma unroll
            for (int k = 0; k < 4; ++k) cnt += __popc((unsigned)(__ballot(cd[k] && v[pr][k] >= cand) >> hsh));
            if (cnt >= K) thr[pr] = cand;
        }
    }
#pragma unroll
    for (int pr = 0; pr < 4; ++pr) {
        int ngt = 0;
#pragma unroll
        for (int k = 0; k < 4; ++k) ngt += __popc((unsigned)(__ballot(cd[k] && v[pr][k] > thr[pr]) >> hsh));
        const int need = K - ngt; const unsigned below = (1u << l) - 1u; int before = 0;
#pragma unroll
        for (int k = 0; k < 4; ++k) { const int j = l + 32 * k; const unsigned eq = (unsigned)(__ballot(cd[k] && v[pr][k] == thr[pr]) >> hsh);
            const bool sl = (j == 0) || (j == jd) || (cd[k] && (v[pr][k] > thr[pr] || (v[pr][k] == thr[pr] && before + __popc(eq & below) < need)));
            before += __popc(eq);
            const unsigned bb = (unsigned)(__ballot(sl) >> hsh);
            if (l == 0) mk0[pr * 8 + k] = bb; }
    }
}

DEV void unit(const P& p, PG8_LAS unsigned char* lds, int b, int kvh, int tile, bool build_tab) {
    Ctx c; c.lds = lds; c.tid = fresh_tid(); c.lane = c.tid & 63; c.l32 = c.lane & 31; c.h = c.lane >> 5; c.xr = c.l32 & 7;
    const int wid = __builtin_amdgcn_readfirstlane(c.tid >> 6); c.g = wid & 3; c.half = wid >> 2;
    c.t0 = tile * 64; c.t = c.t0 + c.half * 32 + c.l32;
    const int head = kvh * 4 + c.g, jd = tile; const size_t row = (size_t)b * SEQ + c.t;
#pragma unroll
    for (int s = 0; s < 4; ++s) c.qf[s] = *(const bf16x8*)(p.qb + row * 512 + head * 64 + 16 * s + 8 * c.h);
    const float g0 = sigmoidf_(p.gatef[row * 32 + head * 3]), g1 = sigmoidf_(p.gatef[row * 32 + head * 3 + 1]), g2 = sigmoidf_(p.gatef[row * 32 + head * 3 + 2]);
    __syncthreads();
    if (build_tab) {
    for (int i = c.tid; i < 4 * TS; i += NTHR_) { const int gg = i / TS, dd = i % TS - PADF; ((PG8_LAS float*)(lds + L_TAB))[i] = dd < 0 ? -INFINITY : p.rel_bias[rel_bucket(dd) * 8 + kvh * 4 + gg] * LOG2E; }
    for (int i = c.tid; i < 4 * TW; i += NTHR_) { const int gg = i / TW, dd = i % TW - PADF; ((PG8_LAS float*)(lds + L_TABW))[i] = (dd < 0 || dd >= 512) ? -INFINITY : p.rel_bias[rel_bucket(dd) * 8 + kvh * 4 + gg] * LOG2E; }
    }
    for (int i = c.tid; i < 64 * IMPS; i += NTHR_) ((PG8_LAS float*)(lds + L_IMP))[i] = 0.f;
    __syncthreads();
    const size_t bh = (size_t)b * 2 + kvh;
    const act_t* Kc = p.kc + bh * NCPAD * 64; const act_t* Vct = p.vct + bh * 64 * NCPAD;
    const act_t* Ks = p.kvb + (size_t)b * SEQ * 512 + 256 + kvh * 64; const act_t* Vst = p.vst + bh * 64 * SEQ;
    const act_t* Kw = p.kwb + (size_t)b * SEQ * 256 + kvh * 64;       const act_t* Vwt = p.vwt + bh * 64 * SEQ;
    const int cjhi = ((c.t0 + 32) / 16) / 64;
    c.tok = c.half * 32 + c.l32;
    Acc a; acc_init(a);
    attend<0>(c, a, Kc, 64, Vct, NCPAD, 0, cjhi, jd, 0, 0, 0, 0, 0.f, 0.f);
    {
        const float lt0 = a.l + __shfl_xor(a.l, 32);
        PG8_LAS float* ml = (PG8_LAS float*)(lds + L_ML);
        if (c.h == 0) { ml[(c.tok * 4 + c.g) * 2] = a.m; ml[(c.tok * 4 + c.g) * 2 + 1] = lt0 > 0.f ? 1.0f / lt0 : 0.f; }
    }
    __syncthreads();
    typedef float f32x4 __attribute__((ext_vector_type(4)));
    {
        Ctx c2 = c; c2.g = c.l32 >> 3; c2.tok = wid * 8 + (c.l32 & 7); c2.t = c.t0 + c2.tok;
        const int head2 = kvh * 4 + c2.g; const size_t row2 = (size_t)b * SEQ + c2.t;
#pragma unroll
        for (int s2 = 0; s2 < 4; ++s2) c2.qf[s2] = *(const bf16x8*)(p.qb + row2 * 512 + head2 * 64 + 16 * s2 + 8 * c.h);
        const PG8_LAS float* ml = (const PG8_LAS float*)(lds + L_ML);
        const float mfin = ml[(c2.tok * 4 + c2.g) * 2], invl = ml[(c2.tok * 4 + c2.g) * 2 + 1];
        const float g0b = sigmoidf_(p.gatef[row2 * 32 + head2 * 3]);
        acc_init(a);
        attend<1>(c2, a, Kc, 64, Vct, NCPAD, 0, cjhi, jd, 0, 0, 0, 0, mfin, invl);
        float* tr2 = p.oc + row2 * 512 + head2 * 64 + 4 * c.h;
#pragma unroll
        for (int i = 0; i < 4; ++i) {
            *(f32x4*)(tr2 + 8 * i) = (f32x4){g0b * a.o0[4 * i], g0b * a.o0[4 * i + 1], g0b * a.o0[4 * i + 2], g0b * a.o0[4 * i + 3]};
            *(f32x4*)(tr2 + 32 + 8 * i) = (f32x4){g0b * a.o1[4 * i], g0b * a.o1[4 * i + 1], g0b * a.o1[4 * i + 2], g0b * a.o1[4 * i + 3]};
        }
        __builtin_amdgcn_fence(__ATOMIC_RELEASE, "workgroup");
    }
    float* trow = p.oc + row * 512 + head * 64 + 4 * c.h;
    float lt;
    topk_oct(lds, wid * 8, jd, c.lane);
    __syncthreads();
    const PG8_LAS unsigned* mk = (const PG8_LAS unsigned*)(lds + L_MASK) + (c.half * 32 + c.l32) * 4;
    const unsigned m0 = mk[0], m1 = mk[1], m2 = mk[2], m3 = mk[3];
    acc_init(a);
    attend<2>(c, a, Ks, 512, Vst, SEQ, 0, jd, jd, m0, m1, m2, m3, 0.f, 0.f);
    lt = a.l + __shfl_xor(a.l, 32);
    { const float sc = g1 / lt;
#pragma unroll
      for (int i = 0; i < 4; ++i) {
          f32x4 u = *(f32x4*)(trow + 8 * i), v = *(f32x4*)(trow + 32 + 8 * i);
#pragma unroll
          for (int r = 0; r < 4; ++r) { u[r] += sc * a.o0[4 * i + r]; v[r] += sc * a.o1[4 * i + r]; }
          *(f32x4*)(trow + 8 * i) = u; *(f32x4*)(trow + 32 + 8 * i) = v;
      } }
    acc_init(a);
    attend<3>(c, a, Kw, 256, Vwt, SEQ, jd >= 8 ? jd - 8 : 0, jd, jd, 0, 0, 0, 0, 0.f, 0.f);
    lt = a.l + __shfl_xor(a.l, 32);
    act_t* orow = p.mixb + row * 1024 + head * 64;
    { const float sc = g2 / lt;
      typedef unsigned u32x2 __attribute__((ext_vector_type(2)));
#pragma unroll
      for (int i = 0; i < 4; ++i) {
          f32x4 u = *(f32x4*)(trow + 8 * i), v = *(f32x4*)(trow + 32 + 8 * i);
#pragma unroll
          for (int r = 0; r < 4; ++r) { u[r] += sc * a.o0[4 * i + r]; v[r] += sc * a.o1[4 * i + r]; }
          u32x2 w0; w0[0] = pk2(u[0], u[1]); w0[1] = pk2(u[2], u[3]); *(u32x2*)(orow + 8 * i + 4 * c.h) = w0;
          u32x2 w1; w1[0] = pk2(v[0], v[1]); w1[1] = pk2(v[2], v[3]); *(u32x2*)(orow + 32 + 8 * i + 4 * c.h) = w1;
      } }
}
}


namespace atts {
using att::bf16x8; using att::f32x16; using att::Acc; using att::acc_init; using att::pack8; using att::pk2; using att::frag;
typedef float f32x4 __attribute__((ext_vector_type(4)));
typedef unsigned u32x4 __attribute__((ext_vector_type(4)));
constexpr int TABN = 856;
constexpr int L_TAB = 131088, L_MASK = L_TAB + 4 * TABN * 4;
constexpr int L_IMP = 0, IMPW = 321;
constexpr int L_XCH = 0;
static_assert(L_MASK + 8 * 12 * 4 <= 147440 && NSB_S <= 288 && NSB_S > 256 && NC_S + 1 == NCSPAD, "sample attention LDS map / shapes");
struct Cs { PG8_LAS unsigned char* lds; int lane, l32, h, xr, wid, i, g, t; const PG8_LAS float* tabp; const act_t* qp; };
DEV bf16x8 qfrag(const Cs& c, int ks) { return *(const bf16x8*)(c.qp + 16 * ks); }

template <int MODE>
DEV void smath(const Cs& c, Acc& a, f32x16& s0, f32x16& s1, int kbase, bool sel, float mfin, float invl) {
#pragma unroll
    for (int kt = 0; kt < 2; ++kt)
#pragma unroll
        for (int r = 0; r < 16; ++r) {
            const int kidx = kbase + kt * 32 + (r & 3) + 8 * (r >> 2) + 4 * c.h;
            const int dist = (MODE <= 1) ? c.t - 16 * kidx - 31 : c.t - kidx;
            int ix = clampi3(dist + 1, 0, TABN - 1);
            if (MODE == 3) ix = dist >= 512 ? 0 : ix;
            if (kt) s1[r] += c.tabp[ix]; else s0[r] += c.tabp[ix];
        }
    if (MODE == 1) {
#pragma unroll
        for (int r = 0; r < 16; ++r) { s0[r] = __builtin_amdgcn_exp2f(s0[r] - mfin) * invl; s1[r] = __builtin_amdgcn_exp2f(s1[r] - mfin) * invl; }
        return;
    }
    float mx = s0[0];
#pragma unroll
    for (int r = 1; r < 16; ++r) mx = fmaxf(mx, s0[r]);
#pragma unroll
    for (int r = 0; r < 16; ++r) mx = fmaxf(mx, s1[r]);
    mx = att::xmax32(mx);
    if (MODE == 2 && !sel) mx = -INFINITY;
    const bool grow = mx > a.m + att::DEFER_THR;
    if (__any(grow)) {
        const float mn = grow ? mx : a.m, alpha = __builtin_amdgcn_exp2f(a.m - mn);
        a.m = mn; a.l *= alpha;
        if (MODE != 0) {
#pragma unroll
            for (int r = 0; r < 16; ++r) { a.o0[r] *= alpha; a.o1[r] *= alpha; }
        }
    }
    const float mref = (MODE == 2 && !sel) ? 1e30f : a.m;
    float ls = 0.f;
#pragma unroll
    for (int r = 0; r < 16; ++r) { s0[r] = __builtin_amdgcn_exp2f(s0[r] - mref); s1[r] = __builtin_amdgcn_exp2f(s1[r] - mref); ls += s0[r] + s1[r]; }
    a.l += ls;
}
DEV void stage_rows(PG8_LAS unsigned char* kt_, PG8_LAS unsigned char* vt_, const float* krow0, const float* vrow0, const float* krow1, const float* vrow1, int l32, int hh) {
#pragma unroll
    for (int ps = 0; ps < 2; ++ps) {
        const float* kr = ps ? krow1 : krow0; const float* vr = ps ? vrow1 : vrow0; const int row = ps * 32 + l32;
        {
            f32x4 kv[8];
#pragma unroll
            for (int q = 0; q < 8; ++q) kv[q] = kr ? *(const f32x4*)(kr + hh * 32 + q * 4) : (f32x4){0.f, 0.f, 0.f, 0.f};
#pragma unroll
            for (int q = 0; q < 4; ++q) { u32x4 o; o[0] = pk2(kv[2 * q][0], kv[2 * q][1]); o[1] = pk2(kv[2 * q][2], kv[2 * q][3]); o[2] = pk2(kv[2 * q + 1][0], kv[2 * q + 1][1]); o[3] = pk2(kv[2 * q + 1][2], kv[2 * q + 1][3]);
                *(PG8_LAS u32x4*)(kt_ + row * 128 + (((hh * 4 + q) ^ (row & 7)) << 4)) = o; }
        }
        __builtin_amdgcn_sched_barrier(0);
        {
            f32x4 vv[8];
#pragma unroll
            for (int q = 0; q < 8; ++q) vv[q] = vr ? *(const f32x4*)(vr + hh * 32 + q * 4) : (f32x4){0.f, 0.f, 0.f, 0.f};
            const int pos = perm16(row);
#pragma unroll
            for (int q = 0; q < 8; ++q)
#pragma unroll
                for (int e = 0; e < 4; ++e) { const int d = hh * 32 + q * 4 + e; *(PG8_LAS unsigned short*)(vt_ + d * 128 + (((pos >> 3) ^ (d & 7)) << 4) + (pos & 7) * 2) = to_act(vv[q][e]); }
        }
        __builtin_amdgcn_sched_barrier(0);
    }
}
DEV void qk_lds(const Cs& c, const PG8_LAS unsigned char* kb, f32x16& s0, f32x16& s1) {
#pragma unroll
    for (int r = 0; r < 16; ++r) { s0[r] = 0.f; s1[r] = 0.f; }
#pragma unroll
    for (int ks = 0; ks < 4; ++ks) { s0 = MFMA32(frag(kb, c.l32, 2 * ks + c.h, c.xr), qfrag(c, ks), s0); s1 = MFMA32(frag(kb, 32 + c.l32, 2 * ks + c.h, c.xr), qfrag(c, ks), s1); }
}
DEV void pv_lds(const Cs& c, const PG8_LAS unsigned char* vb, Acc& a, const f32x16& s0, const f32x16& s1) {
#pragma unroll
    for (int kt = 0; kt < 2; ++kt)
#pragma unroll
        for (int sp = 0; sp < 2; ++sp) { const bf16x8 pf = pack8(kt ? s1 : s0, sp);
            a.o0 = MFMA32(frag(vb, c.l32, kt * 4 + 2 * sp + c.h, c.xr), pf, a.o0); a.o1 = MFMA32(frag(vb, 32 + c.l32, kt * 4 + 2 * sp + c.h, c.xr), pf, a.o1); }
}
template <bool NORM = true>
DEV void merge(const Cs& c, Acc& a, float gate) {
    PG8_LAS float* x = (PG8_LAS float*)(c.lds + L_XCH);
    const float lp = a.l + __shfl_xor(a.l, 32);
    __syncthreads();
    PG8_LAS float* mine = x + (c.wid * 64 + c.lane) * 34;
    mine[0] = a.m; mine[1] = lp;
#pragma unroll
    for (int r = 0; r < 16; ++r) { mine[2 + r] = a.o0[r]; mine[18 + r] = a.o1[r]; }
    __syncthreads();
    float M = -1e30f;
#pragma unroll
    for (int w = 0; w < 8; ++w) M = fmaxf(M, x[(w * 64 + c.lane) * 34]);
    float L = 0.f;
#pragma unroll
    for (int r = 0; r < 16; ++r) { a.o0[r] = 0.f; a.o1[r] = 0.f; }
#pragma unroll 1
    for (int w = 0; w < 8; ++w) { const PG8_LAS float* q = x + (w * 64 + c.lane) * 34; const float sc = __builtin_amdgcn_exp2f(q[0] - M); L += q[1] * sc;
#pragma unroll
        for (int r = 0; r < 16; ++r) { a.o0[r] += sc * q[2 + r]; a.o1[r] += sc * q[18 + r]; } }
    if (NORM) { const float f = L > 0.f ? gate / L : 0.f;
#pragma unroll
        for (int r = 0; r < 16; ++r) { a.o0[r] *= f; a.o1[r] *= f; } }
    a.m = M; a.l = L;
}
constexpr int NPART = 4;
DEV void unit(const P& p, PG8_LAS unsigned char* lds, int b, int kvh, int part) {
    Cs c; c.lds = lds; const int tid = fresh_tid(); c.lane = tid & 63; c.l32 = c.lane & 31; c.h = c.lane >> 5; c.xr = c.l32 & 7;
    c.wid = __builtin_amdgcn_readfirstlane(tid >> 6); c.i = c.l32 & 7; c.g = c.l32 >> 3; c.t = PAST + c.i;
    const int head = kvh * 4 + c.g; const size_t row = (size_t)TOKP + b * DS + c.i;
    c.qp = p.qb + row * 512 + head * 64 + 8 * c.h;
    const float g0 = sigmoidf_(p.gatef[row * 32 + head * 3]), g1 = sigmoidf_(p.gatef[row * 32 + head * 3 + 1]), g2 = sigmoidf_(p.gatef[row * 32 + head * 3 + 2]);
    __syncthreads();
    for (int k = tid; k < 4 * TABN; k += NTHR_) { const int e = k % TABN; ((PG8_LAS float*)(lds + L_TAB))[k] = e == 0 ? -INFINITY : p.rel_bias[rel_bucket(e - 1) * 8 + kvh * 4 + k / TABN] * LOG2E; }
    for (int k = tid; k < 8 * IMPW; k += NTHR_) ((PG8_LAS float*)(lds + L_IMP))[k] = 0.f;
    __syncthreads();
    c.tabp = (const PG8_LAS float*)(lds + L_TAB) + c.g * TABN;
    const size_t bh = (size_t)b * 2 + kvh;
    const act_t* Kc = p.kcs + bh * NCSPAD * 64; const act_t* Vct = p.vcts + bh * 64 * NCSPAD;
    constexpr int NCB = NCSPAD / 64;
    Acc a; acc_init(a); f32x16 s0, s1;
    static_assert(NCB == 16, "each wave owns compressed key blocks wid and wid + 8");
    bf16x8 kf[2][8];
#pragma unroll
    for (int bl = 0; bl < 2; ++bl)
#pragma unroll
        for (int ks = 0; ks < 4; ++ks) { const int jb = c.wid + 8 * bl;
            kf[bl][2 * ks] = *(const bf16x8*)(Kc + (size_t)(jb * 64 + c.l32) * 64 + 16 * ks + 8 * c.h); kf[bl][2 * ks + 1] = *(const bf16x8*)(Kc + (size_t)(jb * 64 + 32 + c.l32) * 64 + 16 * ks + 8 * c.h); }
#pragma unroll
    for (int bl = 0; bl < 2; ++bl) { const int jb = c.wid + 8 * bl;
#pragma unroll
        for (int r = 0; r < 16; ++r) { s0[r] = 0.f; s1[r] = 0.f; }
#pragma unroll
        for (int ks = 0; ks < 4; ++ks) { const bf16x8 qf = qfrag(c, ks); s0 = MFMA32(kf[bl][2 * ks], qf, s0); s1 = MFMA32(kf[bl][2 * ks + 1], qf, s1); }
        smath<0>(c, a, s0, s1, jb * 64, true, 0.f, 0.f);
    }
    merge(c, a, 1.0f);
    const float mfin = a.m, invl = a.l > 0.f ? 1.0f / a.l : 0.f;
    __syncthreads();
    for (int k = tid; k < 8 * IMPW; k += NTHR_) ((PG8_LAS float*)(lds + L_IMP))[k] = 0.f;
    __syncthreads();
    acc_init(a);
    bf16x8 vf[2][8];
#pragma unroll
    for (int bl = 0; bl < 2; ++bl)
#pragma unroll
        for (int q = 0; q < 4; ++q) { const int jb = c.wid + 8 * bl;
            vf[bl][2 * q] = *(const bf16x8*)(Vct + (size_t)c.l32 * NCSPAD + jb * 64 + 16 * q + 8 * c.h); vf[bl][2 * q + 1] = *(const bf16x8*)(Vct + (size_t)(32 + c.l32) * NCSPAD + jb * 64 + 16 * q + 8 * c.h); }
#pragma unroll
    for (int bl = 0; bl < 2; ++bl) { const int jb = c.wid + 8 * bl;
#pragma unroll
        for (int r = 0; r < 16; ++r) { s0[r] = 0.f; s1[r] = 0.f; }
#pragma unroll
        for (int ks = 0; ks < 4; ++ks) { const bf16x8 qf = qfrag(c, ks); s0 = MFMA32(kf[bl][2 * ks], qf, s0); s1 = MFMA32(kf[bl][2 * ks + 1], qf, s1); }
        smath<1>(c, a, s0, s1, jb * 64, true, mfin, invl);
        PG8_LAS float* imp = (PG8_LAS float*)(lds + L_IMP) + c.i * IMPW;
#pragma unroll
        for (int kt = 0; kt < 2; ++kt)
#pragma unroll
            for (int q = 0; q < 4; ++q) {
                const float p0 = kt ? s1[4 * q] : s0[4 * q], p1 = kt ? s1[4 * q + 1] : s0[4 * q + 1], p2 = kt ? s1[4 * q + 2] : s0[4 * q + 2], p3 = kt ? s1[4 * q + 3] : s0[4 * q + 3];
                const int jbk = (jb * 64 + kt * 32 + 8 * q + 4 * c.h) >> 2;
                __hip_atomic_fetch_add(imp + jbk, (p0 + p1) + (p2 + p3), __ATOMIC_RELAXED, __HIP_MEMORY_SCOPE_WORKGROUP);
                __hip_atomic_fetch_add(imp + jbk + 1, p3, __ATOMIC_RELAXED, __HIP_MEMORY_SCOPE_WORKGROUP);
            }
#pragma unroll
        for (int kt = 0; kt < 2; ++kt)
#pragma unroll
            for (int sp = 0; sp < 2; ++sp) { const bf16x8 pf = pack8(kt ? s1 : s0, sp);
                a.o0 = MFMA32(vf[bl][2 * (kt * 2 + sp)], pf, a.o0);
                a.o1 = MFMA32(vf[bl][2 * (kt * 2 + sp) + 1], pf, a.o1); }
    }
    __syncthreads();
    {
        const PG8_LAS float* imp = (const PG8_LAS float*)(lds + L_IMP) + c.wid * IMPW; constexpr int jd = NSB_S - 1, K = 14;
        unsigned v[5]; bool cd[5];
#pragma unroll
        for (int k = 0; k < 5; ++k) { const int j = c.lane + 64 * k; cd[k] = j >= 1 && j < jd; v[k] = cd[k] ? __float_as_uint(imp[j]) : 0u; }
        unsigned thr = 0u;
        for (int bit = 30; bit >= 0; --bit) { const unsigned cand = thr | (1u << bit); int cnt = 0;
#pragma unroll
            for (int k = 0; k < 5; ++k) cnt += __popcll(__ballot(cd[k] && v[k] >= cand));
            if (cnt >= K) thr = cand; }
        int ngt = 0;
#pragma unroll
        for (int k = 0; k < 5; ++k) ngt += __popcll(__ballot(cd[k] && v[k] > thr));
        const int need = K - ngt; const unsigned long long below = (1ull << c.lane) - 1ull; int before = 0;
        PG8_LAS unsigned* mk = (PG8_LAS unsigned*)(lds + L_MASK) + c.wid * 12;
#pragma unroll
        for (int k = 0; k < 5; ++k) { const int j = c.lane + 64 * k; const unsigned long long eq = __ballot(cd[k] && v[k] == thr);
            const bool sl = (j == 0) || (j == jd) || (cd[k] && (v[k] > thr || (v[k] == thr && before + __popcll(eq & below) < need)));
            before += __popcll(eq);
            const unsigned long long bb = __ballot(sl);
            if (c.lane == 0) { mk[2 * k] = (unsigned)bb; mk[2 * k + 1] = (unsigned)(bb >> 32); } }
    }
    { a.m = 0.f; a.l = 0.5f; }
    merge(c, a, g0 * 8.0f);
    float* trow = p.oc + row * 512 + head * 64 + 4 * c.h;
    if (c.wid == 0 && part == 0) {
#pragma unroll
        for (int q = 0; q < 4; ++q) { *(f32x4*)(trow + 8 * q) = (f32x4){a.o0[4 * q], a.o0[4 * q + 1], a.o0[4 * q + 2], a.o0[4 * q + 3]}; *(f32x4*)(trow + 32 + 8 * q) = (f32x4){a.o1[4 * q], a.o1[4 * q + 1], a.o1[4 * q + 2], a.o1[4 * q + 3]}; }
    }
    __syncthreads();
    const PG8_LAS unsigned* mkAll = (const PG8_LAS unsigned*)(lds + L_MASK);
    PG8_LAS unsigned char* kt_ = lds + c.wid * 16384; PG8_LAS unsigned char* vt_ = kt_ + 8192;
    const int hh = c.h;
    acc_init(a);
    {
        int cnt = 0;
        for (int wd = 0; wd < 9; ++wd) {
            unsigned un = 0u;
#pragma unroll
            for (int tk = 0; tk < 8; ++tk) un |= mkAll[tk * 12 + wd];
            un = __builtin_amdgcn_readfirstlane(un);
            const unsigned mine = mkAll[c.i * 12 + wd];
            while (un) {
                const int bit = __builtin_ctz(un); un &= un - 1u; const int j = wd * 32 + bit;
                if (((cnt++) % (8 * NPART)) != part * 8 + c.wid) continue;
                const float *k0 = nullptr, *v0 = nullptr, *k1 = nullptr, *v1 = nullptr;
                if (j < PAST / 64) {
                    const int T0 = j * 64 + c.l32, T1 = T0 + 32;
                    const float* r0 = p.cache_kv + (((size_t)p.page_table[b * NPAGES + T0 / PAGE] * PAGE + T0 % PAGE) * 4) * 128 + kvh * 64;
                    const float* r1 = p.cache_kv + (((size_t)p.page_table[b * NPAGES + T1 / PAGE] * PAGE + T1 % PAGE) * 4) * 128 + kvh * 64;
                    k0 = r0 + 2 * 128; v0 = r0 + 3 * 128; k1 = r1 + 2 * 128; v1 = r1 + 3 * 128;
                } else if (c.l32 < DS) { const float* r0 = p.o_kvs + (size_t)(b * DS + c.l32) * 512 + kvh * 64; k0 = r0 + 2 * 128; v0 = r0 + 3 * 128; }
                stage_rows(kt_, vt_, k0, v0, k1, v1, c.l32, hh);
                __builtin_amdgcn_wave_barrier();
                qk_lds(c, kt_, s0, s1);
                smath<2>(c, a, s0, s1, j * 64, (mine >> bit) & 1u, 0.f, 0.f);
                pv_lds(c, vt_, a, s0, s1);
                __builtin_amdgcn_wave_barrier();
            }
        }
    }
    merge<false>(c, a, 1.0f);
    float* sp = p.spart + (((size_t)(b * 2 + kvh) * NPART + part) * 2 + 0) * 64 * 34 + c.lane;
    if (c.wid == 0) { sp[0] = a.m; sp[64] = a.l;
#pragma unroll
        for (int r = 0; r < 16; ++r) { sp[(2 + r) * 64] = a.o0[r]; sp[(18 + r) * 64] = a.o1[r]; } }
    __syncthreads();
    acc_init(a);
    for (int wj = part * 8 + c.wid; wj < 9; wj += 8 * NPART) {
        const float *k0 = nullptr, *v0 = nullptr, *k1 = nullptr, *v1 = nullptr;
        { const int w0 = wj * 64 + c.l32, w1 = w0 + 32;
          if (w0 < WBS) { const float* r = p.cache_win + ((size_t)b * WBS + w0) * 256 + kvh * 64; k0 = r; v0 = r + 128; }
          else if (w0 < WBS + DS) { const float* r = p.kvwf + (size_t)(TOKP + b * DS + w0 - WBS) * 256 + kvh * 64; k0 = r; v0 = r + 128; }
          if (w1 < WBS) { const float* r = p.cache_win + ((size_t)b * WBS + w1) * 256 + kvh * 64; k1 = r; v1 = r + 128; }
          else if (w1 < WBS + DS) { const float* r = p.kvwf + (size_t)(TOKP + b * DS + w1 - WBS) * 256 + kvh * 64; k1 = r; v1 = r + 128; } }
        stage_rows(kt_, vt_, k0, v0, k1, v1, c.l32, hh);
        __builtin_amdgcn_wave_barrier();
        qk_lds(c, kt_, s0, s1);
        smath<3>(c, a, s0, s1, PAST - WBS + wj * 64, true, 0.f, 0.f);
        pv_lds(c, vt_, a, s0, s1);
        __builtin_amdgcn_wave_barrier();
    }
    merge<false>(c, a, 1.0f);
    if (c.wid == 0) { float* sw = sp + 64 * 34; sw[0] = a.m; sw[64] = a.l;
#pragma unroll
        for (int r = 0; r < 16; ++r) { sw[(2 + r) * 64] = a.o0[r]; sw[(18 + r) * 64] = a.o1[r]; } }
    __syncthreads();
}
DEV void finish(const P& p, int gw, int nw, int lane) {
    typedef unsigned u32x2 __attribute__((ext_vector_type(2)));
    for (int u = gw; u < DB * 2; u += nw) {
        const int b = u >> 1, kvh = u & 1, l32 = lane & 31, hh = lane >> 5, i = l32 & 7, g = l32 >> 3, head = kvh * 4 + g; const size_t row = (size_t)TOKP + b * DS + i;
        const float gs = sigmoidf_(p.gatef[row * 32 + head * 3 + 1]), gwn = sigmoidf_(p.gatef[row * 32 + head * 3 + 2]);
        float tot[32]; const float* trow = p.oc + row * 512 + head * 64 + 4 * hh;
#pragma unroll
        for (int q = 0; q < 4; ++q) { const f32x4 x = *(const f32x4*)(trow + 8 * q), y = *(const f32x4*)(trow + 32 + 8 * q);
#pragma unroll
            for (int e = 0; e < 4; ++e) { tot[4 * q + e] = x[e]; tot[16 + 4 * q + e] = y[e]; } }
#pragma unroll 1
        for (int br = 0; br < 2; ++br) {
            const float* base = p.spart + (((size_t)u * NPART) * 2 + br) * 64 * 34 + lane;
            float M = -1e30f;
#pragma unroll
            for (int pt = 0; pt < NPART; ++pt) M = fmaxf(M, base[(size_t)pt * 2 * 64 * 34]);
            float L = 0.f, acc[32];
#pragma unroll
            for (int r = 0; r < 32; ++r) acc[r] = 0.f;
#pragma unroll 1
            for (int pt = 0; pt < NPART; ++pt) { const float* q = base + (size_t)pt * 2 * 64 * 34; const float sc = __builtin_amdgcn_exp2f(q[0] - M); L += q[64] * sc;
#pragma unroll
                for (int r = 0; r < 32; ++r) acc[r] += sc * q[(2 + r) * 64]; }
            const float f = (br ? gwn : gs) / L;
#pragma unroll
            for (int r = 0; r < 32; ++r) tot[r] += f * acc[r];
        }
        act_t* orow = p.mixb + row * 1024 + head * 64;
#pragma unroll
        for (int q = 0; q < 4; ++q) {
            u32x2 w0; w0[0] = att::pk2(tot[4 * q], tot[4 * q + 1]); w0[1] = att::pk2(tot[4 * q + 2], tot[4 * q + 3]); *(u32x2*)(orow + 8 * q + 4 * hh) = w0;
            u32x2 w1; w1[0] = att::pk2(tot[16 + 4 * q], tot[16 + 4 * q + 1]); w1[1] = att::pk2(tot[16 + 4 * q + 2], tot[16 + 4 * q + 3]); *(u32x2*)(orow + 32 + 8 * q + 4 * hh) = w1;
        }
    }
}
}


namespace mls {
using att::bf16x8; using att::f32x16; using att::pack8; using att::pk2;
typedef float f32x4 __attribute__((ext_vector_type(4)));
typedef unsigned u32x4 __attribute__((ext_vector_type(4)));
typedef unsigned u32x2 __attribute__((ext_vector_type(2)));
constexpr int L_Q = 0, L_K = 16384, L_VT = 32768, L_KWT = 49152, L_CT = 65536, L_G = 98304;
constexpr int G_WK = 0, G_IBL = 64, G_BML = 128, G_INT = 192, G_EMT = 256, G_NP = 320, G_SSQ = 448;
DEV PG8_LAS float* gf(PG8_LAS unsigned char* lds) { return (PG8_LAS float*)(lds + L_G); }
DEV bf16x8 frag256(const PG8_LAS unsigned char* buf, int row, int ch) { return *(const PG8_LAS bf16x8*)(buf + row * 256 + ((ch ^ (row & 15)) << 4)); }
DEV bf16x8 frag128(const PG8_LAS unsigned char* buf, int row, int ch) { return *(const PG8_LAS bf16x8*)(buf + row * 128 + ((ch ^ (row & 7)) << 4)); }
DEV float bf2f(unsigned short u) { return __uint_as_float((unsigned)u << 16); }
DEV void put_t(PG8_LAS unsigned char* img, int s, int c0, const float* f, float scale) {
    const int pos = perm16(s);
#pragma unroll
    for (int e = 0; e < 8; ++e) { const int c = c0 + e; *(PG8_LAS unsigned short*)(img + c * 128 + (((pos >> 3) ^ (c & 7)) << 4) + (pos & 7) * 2) = to_act(f[e] * scale); }
}
DEV void stage_vT(const P& p, PG8_LAS unsigned char* lds, int r0, int cl, int h, int tid) {
#pragma unroll
    for (int i = 0; i < 2; ++i) { const int it = tid + 512 * i, srow = it >> 4, ch = it & 15; float f[8];
        if (srow < cl) { const u32x4 raw = *(const u32x4*)(p.mvb + (size_t)(r0 + srow) * 512 + h * 128 + ch * 8);
#pragma unroll
            for (int e = 0; e < 4; ++e) { f[2 * e] = __uint_as_float(raw[e] << 16); f[2 * e + 1] = __uint_as_float(raw[e] & 0xffff0000u); } }
        else {
#pragma unroll
            for (int e = 0; e < 8; ++e) f[e] = 0.f; }
        put_t(lds + L_VT, srow, ch * 8, f, 1.0f); }
}
struct PreA { u32x4 k[2], v[2]; float bs, ig, mp; };
DEV void load_a(const P& p, int u, int tid, PreA& r) {
    const int ch = u >> 2, h = u & 3; int path, b, c, r0, cl; chunk_info(ch, path, b, c, r0, cl);
    const act_t* kb = p.qkb + (size_t)r0 * 1024 + 512 + h * 128; const act_t* vb = p.mvb + (size_t)r0 * 512 + h * 128;
#pragma unroll
    for (int i = 0; i < 2; ++i) { const unsigned it = tid + 512 * i, srow = it >> 4, chk = it & 15; r.k[i] = (u32x4){0u, 0u, 0u, 0u}; r.v[i] = (u32x4){0u, 0u, 0u, 0u};
        if ((int)srow < cl) { r.k[i] = *(const u32x4*)(kb + (srow * 1024u + chk * 8u)); r.v[i] = *(const u32x4*)(vb + (srow * 512u + chk * 8u)); } }
    const int lane = tid & 63; const bool act = tid < 64 && lane < cl; const unsigned lr = act ? lane : 0;
    r.bs = act ? (p.gb + (size_t)r0 * 4 + h)[lr * 4u] : 0.f; r.ig = act ? (p.mif + (size_t)r0 * 8 + h)[lr * 8u] : 0.f; r.mp = p.mprev[(size_t)ch * 4 + h];
}
DEV void unpack8(const u32x4 raw, float* f) {
#pragma unroll
    for (int e = 0; e < 4; ++e) { f[2 * e] = __uint_as_float(raw[e] << 16); f[2 * e + 1] = __uint_as_float(raw[e] & 0xffff0000u); }
}
DEV void phase_a(const P& p, PG8_LAS unsigned char* lds) {
    const int tid = fresh_tid(), lane = tid & 63, l32 = lane & 31, hh = lane >> 5, wid = __builtin_amdgcn_readfirstlane(tid >> 6);
    PG8_LAS float* G = gf(lds);
    int u = blockIdx.x; if (u >= NCHUNK * 4) return;
    PreA r; load_a(p, u, tid, r);
    for (; u < NCHUNK * 4; u += gridDim.x) {
        const int ch = u >> 2, h = u & 3; int path, b, c, r0, cl; chunk_info(ch, path, b, c, r0, cl);
        __syncthreads();
        if (wid == 0) {
            const bool act = lane < cl;
            float pm = act ? r.ig - r.bs : -INFINITY;
#pragma unroll
            for (int o = 32; o; o >>= 1) pm = fmaxf(pm, __shfl_xor(pm, o));
            const float bend = __shfl(r.bs, cl - 1), mnew = bend + fmaxf(r.mp, pm);
            G[G_WK + lane] = act ? expf(bend - r.bs + r.ig - mnew) : 0.f;
        }
        __syncthreads();
#pragma unroll
        for (int i = 0; i < 2; ++i) { const int it = tid + 512 * i, srow = it >> 4, chk = it & 15; float f[8];
            unpack8(r.k[i], f); put_t(lds + L_KWT, srow, chk * 8, f, G[G_WK + srow]);
            unpack8(r.v[i], f); put_t(lds + L_VT, srow, chk * 8, f, 1.0f); }
        __syncthreads();
        if (u + (int)gridDim.x < NCHUNK * 4) load_a(p, u + gridDim.x, tid, r);
        const int dt = wid & 3;
        f32x16 acc[2];
#pragma unroll
        for (int j = 0; j < 2; ++j)
#pragma unroll
            for (int q = 0; q < 16; ++q) acc[j][q] = 0.f;
#pragma unroll
        for (int ks = 0; ks < 4; ++ks) { const bf16x8 af = frag128(lds + L_KWT, dt * 32 + l32, 2 * ks + hh);
#pragma unroll
            for (int j = 0; j < 2; ++j) acc[j] = MFMA32(af, frag128(lds + L_VT, ((wid >> 2) * 2 + j) * 32 + l32, 2 * ks + hh), acc[j]); }
        act_t* out = p.dct + ((size_t)ch * 4 + h) * 16384;
#pragma unroll
        for (int j = 0; j < 2; ++j) { const int vp = ((wid >> 2) * 2 + j) * 32 + l32;
#pragma unroll
            for (int q = 0; q < 4; ++q) { u32x2 o; o[0] = pk2(acc[j][4 * q], acc[j][4 * q + 1]); o[1] = pk2(acc[j][4 * q + 2], acc[j][4 * q + 3]); *(u32x2*)(out + (size_t)vp * 128 + dt * 32 + 8 * q + 4 * hh) = o; } }
        if (tid < 128) { float sn = 0.f;
#pragma unroll
            for (int cq = 0; cq < 8; ++cq) { const bf16x8 v = frag128(lds + L_KWT, tid, cq);
#pragma unroll
                for (int e = 0; e < 8; ++e) sn += bf2f((unsigned short)v[e]); }
            p.dn[((size_t)ch * 4 + h) * 128 + tid] = sn; }
    }
}
struct PreB { u32x4 q[2], k[2], v[2], ct[4]; float bs, ig, mp, np; };
DEV void load_b(const P& p, int u, int tid, PreB& r) {
    const int ch = u >> 2, h = u & 3; int path, b, c, r0, cl; chunk_info(ch, path, b, c, r0, cl);
    const act_t* qb_ = p.qkb + (size_t)r0 * 1024 + h * 128; const act_t* vb = p.mvb + (size_t)r0 * 512 + h * 128; const act_t* cb = p.cpt + ((size_t)ch * 4 + h) * 16384;
#pragma unroll
    for (int i = 0; i < 2; ++i) { const unsigned it = tid + 512 * i, srow = it >> 4, chk = it & 15; r.q[i] = (u32x4){0u, 0u, 0u, 0u}; r.k[i] = r.q[i]; r.v[i] = r.q[i];
        if ((int)srow < cl) { r.q[i] = *(const u32x4*)(qb_ + (srow * 1024u + chk * 8u)); r.k[i] = *(const u32x4*)(qb_ + (srow * 1024u + chk * 8u + 512u)); r.v[i] = *(const u32x4*)(vb + (srow * 512u + chk * 8u)); } }
#pragma unroll
    for (int i = 0; i < 4; ++i) { const unsigned it = tid + 512 * i; r.ct[i] = *(const u32x4*)(cb + it * 8u); }
    const int lane = tid & 63; const bool act = tid < 64 && lane < cl; const unsigned lr = act ? lane : 0;
    r.bs = act ? (p.gb + (size_t)r0 * 4 + h)[lr * 4u] : 0.f; r.ig = act ? (p.mif + (size_t)r0 * 8 + h)[lr * 8u] : 0.f; r.mp = p.mprev[(size_t)ch * 4 + h];
    r.np = (tid >= 64 && tid < 192) ? (p.nprev + ((size_t)ch * 4 + h) * 128)[(unsigned)(tid - 64)] : 0.f;
}
DEV void phase_b(const P& p, PG8_LAS unsigned char* lds) {
    const int tid = fresh_tid(), lane = tid & 63, l32 = lane & 31, hh = lane >> 5, wid = __builtin_amdgcn_readfirstlane(tid >> 6);
    PG8_LAS float* G = gf(lds);
    int u = blockIdx.x; if (u >= NCHUNK * 4) return;
    PreB r; load_b(p, u, tid, r);
    const int vt = wid & 3, tt = wid >> 2, tl = tt * 32 + l32;
    for (; u < NCHUNK * 4; u += gridDim.x) {
        const int ch = u >> 2, h = u & 3; int path, b, c, r0, cl; chunk_info(ch, path, b, c, r0, cl);
        int tlo = tl, l32o = l32; asm volatile("" : "+v"(tlo), "+v"(l32o));
        const bool live = tl < cl;
        const int head_col = h * 128 + vt * 32 + 4 * hh;
        u32x2 mor[4];
#pragma unroll
        for (int q = 0; q < 4; ++q) mor[q] = *(const u32x2*)((p.mob + (size_t)r0 * 512) + ((unsigned)(live ? tl : 0) * 512u + head_col + 8 * q));
        __syncthreads();
        if (wid == 0) {
            const bool act = lane < cl;
            float pm = act ? r.ig - r.bs : -INFINITY;
#pragma unroll
            for (int o = 1; o < 64; o <<= 1) { const float t = __shfl_up(pm, o); if (lane >= o) pm = fmaxf(pm, t); }
            const float mt = r.bs + fmaxf(r.mp, pm);
            G[G_IBL + lane] = act ? (r.ig - r.bs) * LOG2E : -INFINITY; G[G_BML + lane] = (r.bs - mt) * LOG2E; G[G_INT + lane] = act ? expf(r.bs + r.mp - mt) : 0.f; G[G_EMT + lane] = expf(-mt);
        }
        if (tid >= 64 && tid < 192) G[G_NP + tid - 64] = r.np;
#pragma unroll
        for (int i = 0; i < 2; ++i) { const int it = tid + 512 * i, srow = it >> 4, chk = it & 15; float f[8];
            *(PG8_LAS u32x4*)(lds + L_Q + srow * 256 + ((chk ^ (srow & 15)) << 4)) = r.q[i]; *(PG8_LAS u32x4*)(lds + L_K + srow * 256 + ((chk ^ (srow & 15)) << 4)) = r.k[i];
            unpack8(r.v[i], f); put_t(lds + L_VT, srow, chk * 8, f, 1.0f); }
#pragma unroll
        for (int i = 0; i < 4; ++i) { const int it = tid + 512 * i, vrow = it >> 4, chk = it & 15; *(PG8_LAS u32x4*)(lds + L_CT + vrow * 256 + ((chk ^ (vrow & 15)) << 4)) = r.ct[i]; }
        __syncthreads();
        if (u + (int)gridDim.x < NCHUNK * 4) load_b(p, u + gridDim.x, tid, r);
        f32x16 o1;
        const float inter = G[G_INT + tlo];
        {
            f32x16 o2;
#pragma unroll
            for (int q = 0; q < 16; ++q) o2[q] = 0.f;
#pragma unroll
            for (int ks = 0; ks < 8; ++ks) o2 = MFMA32(frag256(lds + L_CT, vt * 32 + l32o, 2 * ks + hh), frag256(lds + L_Q, tlo, 2 * ks + hh), o2);
#pragma unroll
            for (int q = 0; q < 16; ++q) o1[q] = inter * o2[q];
        }
        const float bml = G[G_BML + tl]; float den = 0.f;
#pragma unroll 1
        for (int st = 0; st < 2; ++st) {
            f32x16 sc;
#pragma unroll
            for (int q = 0; q < 16; ++q) sc[q] = 0.f;
#pragma unroll
            for (int ks = 0; ks < 8; ++ks) sc = MFMA32(frag256(lds + L_K, st * 32 + l32o, 2 * ks + hh), frag256(lds + L_Q, tlo, 2 * ks + hh), sc);
#pragma unroll
            for (int q = 0; q < 16; ++q) { const int sidx = st * 32 + (q & 3) + 8 * (q >> 2) + 4 * hh;
                const float w = __builtin_amdgcn_exp2f(bml + G[G_IBL + sidx] + (sidx <= tlo ? 0.f : -INFINITY));
                sc[q] *= w; den += sc[q]; }
#pragma unroll
            for (int sp = 0; sp < 2; ++sp) o1 = MFMA32(frag128(lds + L_VT, vt * 32 + l32o, st * 4 + 2 * sp + hh), pack8(sc, sp), o1);
        }
        float qn = 0.f;
#pragma unroll 2
        for (int cq = 0; cq < 8; ++cq) { const bf16x8 qv = frag256(lds + L_Q, tlo, hh * 8 + cq);
#pragma unroll
            for (int e = 0; e < 8; ++e) qn += bf2f((unsigned short)qv[e]) * G[G_NP + hh * 64 + cq * 8 + e]; }
        den += __shfl_xor(den, 32); qn += __shfl_xor(qn, 32);
        den += inter * qn;
        const float inv = 1.0f / fmaxf(fabsf(den), G[G_EMT + tl]);
        float ss = 0.f;
#pragma unroll
        for (int q = 0; q < 4; ++q) {
            const float mo[4] = {__uint_as_float(mor[q][0] << 16), __uint_as_float(mor[q][0] & 0xffff0000u), __uint_as_float(mor[q][1] << 16), __uint_as_float(mor[q][1] & 0xffff0000u)};
#pragma unroll
            for (int e = 0; e < 4; ++e) { const float hv = o1[4 * q + e] * inv * fsigmoid_(mo[e]); o1[4 * q + e] = hv; ss += hv * hv; } }
        ss += __shfl_xor(ss, 32);
        if (hh == 0) G[G_SSQ + (tt * 4 + vt) * 32 + l32] = ss;
        __syncthreads();
        const float tot = G[G_SSQ + (tt * 4 + 0) * 32 + l32] + G[G_SSQ + (tt * 4 + 1) * 32 + l32] + G[G_SSQ + (tt * 4 + 2) * 32 + l32] + G[G_SSQ + (tt * 4 + 3) * 32 + l32];
        const float rr = 1.0f / sqrtf(tot / 128 + 1e-6f);
        if (live) {
#pragma unroll
            for (int q = 0; q < 4; ++q) { const f32x4 g = *(const f32x4*)(p.g_mnorm + head_col + 8 * q);
                u32x2 o; o[0] = pk2(o1[4 * q] * rr * g[0], o1[4 * q + 1] * rr * g[1]); o[1] = pk2(o1[4 * q + 2] * rr * g[2], o1[4 * q + 3] * rr * g[3]);
                *(u32x2*)((p.mixb + (size_t)r0 * 1024 + 512) + ((unsigned)tl * 1024u + head_col + 8 * q)) = o; }
        }
    }
}
}

namespace coop {
typedef float f32x4 __attribute__((ext_vector_type(4)));
typedef unsigned u32x2 __attribute__((ext_vector_type(2)));
typedef unsigned u32x4 __attribute__((ext_vector_type(4)));
DEV float wave_sum(float v) {
#pragma unroll
    for (int o = 32; o; o >>= 1) v += __shfl_xor(v, o);
    return v;
}
DEV unsigned pk2(float lo, float hi) { return pkbf(lo, hi); }
DEV f32x4 ldb4(const act_t* q) { const u32x2 r = *(const u32x2*)q; return (f32x4){__uint_as_float(r[0] << 16), __uint_as_float(r[0] & 0xffff0000u), __uint_as_float(r[1] << 16), __uint_as_float(r[1] & 0xffff0000u)}; }
DEV f32x4 cvb4(u32x2 r) { return (f32x4){__uint_as_float(r[0] << 16), __uint_as_float(r[0] & 0xffff0000u), __uint_as_float(r[1] << 16), __uint_as_float(r[1] & 0xffff0000u)}; }
static_assert(D == 1024, "wave-per-row helpers assume d_model 1024 (16 floats per lane)");
DEV void rmsnorm_in(const P& p, int gw, int nw, int lane) {
    f32x4 gv[4];
#pragma unroll
    for (int i = 0; i < 4; ++i) gv[i] = *(const f32x4*)(p.g_attn_pre + i * 256 + lane * 4);
    int row = gw; if (row >= TOK) return;
    f32x4 v[4], nv[4];
#pragma unroll
    for (int i = 0; i < 4; ++i) v[i] = *(const f32x4*)(xrow(p, row) + i * 256 + lane * 4);
    for (; row < TOK; row += nw) {
        const int nr = row + nw < TOK ? row + nw : row;
#pragma unroll
        for (int i = 0; i < 4; ++i) nv[i] = *(const f32x4*)(xrow(p, nr) + i * 256 + lane * 4);
        float ss = 0.f;
#pragma unroll
        for (int i = 0; i < 4; ++i) ss += v[i][0] * v[i][0] + v[i][1] * v[i][1] + v[i][2] * v[i][2] + v[i][3] * v[i][3];
        const float r = 1.0f / sqrtf(wave_sum(ss) / D + 1e-6f);
#pragma unroll
        for (int i = 0; i < 4; ++i) { const f32x4 g = gv[i];
            u32x2 o; o[0] = pk2(v[i][0] * r * g[0], v[i][1] * r * g[1]); o[1] = pk2(v[i][2] * r * g[2], v[i][3] * r * g[3]); *(u32x2*)(p.hb + (size_t)row * D + i * 256 + lane * 4) = o; }
#pragma unroll
        for (int i = 0; i < 4; ++i) v[i] = nv[i];
    }
}
DEV void post1(const P& p, int lo, int hi, int gw, int nw, int lane) {
    int row = lo + gw; if (row >= hi) return;
    f32x4 v[4], xv[4], nv[4], nx[4], ga[4], gf[4];
#pragma unroll
    for (int i = 0; i < 4; ++i) { ga[i] = *(const f32x4*)(p.g_attn_post + i * 256 + lane * 4); gf[i] = *(const f32x4*)(p.g_ffn_pre + i * 256 + lane * 4); }
#pragma unroll
    for (int i = 0; i < 4; ++i) { v[i] = ldb4(p.mixh + (size_t)row * D + i * 256 + lane * 4); xv[i] = *(const f32x4*)(xrow(p, row) + i * 256 + lane * 4); }
    for (; row < hi; row += nw) {
        const int nr = row + nw < hi ? row + nw : row;
#pragma unroll
        for (int i = 0; i < 4; ++i) { nv[i] = ldb4(p.mixh + (size_t)nr * D + i * 256 + lane * 4); nx[i] = *(const f32x4*)(xrow(p, nr) + i * 256 + lane * 4); }
        float ss = 0.f;
#pragma unroll
        for (int i = 0; i < 4; ++i) ss += v[i][0] * v[i][0] + v[i][1] * v[i][1] + v[i][2] * v[i][2] + v[i][3] * v[i][3];
        const float r1 = 1.0f / sqrtf(wave_sum(ss) / D + 1e-6f); float s2 = 0.f;
#pragma unroll
        for (int i = 0; i < 4; ++i) { const f32x4 g = ga[i];
            v[i] = xv[i] + v[i] * r1 * g; *(f32x4*)(p.x1 + (size_t)row * D + i * 256 + lane * 4) = v[i]; s2 += v[i][0] * v[i][0] + v[i][1] * v[i][1] + v[i][2] * v[i][2] + v[i][3] * v[i][3]; }
        const float r2 = 1.0f / sqrtf(wave_sum(s2) / D + 1e-6f);
#pragma unroll
        for (int i = 0; i < 4; ++i) { const f32x4 g = gf[i];
            u32x2 o; o[0] = pk2(v[i][0] * r2 * g[0], v[i][1] * r2 * g[1]); o[1] = pk2(v[i][2] * r2 * g[2], v[i][3] * r2 * g[3]); *(u32x2*)(p.h2b + (size_t)row * D + i * 256 + lane * 4) = o; }
#pragma unroll
        for (int i = 0; i < 4; ++i) { v[i] = nv[i]; xv[i] = nx[i]; }
    }
}
template <bool TWO>
DEV void post2(const P& p, int lo, int hi, int gw, int nw, int lane) {
    int row = lo + gw; if (row >= hi) return;
    f32x4 v[4], xv[4], nv[4], nx[4], gp[4];
#pragma unroll
    for (int i = 0; i < 4; ++i) gp[i] = *(const f32x4*)(p.g_ffn_post + i * 256 + lane * 4);
#pragma unroll
    for (int i = 0; i < 4; ++i) { v[i] = ldb4(p.fh + (size_t)row * D + i * 256 + lane * 4); if (TWO) v[i] += ldb4(p.fh2 + (size_t)(row - TOKP) * D + i * 256 + lane * 4); xv[i] = *(const f32x4*)(p.x1 + (size_t)row * D + i * 256 + lane * 4); }
    for (; row < hi; row += nw) {
        const int nr = row + nw < hi ? row + nw : row;
#pragma unroll
        for (int i = 0; i < 4; ++i) { nv[i] = ldb4(p.fh + (size_t)nr * D + i * 256 + lane * 4); if (TWO) nv[i] += ldb4(p.fh2 + (size_t)(nr - TOKP) * D + i * 256 + lane * 4); nx[i] = *(const f32x4*)(p.x1 + (size_t)nr * D + i * 256 + lane * 4); }
        float ss = 0.f;
#pragma unroll
        for (int i = 0; i < 4; ++i) ss += v[i][0] * v[i][0] + v[i][1] * v[i][1] + v[i][2] * v[i][2] + v[i][3] * v[i][3];
        const float r1 = 1.0f / sqrtf(wave_sum(ss) / D + 1e-6f);
        float* y = row < TOKP ? p.o_yp + (size_t)row * D : p.o_ys + (size_t)(row - TOKP) * D;
#pragma unroll
        for (int i = 0; i < 4; ++i) { const f32x4 g = gp[i]; *(f32x4*)(y + i * 256 + lane * 4) = xv[i] + v[i] * r1 * g; }
#pragma unroll
        for (int i = 0; i < 4; ++i) { v[i] = nv[i]; xv[i] = nx[i]; }
    }
}
DEV void hnorm(const P& p, int gw, int nw, int lane) {
    for (int row = gw; row < TOK; row += nw) {
        const float* x = p.hm_pre + (size_t)row * 512 + lane * 8; const f32x4 a = *(const f32x4*)x, b = *(const f32x4*)(x + 4);
        float ss = a[0] * a[0] + a[1] * a[1] + a[2] * a[2] + a[3] * a[3] + b[0] * b[0] + b[1] * b[1] + b[2] * b[2] + b[3] * b[3];
#pragma unroll
        for (int o = 8; o; o >>= 1) ss += __shfl_xor(ss, o);
        const float rr = 1.0f / sqrtf(ss / 128 + 1e-6f);
        const f32x4 g0 = *(const f32x4*)(p.g_mnorm + lane * 8), g1 = *(const f32x4*)(p.g_mnorm + lane * 8 + 4);
        u32x4 o; o[0] = pk2(a[0] * rr * g0[0], a[1] * rr * g0[1]); o[1] = pk2(a[2] * rr * g0[2], a[3] * rr * g0[3]); o[2] = pk2(b[0] * rr * g1[0], b[1] * rr * g1[1]); o[3] = pk2(b[2] * rr * g1[2], b[3] * rr * g1[3]);
        *(u32x4*)(p.mixb + (size_t)row * 1024 + 512 + lane * 8) = o;
    }
}
constexpr int WT_BYTES = 64 * 65 * 4;
template <bool PERM, int MAP = 0>
DEV void transpose_tile_w(PG8_LAS float* tl, const float* src, size_t lds_, int nr, int nc, act_t* dst, size_t ldd, int lane, int nbase = 0) {
#pragma unroll
    for (int i = 0; i < 16; ++i) { const int r = (lane >> 4) + 4 * i, c = (lane & 15) * 4;
        f32x4 v = {0.f, 0.f, 0.f, 0.f};
        if (r < nr && c < nc) v = *(const f32x4*)(src + (size_t)r * lds_ + c);
        tl[r * 65 + c] = v[0]; tl[r * 65 + c + 1] = v[1]; tl[r * 65 + c + 2] = v[2]; tl[r * 65 + c + 3] = v[3]; }
    __builtin_amdgcn_wave_barrier();
#pragma unroll
    for (int i = 0; i < 8; ++i) { const int c = (lane >> 3) + 8 * i, rb = (lane & 7) * 8;
        if (c < nc && rb < nr) {
            float v[8];
#pragma unroll
            for (int e = 0; e < 8; ++e) { const int pos = rb + e, r = PERM ? ((pos & ~15) | (pos & 3) | ((pos & 4) << 1) | ((pos & 8) >> 1)) : pos; v[e] = tl[r * 65 + c]; }
            u32x4 o; o[0] = pk2(v[0], v[1]); o[1] = pk2(v[2], v[3]); o[2] = pk2(v[4], v[5]); o[3] = pk2(v[6], v[7]);
            const int cd = MAP == 0 ? c : MAP == 3 ? pg8::remap_in(nbase + c) : (c + (MAP == 2 ? 128 : 0));
            *(u32x4*)(dst + (size_t)cd * ldd + rb) = o;
        } }
    __builtin_amdgcn_wave_barrier();
}
template <int MAP = 0>
DEV void weight_t(PG8_LAS float* lds0, const float* w, int K, int N, act_t* bt, int row0, int tid) {
    const int tk = K / 64, tn = (N + 63) / 64, wv = tid >> 6, lane = tid & 63; PG8_LAS float* tl = lds0 + wv * (WT_BYTES / 4);
    for (int t = (int)blockIdx.x * (NTHR_ / 64) + wv; t < tk * tn; t += (int)gridDim.x * (NTHR_ / 64)) { const int k0 = (t / tn) * 64, n0 = (t % tn) * 64;
        transpose_tile_w<false, MAP>(tl, w + (size_t)k0 * N + n0, N, 64, N - n0 < 64 ? N - n0 : 64, bt + (size_t)(row0 + (MAP == 3 ? 0 : MAP ? 256 * (n0 / 128) + (n0 % 128) : n0)) * K + k0, K, lane, n0); }
}
DEV void prep_prompt(const P& p, PG8_LAS float* lds0, int tid) {
    constexpr int NT = SEQ / 64; const int wv = tid >> 6, lane = tid & 63; PG8_LAS float* tl = lds0 + wv * (WT_BYTES / 4);
    for (int u = (int)blockIdx.x * (NTHR_ / 64) + wv; u < BATCH * 2 * NT * 2; u += (int)gridDim.x * (NTHR_ / 64)) {
        const int which = u & 1, tt = (u >> 1) % NT, bh = (u >> 1) / NT, b = bh >> 1, kvh = bh & 1;
        const float* src = which ? p.kvwf + (size_t)(b * SEQ + tt * 64) * 256 + 128 + kvh * 64 : p.o_kvp + (size_t)(b * SEQ + tt * 64) * 512 + 3 * 128 + kvh * 64;
        act_t* dst = (which ? p.vwt : p.vst) + (size_t)bh * 64 * SEQ + tt * 64;
        transpose_tile_w<true>(tl, src, which ? 256 : 512, 64, 64, dst, SEQ, lane);
    }
}
DEV void conv_rows(const P& p, int gw, int nw, int lane) {
    const int c0 = lane * 16;
    f32x4 wv[4][4], bv[4];
#pragma unroll
    for (int q = 0; q < 4; ++q) { bv[q] = *(const f32x4*)(p.conv_b + c0 + 4 * q);
#pragma unroll
        for (int j = 0; j < 4; ++j) wv[j][q] = *(const f32x4*)(p.conv_w + j * 1024 + c0 + 4 * q); }
    int row = gw; if (row >= TOK) return;
    u32x4 ta[4], tb[4], na[4], nb[4];
    auto ldt = [&](int rw, u32x4 (&A)[4], u32x4 (&B)[4]) {
        const int t = row_info(rw).t;
#pragma unroll
        for (int j = 0; j < 4; ++j) {
            if (t - 3 + j >= 0) { A[j] = *(const u32x4*)(p.mqkb + (size_t)(rw - 3 + j) * 1024 + c0); B[j] = *(const u32x4*)(p.mqkb + (size_t)(rw - 3 + j) * 1024 + c0 + 8); }
            else { A[j] = (u32x4){0u, 0u, 0u, 0u}; B[j] = (u32x4){0u, 0u, 0u, 0u}; } }
    };
    ldt(row, ta, tb);
    for (; row < TOK; row += nw) {
        const int nr = row + nw < TOK ? row + nw : row;
        ldt(nr, na, nb);
        const Row r = row_info(row);
        float acc[16];
#pragma unroll
        for (int q = 0; q < 4; ++q) { acc[4 * q] = bv[q][0]; acc[4 * q + 1] = bv[q][1]; acc[4 * q + 2] = bv[q][2]; acc[4 * q + 3] = bv[q][3]; }
#pragma unroll
        for (int j = 0; j < 4; ++j) { const int tt = r.t - 3 + j; float v[16];
#pragma unroll
            for (int e = 0; e < 4; ++e) { v[2 * e] = __uint_as_float(ta[j][e] << 16); v[2 * e + 1] = __uint_as_float(ta[j][e] & 0xffff0000u); v[8 + 2 * e] = __uint_as_float(tb[j][e] << 16); v[8 + 2 * e + 1] = __uint_as_float(tb[j][e] & 0xffff0000u); }
            if (tt < 0 && r.path) { const float* src = p.state_conv + ((size_t)r.b * 3 + (r.t + j)) * 1024 + c0;
#pragma unroll
                for (int q = 0; q < 4; ++q) { const f32x4 t = *(const f32x4*)(src + 4 * q); v[4 * q] = t[0]; v[4 * q + 1] = t[1]; v[4 * q + 2] = t[2]; v[4 * q + 3] = t[3]; } }
#pragma unroll
            for (int q = 0; q < 4; ++q) {
#pragma unroll
                for (int e = 0; e < 4; ++e) acc[4 * q + e] += v[4 * q + e] * wv[j][q][e]; } }
        const float sc = c0 >= 512 ? 0.08838834764831845f : 1.0f;
        u32x4 o[2];
#pragma unroll
        for (int q = 0; q < 4; ++q) { float v[4];
#pragma unroll
            for (int e = 0; e < 4; ++e) v[e] = acc[4 * q + e] * fsigmoid_(acc[4 * q + e]) * sc;
            o[q >> 1][(q & 1) * 2] = pk2(v[0], v[1]); o[q >> 1][(q & 1) * 2 + 1] = pk2(v[2], v[3]); }
        *(u32x4*)(p.qkb + (size_t)row * 1024 + c0) = o[0]; *(u32x4*)(p.qkb + (size_t)row * 1024 + c0 + 8) = o[1];
#pragma unroll
        for (int j = 0; j < 4; ++j) { ta[j] = na[j]; tb[j] = nb[j]; }
    }
}
DEV void out_kv_rows(const P& p, int gw, int nw, int lane) {
    for (int row = gw; row < TOK; row += nw) {
        const float* src = p.proj + (size_t)row * PROJ + C_KVP + lane * 8; float* dst = (row < TOKP ? p.o_kvp + (size_t)row * 512 : p.o_kvs + (size_t)(row - TOKP) * 512) + lane * 8;
        const f32x4 a = *(const f32x4*)src, b = *(const f32x4*)(src + 4); *(f32x4*)dst = a; *(f32x4*)(dst + 4) = b;
    }
}
DEV void cmpA_rows_s(const P& p, int gw, int nw, int lane) {
    const int j = lane >> 2, qd = lane & 3;
    for (int r = gw; r < 2 * CROWS_S; r += nw) {
        const int cidx = r % NCH_S, bh = (r / NCH_S) % (DB * 2), tensor = r / CROWS_S, b = bh >> 1, h = bh & 1, T = 16 * cidx + j;
        const float* src = p.cache_kv + ((((size_t)p.page_table[b * NPAGES + T / PAGE] * PAGE + T % PAGE) * 4 + tensor) * 128) + h * 64 + qd * 16;
        f32x4 v[4];
#pragma unroll
        for (int q = 0; q < 4; ++q) v[q] = *(const f32x4*)(src + 4 * q);
        u32x4 o0, o1; o0[0] = pk2(v[0][0], v[0][1]); o0[1] = pk2(v[0][2], v[0][3]); o0[2] = pk2(v[1][0], v[1][1]); o0[3] = pk2(v[1][2], v[1][3]);
        o1[0] = pk2(v[2][0], v[2][1]); o1[1] = pk2(v[2][2], v[2][3]); o1[2] = pk2(v[3][0], v[3][1]); o1[3] = pk2(v[3][2], v[3][3]);
        act_t* dst = p.cas + (size_t)r * 1024 + j * 64 + qd * 16; *(u32x4*)dst = o0; *(u32x4*)(dst + 8) = o1;
    }
}

DEV void cmp_const_w(const P& p, int gw, int nw, int lane) {
    for (int u = gw; u < 256; u += nw) {
        const int e = u % 128, tensor = u / 128; float acc = 0.f;
#pragma unroll 8
        for (int k = lane; k < 2048; k += 64) acc += p.cmp_pos[tensor * 2048 + k] * p.cmp_w1[((size_t)tensor * 2048 + k) * 128 + e];
        acc = wave_sum(acc);
        if (lane == 0) p.cmpc[u] = acc + p.cmp_b1[tensor * 128 + e];
    }
}
DEV void gates1(const P& p, int gw, int nw, int lane) {
    for (int ch = gw; ch < NCHUNK; ch += nw) {
        int path, b, c, r0, cl; chunk_info(ch, path, b, c, r0, cl);
        const bool act = lane < cl; const size_t row = r0 + (act ? lane : 0);
        const f32x4 iv4 = *(const f32x4*)(p.mif + row * 8), fv4 = *(const f32x4*)(p.mif + row * 8 + 4);
        float bs[4], ig[4];
#pragma unroll
        for (int h = 0; h < 4; ++h) { ig[h] = act ? iv4[h] : 0.f; bs[h] = act ? logsigmoidf_(fv4[h]) : 0.f; }
#pragma unroll
        for (int o = 1; o < 64; o <<= 1) {
#pragma unroll
            for (int h = 0; h < 4; ++h) { const float t = __shfl_up(bs[h], o); if (lane >= o) bs[h] += t; } }
        float bend[4], iv[4];
#pragma unroll
        for (int h = 0; h < 4; ++h) { bend[h] = __shfl(bs[h], cl - 1); iv[h] = act ? ig[h] + bend[h] - bs[h] : -INFINITY; }
#pragma unroll
        for (int o = 32; o; o >>= 1) {
#pragma unroll
            for (int h = 0; h < 4; ++h) iv[h] = fmaxf(iv[h], __shfl_xor(iv[h], o)); }
        if (act) *(f32x4*)(p.gb + row * 4) = (f32x4){bs[0], bs[1], bs[2], bs[3]};
        if (lane < 4) { const float be = lane == 0 ? bend[0] : lane == 1 ? bend[1] : lane == 2 ? bend[2] : bend[3], im = lane == 0 ? iv[0] : lane == 1 ? iv[1] : lane == 2 ? iv[2] : iv[3];
            p.cmap[((size_t)ch * 4 + lane) * 2] = be; p.cmap[((size_t)ch * 4 + lane) * 2 + 1] = im; }
    }
}
DEV void gates2(const P& p, int gw, int nw, int lane) {
    for (int u = gw; u < NSEQ * 4; u += nw) {
        const int h = u & 3, sq = u >> 2, path = sq < BATCH ? 0 : 1, b = path ? sq - BATCH : sq, nck = path ? 1 : NCKP, ch0 = path ? BATCH * NCKP + b : b * NCKP;
        const float m0 = path ? p.state_m[b * 4 + h] : 0.f;
        const int c0 = 2 * lane, c1 = 2 * lane + 1;
        float L0 = 0.f, I0 = -INFINITY, L1 = 0.f, I1 = -INFINITY;
        if (c0 < nck) { L0 = p.cmap[((size_t)(ch0 + c0) * 4 + h) * 2]; I0 = p.cmap[((size_t)(ch0 + c0) * 4 + h) * 2 + 1]; }
        if (c1 < nck) { L1 = p.cmap[((size_t)(ch0 + c1) * 4 + h) * 2]; I1 = p.cmap[((size_t)(ch0 + c1) * 4 + h) * 2 + 1]; }
        float L = L0 + L1, I = fmaxf(I0 + L1, I1);
#pragma unroll
        for (int o = 1; o < 64; o <<= 1) { const float pl = __shfl_up(L, o), pi = __shfl_up(I, o); if (lane >= o) { I = fmaxf(pi + L, I); L = pl + L; } }
        float eL = __shfl_up(L, 1), eI = __shfl_up(I, 1); if (lane == 0) { eL = 0.f; eI = -INFINITY; }
        const float mb0 = fmaxf(m0 + eL, eI), mb1 = fmaxf(mb0 + L0, I0);
        if (c0 < nck) p.mprev[(size_t)(ch0 + c0) * 4 + h] = mb0;
        if (c1 < nck) p.mprev[(size_t)(ch0 + c1) * 4 + h] = mb1;
        const float mfin = __shfl(fmaxf(m0 + L, I), 63);
        if (lane == 0) { if (path) p.o_ms[b * 4 + h] = mfin; else p.o_mp[b * 4 + h] = mfin; }
    }
}
DEV void gates3(const P& p, int gw, int nw, int lane) {
    for (int u = gw; u < NCHUNK * 4; u += nw) {
        const int h = u & 3, ch = u >> 2; int path, b, c, r0, cl; chunk_info(ch, path, b, c, r0, cl);
        const bool act = lane < cl; const size_t row = r0 + (act ? lane : 0);
        const float bs = act ? p.gb[row * 4 + h] : 0.f; float pm = act ? p.proj[row * PROJ + C_MIF + h] - bs : -INFINITY;
#pragma unroll
        for (int o = 1; o < 64; o <<= 1) { const float t = __shfl_up(pm, o); if (lane >= o) pm = fmaxf(pm, t); }
        if (act) p.gm[row * 4 + h] = bs + fmaxf(p.mprev[(size_t)ch * 4 + h], pm);
    }
}

DEV void cmp_combine(const P& p, int path, int gw, int nw, int lane) {
    typedef short bf16x8 __attribute__((ext_vector_type(8))); typedef float f32x16 __attribute__((ext_vector_type(16)));
    const int nch = path ? NCH_S : NCH_P, nb = path ? DB : BATCH; const act_t* C = path ? p.ccs : p.ccp; const size_t crows = path ? CROWS_S : CROWS_P;
    act_t* kc = path ? p.kcs : p.kc; act_t* vct = path ? p.vcts : p.vct;
    const int l32 = lane & 31, hh = lane >> 5, upr = nch / 32;
    for (int u = gw; u < 2 * nb * 2 * upr; u += nw) {
        const int c0 = (u % upr) * 32, bh = (u / upr) % (nb * 2), tensor = u / (upr * nb * 2), c = c0 + l32;
        const bool live = c < nch - 1;
        const act_t* lo = C + ((size_t)tensor * crows + (size_t)bh * nch + (live ? c : 0)) * 256; const act_t* hi = lo + 256 + 128;
        f32x16 o0, o1;
#pragma unroll
        for (int r = 0; r < 16; ++r) { o0[r] = 0.f; o1[r] = 0.f; }
#pragma unroll
        for (int half = 0; half < 2; ++half) {
            u32x2 ar[4][4]; f32x4 cv[4][2]; bf16x8 wf[4][2];
#pragma unroll
            for (int k4 = 0; k4 < 4; ++k4) { const int e0 = 16 * (half * 4 + k4) + 8 * hh;
                ar[k4][0] = *(const u32x2*)(lo + e0); ar[k4][1] = *(const u32x2*)(lo + e0 + 4); ar[k4][2] = *(const u32x2*)(hi + e0); ar[k4][3] = *(const u32x2*)(hi + e0 + 4);
                cv[k4][0] = *(const f32x4*)(p.cmpc + tensor * 128 + e0); cv[k4][1] = *(const f32x4*)(p.cmpc + tensor * 128 + e0 + 4);
                wf[k4][0] = *(const bf16x8*)(p.w2t + ((size_t)tensor * 64 + l32) * 128 + e0); wf[k4][1] = *(const bf16x8*)(p.w2t + ((size_t)tensor * 64 + 32 + l32) * 128 + e0); }
#pragma unroll
            for (int k4 = 0; k4 < 4; ++k4) {
                const f32x4 a0 = cvb4(ar[k4][0]), a1 = cvb4(ar[k4][1]), b0 = cvb4(ar[k4][2]), b1 = cvb4(ar[k4][3]);
                float hv[8];
#pragma unroll
                for (int e = 0; e < 4; ++e) { const float x0 = live ? a0[e] + b0[e] + cv[k4][0][e] : 0.f, x1 = live ? a1[e] + b1[e] + cv[k4][1][e] : 0.f; hv[e] = gelu_tanh(x0); hv[4 + e] = gelu_tanh(x1); }
                u32x4 q; q[0] = pk2(hv[0], hv[1]); q[1] = pk2(hv[2], hv[3]); q[2] = pk2(hv[4], hv[5]); q[3] = pk2(hv[6], hv[7]);
                const bf16x8 af = __builtin_bit_cast(bf16x8, q);
                o0 = __builtin_amdgcn_mfma_f32_32x32x16_bf16(af, wf[k4][0], o0, 0, 0, 0);
                o1 = __builtin_amdgcn_mfma_f32_32x32x16_bf16(af, wf[k4][1], o1, 0, 0, 0);
            }
        }
        const float bb0 = p.cmp_b2[tensor * 64 + l32], bb1 = p.cmp_b2[tensor * 64 + 32 + l32];
#pragma unroll
        for (int q = 0; q < 4; ++q) {
            const int cb = c0 + 8 * q + 4 * hh;
            float v0[4], v1[4];
#pragma unroll
            for (int e = 0; e < 4; ++e) { const bool lv = cb + e < nch - 1; v0[e] = lv ? o0[4 * q + e] + bb0 : 0.f; v1[e] = lv ? o1[4 * q + e] + bb1 : 0.f; }
            if (tensor == 0) {
#pragma unroll
                for (int e = 0; e < 4; ++e) { kc[((size_t)bh * nch + cb + e) * 64 + l32] = to_act(v0[e]); kc[((size_t)bh * nch + cb + e) * 64 + 32 + l32] = to_act(v1[e]); }
            } else {
                const int pos = perm16(cb);
                u32x2 w0; w0[0] = pk2(v0[0], v0[1]); w0[1] = pk2(v0[2], v0[3]); *(u32x2*)(vct + ((size_t)bh * 64 + l32) * nch + pos) = w0;
                u32x2 w1; w1[0] = pk2(v1[0], v1[1]); w1[1] = pk2(v1[2], v1[3]); *(u32x2*)(vct + ((size_t)bh * 64 + 32 + l32) * nch + pos) = w1;
            }
        }
    }
}
DEV void cmp_combine_s(const P& p, int gw, int nw, int lane) { cmp_combine(p, 1, gw, nw, lane); }
DEV void cmp_combine_p(const P& p, int gw, int nw, int lane) { cmp_combine(p, 0, gw, nw, lane); }
}

constexpr int NTHR = 512, LDS_BYTES = 147456, LDS_BAR_OFF = 147440;
DEV void run_gemm_proj(PG8_LAS unsigned char* lds, const P& p) {
    pg8::Gemm g{p.hb, p.bt_in, TOK, PROJP, D}; pg8::StaticOrder S; S.init(TOK, PROJP, (int)gridDim.x, (int)blockIdx.x);
    pg8::EpiProj E{p.b_in, p.qb, p.kvb, p.kwb, p.mqkb, p.mvb, p.mob, p.o_kvp, p.o_kvs, p.kvwf, p.gatef, p.mif, p.o_convp, p.o_convs, 0.125f * LOG2E};
    pg8::gemm_phase<pg8::EpiProj, pg8::StaticOrder>(lds, g, S, E);
}
DEV void run_gemm_b16(PG8_LAS unsigned char* lds, const act_t* A, const act_t* Bt, int M, int N, int K, act_t* O, int ldo, int rot = 0, int ld = 0) {
    pg8::Gemm g{A, Bt, M, N, K, ld}; pg8::StaticOrder S; S.init(M, N, (int)gridDim.x, ((int)blockIdx.x + (int)gridDim.x - rot) % (int)gridDim.x);
    pg8::EpiB16 E{O, ldo};
    pg8::gemm_phase<pg8::EpiB16, pg8::StaticOrder>(lds, g, S, E);
}
DEV void run_gemm_swiglu(PG8_LAS unsigned char* lds, const act_t* A, const act_t* Bt, int M, int N, int K, act_t* O, int ldo) {
    pg8::Gemm g{A, Bt, M, N, K}; pg8::StaticOrder S; S.init(M, N, (int)gridDim.x, (int)blockIdx.x);
    pg8::EpiSwiglu E{O, ldo};
    pg8::gemm_phase<pg8::EpiSwiglu, pg8::StaticOrder>(lds, g, S, E);
}
DEV void run_gemm(PG8_LAS unsigned char* lds, const act_t* A, const act_t* Bt, int M, int N, int K, float* C, int ldc, const float* bias, int ncols, int rot = 0) {
    pg8::Gemm g{A, Bt, M, N, K}; pg8::StaticOrder S; S.init(M, N, (int)gridDim.x, ((int)blockIdx.x + (int)gridDim.x - rot) % (int)gridDim.x);
    pg8::EpiF32 E{C, ldc, bias, ncols};
    pg8::gemm_phase<pg8::EpiF32, pg8::StaticOrder>(lds, g, S, E);
}


namespace cmps {
using att::bf16x8; using att::f32x16; using att::tile_load; using att::tile_store; using att::frag;
typedef float f32x4 __attribute__((ext_vector_type(4)));
typedef unsigned u32x4 __attribute__((ext_vector_type(4)));
typedef unsigned u32x2 __attribute__((ext_vector_type(2)));
constexpr int NUNIT = 2 * CROWS_S / 256, L_Q = 65536;
static_assert(NCH_S % 32 == 0 && CROWS_S % 256 == 0 && 16 * NCH_S <= PAST && PAGE == 128, "sample compression shapes");
DEV void unit(const P& p, PG8_LAS unsigned char* lds, int u) {
    const int tid = fresh_tid(), lane = tid & 63, l32 = lane & 31, h = lane >> 5, wid = __builtin_amdgcn_readfirstlane(tid >> 6), xr = l32 & 7;
    const int tensor = u / (CROWS_S / 256), r = (u % (CROWS_S / 256)) * 256 + wid * 32 + l32;
    const int bh = r / NCH_S, cidx = r % NCH_S, b = bh >> 1, kvh = bh & 1;
    const int page = p.page_table[b * NPAGES + (cidx >> 3)];
    const float* arow = p.cache_kv + (((size_t)page * PAGE + 16 * (cidx & 7)) * 4 + tensor) * 128 + kvh * 64 + h * 32;
    const act_t* wsrc = p.btc + (size_t)tensor * 256 * 1024;
    f32x16 acc[8];
#pragma unroll
    for (int ct = 0; ct < 8; ++ct)
#pragma unroll
        for (int i = 0; i < 16; ++i) acc[ct][i] = 0.f;
    f32x4 xa[8]; u32x4 wreg[4];
#pragma unroll
    for (int q = 0; q < 8; ++q) xa[q] = *(const f32x4*)(arow + 4 * q);
#pragma unroll
    for (int q = 0; q < 4; ++q) wreg[q] = tile_load(wsrc + (size_t)q * 64 * 1024, 1024, tid);
#pragma unroll
    for (int q = 0; q < 4; ++q) tile_store(lds + q * 8192, wreg[q], tid);
    __syncthreads();
    int cur = 0;
#pragma unroll 1
    for (int j = 0; j < 16; ++j) {
        bf16x8 xf[4];
#pragma unroll
        for (int ks = 0; ks < 4; ++ks) { u32x4 t; t[0] = pkbf(xa[2 * ks][0], xa[2 * ks][1]); t[1] = pkbf(xa[2 * ks][2], xa[2 * ks][3]); t[2] = pkbf(xa[2 * ks + 1][0], xa[2 * ks + 1][1]); t[3] = pkbf(xa[2 * ks + 1][2], xa[2 * ks + 1][3]);
            xf[ks] = __builtin_bit_cast(bf16x8, t); }
        const bool more = j < 15;
        if (more) {
#pragma unroll
            for (int q = 0; q < 8; ++q) xa[q] = *(const f32x4*)(arow + (size_t)(j + 1) * 512 + 4 * q);
#pragma unroll
            for (int q = 0; q < 4; ++q) wreg[q] = tile_load(wsrc + (size_t)q * 64 * 1024 + (j + 1) * 64, 1024, tid);
        }
        const PG8_LAS unsigned char* wb = lds + cur * 32768;
#pragma unroll
        for (int ks = 0; ks < 4; ++ks)
#pragma unroll
            for (int ct = 0; ct < 8; ++ct) acc[ct] = MFMA32(frag(wb, ct * 32 + l32, 4 * h + ks, xr), xf[ks], acc[ct]);
        if (more) {
#pragma unroll
            for (int q = 0; q < 4; ++q) tile_store(lds + (cur ^ 1) * 32768 + q * 8192, wreg[q], tid);
        }
        __syncthreads();
        cur ^= 1;
    }
    act_t* orow = p.ccs + ((size_t)tensor * CROWS_S + r) * 256 + 4 * h;
#pragma unroll
    for (int ct = 0; ct < 8; ++ct)
#pragma unroll
        for (int q = 0; q < 4; ++q) { u32x2 w; w[0] = pkbf(acc[ct][4 * q], acc[ct][4 * q + 1]); w[1] = pkbf(acc[ct][4 * q + 2], acc[ct][4 * q + 3]); *(u32x2*)(orow + ct * 32 + 8 * q) = w; }
}
DEV void phase(const P& p, PG8_LAS unsigned char* lds, unsigned* counter) {
    for (;;) {
        if (threadIdx.x == 0) *(PG8_LAS unsigned*)(lds + L_Q) = atomicAdd(counter, 1u);
        __syncthreads();
        const int u = (int)*(const volatile PG8_LAS unsigned*)(lds + L_Q);
        __syncthreads();
        if (u >= NUNIT) break;
        unit(p, lds, u);
    }
}
}

struct MP { P p; unsigned* bar; };
#define PH(F, total) do { const int _tid = fresh_tid(); const long _t = (total); for (long gid = (long)blockIdx.x * NTHR + _tid; gid < _t; gid += (long)gridDim.x * NTHR) F(p, gid); } while (0)
#define COOP(fn) do { const int _tid = fresh_tid(); fn(p, (int)blockIdx.x * (NTHR / 64) + (_tid >> 6), (int)gridDim.x * (NTHR / 64), _tid & 63); } while (0)
#define BAR() xcd_barrier(xb)
__global__ void __launch_bounds__(NTHR, 2) k_mega(MP mp) {
    extern __shared__ __attribute__((aligned(16))) unsigned char shm[];
    PG8_LAS unsigned char* lds = (PG8_LAS unsigned char*)shm;
    const P& p = mp.p;
    if (threadIdx.x < 4) ((PG8_LAS unsigned*)(lds + LDS_BAR_OFF))[threadIdx.x] = 0u;
    __syncthreads();
    XcdBarrier xb = xcd_barrier_post(mp.bar, (volatile LAS unsigned*)(lds + LDS_BAR_OFF));
    PG8_LAS float* tl = (PG8_LAS float*)lds;
#ifndef DUP_MASK
#define DUP_MASK 0
#endif
#define REP(bit) for (int _rep = 0; _rep < 1 + 4 * ((DUP_MASK >> (bit)) & 1); ++_rep)
    REP(0) {
    COOP(coop::rmsnorm_in);
    __syncthreads();
    coop::weight_t<3>(tl, p.w_in, D, PROJ, p.bt_in, 0, fresh_tid()); PH(b_wt_inpad, (long)(PROJP - PROJ) * D);
    coop::weight_t(tl, p.w_out, 1024, D, p.bt_out, 0, fresh_tid());
    coop::weight_t<1>(tl, p.w_gate, D, DFF, p.bt_gu, 0, fresh_tid()); coop::weight_t<2>(tl, p.w_up, D, DFF, p.bt_gu, 0, fresh_tid());
    coop::weight_t(tl, p.w_down, DFF, D, p.bt_down, 0, fresh_tid());
    for (int ts = 0; ts < 2; ++ts) {
        coop::weight_t(tl, p.cmp_w1 + (size_t)ts * 2048 * 128, 1024, 128, p.btc + (size_t)ts * 256 * 1024, 0, fresh_tid());
        coop::weight_t(tl, p.cmp_w1 + (size_t)ts * 2048 * 128 + 1024 * 128, 1024, 128, p.btc + (size_t)ts * 256 * 1024, 128, fresh_tid());
    }
    COOP(coop::cmp_const_w); PH(b_w2t, 2 * 64 * 128);
    __syncthreads();
    }
    BAR();
    REP(2) {
    run_gemm_proj(lds, p);
    }
    cmps::phase(p, lds, mp.bar + CMPS_CNT_WORD);
    BAR();
    REP(4) {
    COOP(coop::gates1);
    PH(g_out_winp, (long)BATCH * WBP * 64); PH(g_out_wins, (long)DB * WBS * 64);
    PH(b_cmpA_p, (long)2 * CROWS_P * 128); COOP(coop::conv_rows);
    __syncthreads(); coop::prep_prompt(p, tl, fresh_tid()); __syncthreads();
    }
    REP(5) { COOP(coop::cmp_combine_s); }
    BAR();
    REP(16) { COOP(coop::gates2); }
    REP(9) {
    for (int u = (int)gridDim.x - 1 - (int)blockIdx.x; u < DB * 2 * atts::NPART; u += gridDim.x) atts::unit(p, lds, (u / atts::NPART) >> 1, (u / atts::NPART) & 1, u % atts::NPART);
    }
    REP(17) {
    for (int ts = 0; ts < 2; ++ts) run_gemm_b16(lds, p.cap + (size_t)ts * CROWS_P * 1024, p.btc + (size_t)ts * 256 * 1024, CROWS_P, 256, 1024, p.ccp + (size_t)ts * CROWS_P * 256, 256, 64 + 64 * ts);
    }
    BAR();
    REP(18) { const int t_ = fresh_tid(); const int g_ = ((int)blockIdx.x - (int)gridDim.x / 2) * (NTHR / 64) + (t_ >> 6); if (g_ >= 0) coop::cmp_combine_p(p, g_, ((int)gridDim.x / 2) * (NTHR / 64), t_ & 63); }
    REP(19) { const int t_ = fresh_tid(); const int g_ = ((int)blockIdx.x - ((int)gridDim.x - 8)) * (NTHR / 64) + (t_ >> 6); if (g_ >= 0) atts::finish(p, g_, 8 * (NTHR / 64), t_ & 63); }
    REP(6) {
    mls::phase_a(p, lds);
    }
    BAR();
    REP(7) { PH(b_scan3, (long)NSEQ * 16384); }
    BAR();
    REP(8) {
    mls::phase_b(p, lds);
    }
    REP(10) {
        constexpr int NT = SEQ / 64, NU = BATCH * 2 * NT;
        int tab_kvh = -1;
        for (int u = blockIdx.x; u < NU; u += gridDim.x) {
            const int k = u / (int)gridDim.x, per = (int)gridDim.x, lin = u % per;
            constexpr int NC8 = BATCH * 2;
            const int slot = lin / NC8, nslot = per / NC8;
            const int idx = k * per + ((k & 1) ? (nslot - 1 - slot) : slot) * NC8 + lin % NC8;
            if (idx < NU) { att::unit(p, lds, (idx % NC8) >> 1, idx & 1, idx / NC8, (idx & 1) != tab_kvh); tab_kvh = idx & 1; }
        }
    }
    BAR();
    constexpr int NSW = 4;
    const bool sw = (int)blockIdx.x < NSW; const int wgw = ((int)blockIdx.x - NSW) * (NTHR / 64), wnw = ((int)gridDim.x - NSW) * (NTHR / 64);
    REP(11) { run_gemm_b16(lds, p.mixb, p.bt_out, TOKP, D, 1024, p.mixh, D); }
    BAR();
    REP(12) {
        if (sw) run_gemm_b16(lds, p.mixb + (size_t)TOKP * 1024, p.bt_out, TOKS, D, 1024, p.mixh + (size_t)TOKP * D, D);
        else { const int t_ = fresh_tid(); coop::post1(p, 0, TOKP, wgw + (t_ >> 6), wnw, t_ & 63); }
    }
    BAR();
    REP(13) {
        { const int t_ = fresh_tid(); coop::post1(p, TOKP, TOK, (int)blockIdx.x * (NTHR / 64) + (t_ >> 6), (int)gridDim.x * (NTHR / 64), t_ & 63); }
        run_gemm_swiglu(lds, p.h2b, p.bt_gu, TOKP, 2 * DFF, D, p.actb, DFF);
    }
    BAR();
    REP(14) {
        run_gemm_swiglu(lds, p.h2b + (size_t)TOKP * D, p.bt_gu, TOKS, 2 * DFF, D, p.actb + (size_t)TOKP * DFF, DFF);
        run_gemm_b16(lds, p.actb, p.bt_down, TOKP, D, DFF, p.fh, D);
    }
    BAR();
    REP(15) {
        static_assert((DFF / 2) % 128 == 0, "K-half of the down projection");
        if ((int)blockIdx.x < NSW) run_gemm_b16(lds, p.actb + (size_t)TOKP * DFF, p.bt_down, TOKS, D, DFF / 2, p.fh + (size_t)TOKP * D, D, 0, DFF);
        else if ((int)blockIdx.x < 2 * NSW) run_gemm_b16(lds, p.actb + (size_t)TOKP * DFF + DFF / 2, p.bt_down + DFF / 2, TOKS, D, DFF / 2, p.fh2, D, NSW, DFF);
        else { const int t_ = fresh_tid(); coop::post2<false>(p, 0, TOKP, ((int)blockIdx.x - 2 * NSW) * (NTHR / 64) + (t_ >> 6), ((int)gridDim.x - 2 * NSW) * (NTHR / 64), t_ & 63); }
    }
    BAR();
    { const int t_ = fresh_tid(); coop::post2<true>(p, TOKP, TOK, (int)blockIdx.x * (NTHR / 64) + (t_ >> 6), (int)gridDim.x * (NTHR / 64), t_ & 63); }
}
#else
#define RUN(F, total) do { long _t = (total); _Pragma("omp parallel for schedule(dynamic, 64)") for (long g = 0; g < _t; ++g) F(p, g); } while (0)
static void cpu_gemm(const float* A, const float* B, const float* bias, float* C, int M, int N, int K) {
#pragma omp parallel for
    for (int m = 0; m < M; ++m) {
        for (int n = 0; n < N; ++n) C[(size_t)m * N + n] = bias ? bias[n] : 0.f;
        for (int k = 0; k < K; ++k) { const float a = A[(size_t)m * K + k]; for (int n = 0; n < N; ++n) C[(size_t)m * N + n] += a * B[(size_t)k * N + n]; }
    }
}
#define GEMM(A, B, bias, C, M, N, K) cpu_gemm(A, B, bias, C, M, N, K)
#endif
}

extern "C" void kernel_launch(void* const* d_in, const int* in_sizes, int n_in, void* d_out, int out_size, void* d_ws, size_t ws_size, hipStream_t stream) {
    P p{};
    p.x_prompt = (const float*)d_in[0]; p.x_sample = (const float*)d_in[1]; p.cache_kv = (const float*)d_in[2]; p.cache_win = (const float*)d_in[3];
    p.state_conv = (const float*)d_in[4]; p.state_C = (const float*)d_in[5]; p.state_n = (const float*)d_in[6]; p.state_m = (const float*)d_in[7];
    p.page_table = (const int*)d_in[8]; p.rel_bias = (const float*)d_in[9]; p.g_attn_pre = (const float*)d_in[10]; p.w_in = (const float*)d_in[11];
    p.b_in = (const float*)d_in[12]; p.cmp_pos = (const float*)d_in[13]; p.cmp_w1 = (const float*)d_in[14]; p.cmp_b1 = (const float*)d_in[15];
    p.cmp_w2 = (const float*)d_in[16]; p.cmp_b2 = (const float*)d_in[17]; p.conv_w = (const float*)d_in[18]; p.conv_b = (const float*)d_in[19];
    p.g_mnorm = (const float*)d_in[20]; p.w_out = (const float*)d_in[21]; p.g_attn_post = (const float*)d_in[22]; p.g_ffn_pre = (const float*)d_in[23];
    p.w_gate = (const float*)d_in[24]; p.w_up = (const float*)d_in[25]; p.w_down = (const float*)d_in[26]; p.g_ffn_post = (const float*)d_in[27];
    float* o = (float*)d_out;
    p.o_yp = o; o += (size_t)TOKP * D; p.o_ys = o; o += (size_t)TOKS * D; p.o_kvp = o; o += (size_t)TOKP * 512; p.o_kvs = o; o += (size_t)TOKS * 512;
    p.o_winp = o; o += (size_t)BATCH * WBP * 256; p.o_wins = o; o += (size_t)DB * WBS * 256; p.o_convp = o; o += (size_t)BATCH * 3072; p.o_convs = o; o += (size_t)DB * 3072;
    p.o_Cp = o; o += (size_t)BATCH * 65536; p.o_Cs = o; o += (size_t)DB * 65536; p.o_np = o; o += (size_t)BATCH * 512; p.o_ns = o; o += (size_t)DB * 512;
    p.o_mp = o; o += BATCH * 4; p.o_ms = o; o += DB * 4;
    float* w = (float*)d_ws + 4096;
    auto take = [&](size_t n) { float* r = w; w += (n + 63) / 64 * 64; return r; };
#ifdef CPU_EMU
    p.h = take((size_t)TOK * D); p.proj = take((size_t)TOK * PROJ); p.hid = take((size_t)(CMPROWS_P + CMPROWS_S) * 128); p.kcmp = take((size_t)(CMPROWS_P + CMPROWS_S) * 64);
    p.ml = take((size_t)TOK * 16); p.imp = take((size_t)TOK * 2 * NSB_MAX); p.idx = (int*)take((size_t)TOK * 32);
    p.mixin = take((size_t)TOK * 1024); p.qk = take((size_t)TOK * 1024); p.gm = take((size_t)TOK * 4);
    p.dC = take((size_t)NCHUNK * 65536); p.S = take((size_t)TOK * 256); p.hm_pre = take((size_t)TOK * 512);
    p.h2 = take((size_t)TOK * D); p.gate = take((size_t)TOK * 2 * DFF); p.up = p.gate; p.cprev = nullptr;
#endif
    p.oc = take((size_t)TOK * 512); p.gb = take((size_t)TOK * 4); p.dn = take((size_t)NCHUNK * 512);
    p.mix = take((size_t)TOK * D); p.x1 = take((size_t)TOK * D); p.f = take((size_t)TOK * D);
    auto takeb = [&](size_t n) { return (act_t*)take((n * sizeof(act_t) + 3) / 4); };
    p.hb = takeb((size_t)TOK * D); p.mixb = takeb((size_t)TOK * 1024); p.h2b = takeb((size_t)TOK * D); p.actb = takeb((size_t)TOK * DFF);
    p.qb = takeb((size_t)TOK * 512); p.kcs = takeb((size_t)DB * 2 * NCSPAD * 64); p.vcts = takeb((size_t)DB * 2 * NCSPAD * 64); p.vst = takeb((size_t)TOKP * 128); p.vwt = takeb((size_t)TOKP * 128);
    p.kc = takeb((size_t)BATCH * 2 * NCPAD * 64); p.vct = takeb((size_t)BATCH * 2 * NCPAD * 64);
    p.cmap = take((size_t)NCHUNK * 8); p.mprev = take((size_t)NCHUNK * 4); p.nprev = take((size_t)NCHUNK * 512);
    p.kvb = takeb((size_t)TOK * 512); p.kwb = takeb((size_t)TOK * 256); p.kvwf = take((size_t)TOK * 256); p.gatef = take((size_t)TOK * 32);
    p.mqkb = takeb((size_t)TOK * 1024); p.mvb = takeb((size_t)TOK * 512); p.mif = take((size_t)TOK * 8); p.mob = takeb((size_t)TOK * 512);
    p.mixh = takeb((size_t)TOK * D); p.fh = takeb((size_t)TOK * D); p.fh2 = takeb((size_t)TOKS * D);
    p.w2t = takeb((size_t)2 * 64 * 128);
    p.cas = takeb((size_t)2 * CROWS_S * 1024); p.cap = takeb((size_t)2 * CROWS_P * 1024); p.btc = takeb((size_t)2 * 256 * 1024);
    p.ccs = takeb((size_t)2 * CROWS_S * 256); p.ccp = takeb((size_t)2 * CROWS_P * 256); p.cmpc = take(256);
    p.qkb = takeb((size_t)TOK * 1024); p.dct = takeb((size_t)NCHUNK * 65536); p.cpt = takeb((size_t)NCHUNK * 65536);
    p.spart = take((size_t)DB * 2 * 4 * 2 * 64 * 34);
    p.bt_in = takeb((size_t)PROJP * D); p.bt_out = takeb((size_t)D * 1024); p.bt_gu = takeb((size_t)2 * DFF * D); p.bt_down = takeb((size_t)D * DFF);

#ifdef CPU_EMU
    p.cprev = p.dC; p.nprev = p.dn;
    RUN(b_rmsnorm_in, TOK);
    GEMM(p.hb, p.w_in, p.b_in, p.proj, TOK, PROJ, D);
    RUN(b_out_kv, (long)TOK * 512); RUN(b_out_winp, (long)BATCH * WBP * 256); RUN(b_out_wins, (long)DB * WBS * 256); RUN(b_out_conv, (long)NSEQ * 3072);
    RUN(b_cmp_hid, (CMPROWS_P + CMPROWS_S) * 128); RUN(b_cmp_out, (CMPROWS_P + CMPROWS_S) * 64);
    RUN(b_cmp_attn, (long)8 * TOK); RUN(b_imp, (long)TOK * 2 * NSB_MAX); RUN(b_topk, (long)TOK * 2); RUN(b_sel_win, (long)8 * TOK);
    RUN(b_conv, (long)TOK * 1024); RUN(b_gates, (long)NSEQ * 4); RUN(b_dC, (long)NCHUNK * 65536); RUN(b_scan, (long)NSEQ * 65536);
    RUN(b_S, (long)TOK * 256); RUN(b_hout, (long)TOK * 512); RUN(b_hnorm, (long)TOK * 4);
    GEMM(p.mixb, p.w_out, (const float*)nullptr, p.mix, TOK, D, 1024);
    RUN(b_post1, TOK);
    { float* g2 = p.gate;
      std::vector<float> tg((size_t)TOK * DFF), tu((size_t)TOK * DFF);
      GEMM(p.h2b, p.w_gate, (const float*)nullptr, tg.data(), TOK, DFF, D); GEMM(p.h2b, p.w_up, (const float*)nullptr, tu.data(), TOK, DFF, D);
      for (long r = 0; r < TOK; ++r) for (int c = 0; c < DFF; ++c) { g2[r * 2 * DFF + c] = tg[r * DFF + c]; g2[r * 2 * DFF + DFF + c] = tu[r * DFF + c]; } }
    RUN(b_swiglu, (long)TOK * DFF);
    GEMM(p.actb, p.w_down, (const float*)nullptr, p.f, TOK, D, DFF);
    RUN(b_post2, TOK);
#else
    static int grid = 0;
    if (grid == 0) {
        int dev = 0, cus = 0, per_cu = 0;
        if (hipGetDevice(&dev) != hipSuccess || hipDeviceGetAttribute(&cus, hipDeviceAttributeMultiprocessorCount, dev) != hipSuccess) { grid = -1; return; }
        if (hipFuncSetAttribute((const void*)k_mega, hipFuncAttributeMaxDynamicSharedMemorySize, LDS_BYTES) != hipSuccess) { grid = -1; return; }
        if (hipOccupancyMaxActiveBlocksPerMultiprocessor(&per_cu, (const void*)k_mega, NTHR, LDS_BYTES) != hipSuccess || per_cu < 1) (void)hipGetLastError();
        grid = cus;
    }
    if (grid < 0) return;
    (void)hipMemsetAsync(d_ws, 0, WS_ZERO_BYTES, stream);
    MP mp{}; mp.p = p; mp.bar = (unsigned*)d_ws;
    hipLaunchKernelGGL(k_mega, dim3(grid), dim3(NTHR), LDS_BYTES, stream, mp);
#endif
}
```

```cpp
#ifndef CPU_EMU
#include <hip/hip_runtime.h>
#else
#include <cmath>
#include <cstddef>
#include <vector>
#define __device__
#define __forceinline__ inline
typedef void* hipStream_t;
#endif
#include <stdint.h>

#ifndef CFG_D_MODEL
#define CFG_D_MODEL 1024
#define CFG_BATCH 4
#define CFG_SEQ 8192
#define CFG_DEC_BATCH 32
#define CFG_PAST_LEN 16384
#endif

namespace {
#ifdef CPU_EMU
typedef float act_t;
static inline act_t to_act(float f) { return f; }
#else
typedef unsigned short act_t;
typedef __bf16 hbf16v2_ __attribute__((ext_vector_type(2)));
typedef float hf32v2_ __attribute__((ext_vector_type(2)));
__device__ __forceinline__ unsigned pkbf(float lo, float hi) { hf32v2_ v = {lo, hi}; hbf16v2_ r = __builtin_convertvector(v, hbf16v2_); return __builtin_bit_cast(unsigned, r); }
__device__ __forceinline__ act_t to_act(float f) { return (act_t)(pkbf(f, 0.f) & 0xffffu); }
#endif
constexpr int D = CFG_D_MODEL, BATCH = CFG_BATCH, SEQ = CFG_SEQ, DB = CFG_DEC_BATCH, DS = 8, PAST = CFG_PAST_LEN;
constexpr int PAGE = 128, NPAGES = PAST / PAGE;
constexpr int TOKP = BATCH * SEQ, TOKS = DB * DS, TOK = TOKP + TOKS;
constexpr int PROJ = 3360, PROJP = 3584;
constexpr int DFF = ((-(-(8 * D) / 3)) + 255) / 256 * 256;
constexpr int C_Q = 0, C_KVP = 512, C_KVW = 1024, C_GATE = 1280, C_MQK = 1304, C_MV = 2328, C_MIF = 2840, C_MO = 2848;
constexpr int NC_P = SEQ / 16 - 1, NC_S = (PAST + DS) / 16 - 1;
constexpr int NSB_P = SEQ / 64, NSB_S = (PAST + DS + 63) / 64;
constexpr int NSB_MAX = NSB_P > NSB_S ? NSB_P : NSB_S;
constexpr int WBP = SEQ < 512 ? SEQ : 512, WBS = PAST < 512 ? PAST : 512;
constexpr int CLP = 64, NCKP = SEQ / CLP;
constexpr int NSEQ = BATCH + DB;
constexpr int NCHUNK = BATCH * NCKP + DB;
static_assert(SEQ % 128 == 0 && PAST % 128 == 0 && PAST >= 512 && DS == 8, "shape assumptions");
constexpr float NEGBIG = -1e9f, POSBIG = 1e9f;

struct P {
    const float *x_prompt, *x_sample, *cache_kv, *cache_win, *state_conv, *state_C, *state_n, *state_m;
    const int* page_table;
    const float *rel_bias, *g_attn_pre, *w_in, *b_in, *cmp_pos, *cmp_w1, *cmp_b1, *cmp_w2, *cmp_b2, *conv_w, *conv_b, *g_mnorm, *w_out,
        *g_attn_post, *g_ffn_pre, *w_gate, *w_up, *w_down, *g_ffn_post;
    float *o_yp, *o_ys, *o_kvp, *o_kvs, *o_winp, *o_wins, *o_convp, *o_convs, *o_Cp, *o_Cs, *o_np, *o_ns, *o_mp, *o_ms;
    float *h, *proj, *hid, *kcmp, *oc, *ml, *imp, *mixin, *qk, *gb, *gm, *dC, *dn, *S, *hm_pre, *mix, *x1, *h2, *gate, *up, *f;
    int* idx;
    float *cmap, *mprev, *cprev, *nprev, *spart;
    act_t *hb, *mixb, *h2b, *actb, *bt_in, *bt_out, *bt_gu, *bt_down;
    act_t *qb, *ks, *vst, *kw, *vwt, *kc, *vct, *kcs, *vcts;
    act_t *qkb, *dct, *cpt;
    act_t *kvb, *kwb, *mqkb, *mvb, *mob; float *kvwf, *gatef, *mif;
    act_t *mixh, *fh, *fh2;
    act_t *w2t;
    act_t *cas, *cap, *btc, *ccs, *ccp; float *cmpc;
};

#define DEV __device__ __forceinline__

struct Row { int path, b, t, pos; };
DEV Row row_info(int row) {
    Row r;
    if (row < TOKP) { r.path = 0; r.b = row / SEQ; r.t = row % SEQ; r.pos = r.t; }
    else { int q = row - TOKP; r.path = 1; r.b = q / DS; r.t = q % DS; r.pos = PAST + r.t; }
    return r;
}
DEV const float* xrow(const P& p, int row) { return row < TOKP ? p.x_prompt + (size_t)row * D : p.x_sample + (size_t)(row - TOKP) * D; }
DEV int seq_row0(int path, int b) { return path == 0 ? b * SEQ : TOKP + b * DS; }
DEV const float* kv_ptr(const P& p, int path, int b, int tpos, int which, int h) {
    if (path == 0) return p.proj + (size_t)(b * SEQ + tpos) * PROJ + C_KVP + which * 128 + h * 64;
    if (tpos < PAST) { int pg = p.page_table[b * NPAGES + tpos / PAGE]; return p.cache_kv + (((size_t)pg * PAGE + tpos % PAGE) * 4 + which) * 128 + h * 64; }
    return p.proj + (size_t)(TOKP + b * DS + (tpos - PAST)) * PROJ + C_KVP + which * 128 + h * 64;
}
DEV int rel_bucket(int n) {
    if (n < 16) return n;
    return 16 + (n >= 21) + (n >= 27) + (n >= 35) + (n >= 46) + (n >= 59) + (n >= 77) + (n >= 99) + (n >= 128) + (n >= 166) + (n >= 216) + (n >= 280) +
           (n >= 363) + (n >= 470) + (n >= 609) + (n >= 790);
}
DEV float sigmoidf_(float x) { return 1.0f / (1.0f + expf(-x)); }
DEV float siluf_(float x) { return x * sigmoidf_(x); }
DEV float fsigmoid_(float x) { return __builtin_amdgcn_rcpf(1.0f + __builtin_amdgcn_exp2f(x * -1.4426950408889634f)); }
DEV float logsigmoidf_(float x) { return fminf(x, 0.0f) - log1pf(expf(-fabsf(x))); }
#ifdef CPU_EMU
DEV float gelu_tanh(float x) { return 0.5f * x * (1.0f + tanhf(0.7978845608028654f * (x + 0.044715f * x * x * x))); }
#else
DEV float gelu_tanh(float x) { return x * fsigmoid_(1.5957691216057308f * (x + 0.044715f * x * x * x)); }
#endif
#ifdef CPU_EMU
#define SCHED_FENCE()
#else
#define SCHED_FENCE() __builtin_amdgcn_sched_barrier(0)
#endif
DEV float dot64(const float* q, const float* k) {
    float s = 0.f;
#pragma unroll
    for (int c = 0; c < 4; ++c) {
#pragma unroll
        for (int d = 0; d < 16; ++d) s += q[c * 16 + d] * k[c * 16 + d];
        SCHED_FENCE();
    }
    return s;
}
DEV void axpy64(float* acc, float a, float e, const float* v) {
#pragma unroll
    for (int c = 0; c < 4; ++c) {
#pragma unroll
        for (int d = 0; d < 16; ++d) acc[c * 16 + d] = acc[c * 16 + d] * a + e * v[c * 16 + d];
        SCHED_FENCE();
    }
}
DEV size_t kcmp_off(int path, int tensor) {
    size_t o = 0;
    if (path == 1) o += (size_t)2 * BATCH * NC_P * 128;
    o += (size_t)tensor * (path == 0 ? (size_t)BATCH * NC_P * 128 : (size_t)DB * NC_S * 128);
    return o;
}
DEV size_t hid_off(int path, int tensor) {
    size_t o = 0;
    if (path == 1) o += (size_t)2 * BATCH * NC_P * 256;
    o += (size_t)tensor * (path == 0 ? (size_t)BATCH * NC_P * 256 : (size_t)DB * NC_S * 256);
    return o;
}

DEV void b_rmsnorm_in(const P& p, long gid) {
    const int row = (int)gid; const float* x = xrow(p, row);
    float ss = 0.f; for (int k = 0; k < D; ++k) ss += x[k] * x[k];
    const float r = 1.0f / sqrtf(ss / D + 1e-6f);
    for (int k = 0; k < D; ++k) p.hb[(size_t)row * D + k] = to_act(x[k] * r * p.g_attn_pre[k]);
}
DEV void b_out_kv(const P& p, long gid) {
    const int row = (int)(gid / 512), c = (int)(gid % 512);
    const float v = p.proj[(size_t)row * PROJ + C_KVP + c];
    if (row < TOKP) p.o_kvp[(size_t)row * 512 + c] = v; else p.o_kvs[(size_t)(row - TOKP) * 512 + c] = v;
}
DEV void b_out_winp(const P& p, long gid) {
    const int c = (int)(gid % 256), r = (int)((gid / 256) % WBP), b = (int)(gid / (256 * WBP));
    p.o_winp[gid] = p.proj[(size_t)(b * SEQ + SEQ - WBP + r) * PROJ + C_KVW + c];
}
DEV void b_out_wins(const P& p, long gid) {
    const int c = (int)(gid % 256), r = (int)((gid / 256) % WBS), b = (int)(gid / (256 * WBS));
    const int pr = DS + r;
    p.o_wins[gid] = pr < WBS ? p.cache_win[((size_t)b * WBS + pr) * 256 + c] : p.proj[(size_t)(TOKP + b * DS + pr - WBS) * PROJ + C_KVW + c];
}
DEV void b_out_conv(const P& p, long gid) {
    const int c = (int)(gid % 1024), j = (int)((gid / 1024) % 3), sq = (int)(gid / 3072);
    if (sq < BATCH) p.o_convp[gid] = p.proj[(size_t)(sq * SEQ + SEQ - 3 + j) * PROJ + C_MQK + c];
    else p.o_convs[gid - (size_t)BATCH * 3072] = p.proj[(size_t)(TOKP + (sq - BATCH) * DS + DS - 3 + j) * PROJ + C_MQK + c];
}
constexpr long CMPROWS_P = (long)2 * BATCH * NC_P * 2, CMPROWS_S = (long)2 * DB * NC_S * 2;
DEV void cmp_decode(long r, int& path, int& tensor, int& b, int& c, int& h) {
    if (r < CMPROWS_P) { path = 0; h = (int)(r % 2); c = (int)((r / 2) % NC_P); b = (int)((r / (2 * NC_P)) % BATCH); tensor = (int)(r / ((long)2 * NC_P * BATCH)); }
    else { r -= CMPROWS_P; path = 1; h = (int)(r % 2); c = (int)((r / 2) % NC_S); b = (int)((r / (2 * NC_S)) % DB); tensor = (int)(r / ((long)2 * NC_S * DB)); }
}
DEV void b_cmp_hid(const P& p, long gid) {
    const int e = (int)(gid % 128); int path, tensor, b, c, h; cmp_decode(gid / 128, path, tensor, b, c, h);
    const float* w1 = p.cmp_w1 + (size_t)tensor * 2048 * 128; const float* pos = p.cmp_pos + tensor * 2048;
    float acc = p.cmp_b1[tensor * 128 + e];
    for (int j = 0; j < 32; ++j) {
        const float* kr = kv_ptr(p, path, b, c * 16 + j, tensor, h);
        for (int d = 0; d < 64; ++d) acc += (kr[d] + pos[j * 64 + d]) * w1[(size_t)(j * 64 + d) * 128 + e];
    }
    const int nc = path ? NC_S : NC_P;
    p.hid[hid_off(path, tensor) + ((size_t)(b * nc + c) * 2 + h) * 128 + e] = gelu_tanh(acc);
}
DEV void b_cmp_out(const P& p, long gid) {
    const int d = (int)(gid % 64); int path, tensor, b, c, h; cmp_decode(gid / 64, path, tensor, b, c, h);
    const int nc = path ? NC_S : NC_P;
    const float* hid = p.hid + hid_off(path, tensor) + ((size_t)(b * nc + c) * 2 + h) * 128;
    const float* w2 = p.cmp_w2 + (size_t)tensor * 128 * 64;
    float acc = p.cmp_b2[tensor * 64 + d];
    for (int e = 0; e < 128; ++e) acc += hid[e] * w2[e * 64 + d];
    p.kcmp[kcmp_off(path, tensor) + ((size_t)(b * nc + c) * 2 + h) * 64 + d] = acc;
}
DEV void b_cmp_attn(const P& p, long gid) {
    const int row = (int)(gid % TOK), head = (int)(gid / TOK), kvh = head >> 2; const Row r = row_info(row);
    const int nc = r.path ? NC_S : NC_P;
    float q[64];
#pragma unroll
    for (int d = 0; d < 64; ++d) q[d] = p.proj[(size_t)row * PROJ + C_Q + head * 64 + d] * 0.125f;
    int nv = r.pos >= 31 ? (r.pos - 31) / 16 + 1 : 0; if (nv > nc) nv = nc;
    const float* kc = p.kcmp + kcmp_off(r.path, 0) + (size_t)r.b * nc * 128 + kvh * 64;
    const float* vc = p.kcmp + kcmp_off(r.path, 1) + (size_t)r.b * nc * 128 + kvh * 64;
    float m = -3.0e38f;
    for (int c = 0; c < nv; ++c) { const float s = dot64(q, kc + (size_t)c * 128) + p.rel_bias[rel_bucket(r.pos - (c * 16 + 31)) * 8 + head]; m = fmaxf(m, s); }
    float l = 0.f; float acc[64];
#pragma unroll
    for (int d = 0; d < 64; ++d) acc[d] = 0.f;
    for (int c = 0; c < nv; ++c) {
        const float s = dot64(q, kc + (size_t)c * 128) + p.rel_bias[rel_bucket(r.pos - (c * 16 + 31)) * 8 + head];
        const float e = expf(s - m); l += e; axpy64(acc, 1.0f, e, vc + (size_t)c * 128);
    }
    const float inv = nv > 0 ? 1.0f / l : 0.f;
#pragma unroll
    for (int d = 0; d < 64; ++d) p.oc[(size_t)row * 512 + head * 64 + d] = acc[d] * inv;
    p.ml[((size_t)row * 8 + head) * 2 + 0] = m; p.ml[((size_t)row * 8 + head) * 2 + 1] = inv;
}
DEV void b_imp(const P& p, long gid) {
    const int j = (int)(gid % NSB_MAX), kvh = (int)((gid / NSB_MAX) % 2), row = (int)(gid / (2 * NSB_MAX)); const Row r = row_info(row);
    const int nc = r.path ? NC_S : NC_P, nsb = r.path ? NSB_S : NSB_P;
    if (j >= nsb) return;
    float sc;
    if (j == r.pos / 64 || j == 0) sc = POSBIG;
    else if (j * 64 > r.pos) sc = NEGBIG;
    else {
        sc = 0.f;
        const float* kc = p.kcmp + kcmp_off(r.path, 0) + (size_t)r.b * nc * 128 + kvh * 64;
        for (int g = 0; g < 4; ++g) {
            const int head = kvh * 4 + g;
            const float m = p.ml[((size_t)row * 8 + head) * 2], inv = p.ml[((size_t)row * 8 + head) * 2 + 1];
            const float* qp = p.proj + (size_t)row * PROJ + C_Q + head * 64;
            for (int c = 4 * j - 1; c <= 4 * j + 3; ++c) {
                if (c < 0 || c >= nc || c * 16 + 31 > r.pos) continue;
                float s = 0.f; for (int d = 0; d < 64; ++d) s += qp[d] * 0.125f * kc[(size_t)c * 128 + d];
                s += p.rel_bias[rel_bucket(r.pos - (c * 16 + 31)) * 8 + head];
                sc += expf(s - m) * inv;
            }
        }
    }
    p.imp[((size_t)row * 2 + kvh) * NSB_MAX + j] = sc;
}
DEV void b_topk(const P& p, long gid) {
    const int kvh = (int)(gid % 2), row = (int)(gid / 2); const Row r = row_info(row);
    const int ncb = r.pos / 64 + 1;
    const float* sc = p.imp + ((size_t)row * 2 + kvh) * NSB_MAX;
    float pv = 3.0e38f; int pj = -1;
    for (int it = 0; it < 16; ++it) {
        float bv = -3.0e38f; int bj = -1;
        for (int j = 0; j < ncb; ++j) {
            const float v = sc[j];
            const bool after = (v < pv) || (v == pv && j > pj);
            if (after && (bj < 0 || v > bv)) { bv = v; bj = j; }
        }
        p.idx[((size_t)row * 2 + kvh) * 16 + it] = bj;
        if (bj < 0) { pv = -3.0e38f; pj = 1 << 30; } else { pv = bv; pj = bj; }
    }
}
DEV void b_sel_win(const P& p, long gid) {
    const int row = (int)(gid % TOK), head = (int)(gid / TOK), kvh = head >> 2; const Row r = row_info(row);
    float q[64];
#pragma unroll
    for (int d = 0; d < 64; ++d) q[d] = p.proj[(size_t)row * PROJ + C_Q + head * 64 + d] * 0.125f;
    float m = -3.0e38f, l = 0.f; float acc[64];
#pragma unroll
    for (int d = 0; d < 64; ++d) acc[d] = 0.f;
    for (int it = 0; it < 16; ++it) {
        const int j = p.idx[((size_t)row * 2 + kvh) * 16 + it];
        if (j < 0) continue;
        for (int s = 0; s < 64; ++s) {
            const int kpos = j * 64 + s; if (kpos > r.pos) break;
            const float* kr = kv_ptr(p, r.path, r.b, kpos, 2, kvh); const float* vr = kv_ptr(p, r.path, r.b, kpos, 3, kvh);
            const float sc = dot64(q, kr) + p.rel_bias[rel_bucket(r.pos - kpos) * 8 + head];
            const float mn = fmaxf(m, sc), a = expf(m - mn), e = expf(sc - mn);
            l = l * a + e; m = mn; axpy64(acc, a, e, vr);
        }
    }
    const float g0 = sigmoidf_(p.proj[(size_t)row * PROJ + C_GATE + head * 3 + 0]), g1 = sigmoidf_(p.proj[(size_t)row * PROJ + C_GATE + head * 3 + 1]),
                g2 = sigmoidf_(p.proj[(size_t)row * PROJ + C_GATE + head * 3 + 2]);
    { const float inv = 1.0f / l;
#pragma unroll
      for (int d = 0; d < 64; ++d) p.mixin[(size_t)row * 1024 + head * 64 + d] = g0 * p.oc[(size_t)row * 512 + head * 64 + d] + g1 * acc[d] * inv; }
    m = -3.0e38f; l = 0.f;
#pragma unroll
    for (int d = 0; d < 64; ++d) acc[d] = 0.f;
    int k0 = r.pos - 511; if (r.path == 0 && k0 < 0) k0 = 0;
    for (int kp = k0; kp <= r.pos; ++kp) {
        const float* kr;
        if (r.path == 0) kr = p.proj + (size_t)(r.b * SEQ + kp) * PROJ + C_KVW + kvh * 64;
        else if (kp < PAST) kr = p.cache_win + ((size_t)r.b * WBS + (kp - (PAST - WBS))) * 256 + kvh * 64;
        else kr = p.proj + (size_t)(TOKP + r.b * DS + (kp - PAST)) * PROJ + C_KVW + kvh * 64;
        const float* vr = kr + 128;
        const float sc = dot64(q, kr) + p.rel_bias[rel_bucket(r.pos - kp) * 8 + head];
        const float mn = fmaxf(m, sc), a = expf(m - mn), e = expf(sc - mn);
        l = l * a + e; m = mn; axpy64(acc, a, e, vr);
    }
    { const float inv = 1.0f / l;
#pragma unroll
      for (int d = 0; d < 64; ++d) p.mixb[(size_t)row * 1024 + head * 64 + d] = to_act(p.mixin[(size_t)row * 1024 + head * 64 + d] + g2 * acc[d] * inv); }
}
DEV void b_conv(const P& p, long gid) {
    const int c = (int)(gid % 1024), row = (int)(gid / 1024); const Row r = row_info(row);
    float acc = p.conv_b[c];
#pragma unroll
    for (int j = 0; j < 4; ++j) {
        const int tt = r.t - 3 + j; float v;
        if (tt >= 0) v = p.proj[(size_t)(row - 3 + j) * PROJ + C_MQK + c];
        else v = r.path ? p.state_conv[((size_t)r.b * 3 + (r.t + j)) * 1024 + c] : 0.f;
        acc += v * p.conv_w[j * 1024 + c];
    }
    float o = siluf_(acc); if (c >= 512) o *= 0.08838834764831845f;
    p.qk[(size_t)row * 1024 + c] = o;
#ifndef CPU_EMU
    p.qkb[(size_t)row * 1024 + c] = to_act(o);
#endif
}
DEV void b_gates(const P& p, long gid) {
    const int h = (int)(gid % 4), sq = (int)(gid / 4); const int path = sq < BATCH ? 0 : 1, b = path ? sq - BATCH : sq;
    const int T = path ? DS : SEQ, CL = path ? DS : CLP, r0 = seq_row0(path, b);
    float m = path ? p.state_m[b * 4 + h] : 0.f, bs = 0.f;
    for (int t = 0; t < T; ++t) {
        if (t % CL == 0) bs = 0.f;
        const size_t row = r0 + t;
        const float ig = p.proj[row * PROJ + C_MIF + h], lf = logsigmoidf_(p.proj[row * PROJ + C_MIF + 4 + h]);
        bs += lf; m = fmaxf(lf + m, ig);
        p.gb[row * 4 + h] = bs; p.gm[row * 4 + h] = m;
    }
    if (path) p.o_ms[b * 4 + h] = m; else p.o_mp[b * 4 + h] = m;
}
DEV void chunk_info(int ch, int& path, int& b, int& c, int& r0, int& cl) {
    if (ch < BATCH * NCKP) { path = 0; b = ch / NCKP; c = ch % NCKP; r0 = b * SEQ + c * CLP; cl = CLP; }
    else { path = 1; b = ch - BATCH * NCKP; c = 0; r0 = TOKP + b * DS; cl = DS; }
}
DEV float chunk_mprev(const P& p, int path, int b, int c, int r0, int h) {
    if (c > 0) return p.gm[(size_t)(r0 - 1) * 4 + h];
    return path ? p.state_m[b * 4 + h] : 0.f;
}
DEV void b_scan2(const P& p, long gid) {
    const int v = (int)(gid % 128), d = (int)((gid / 128) % 128), h = (int)((gid / 16384) % 4), sq = (int)(gid / 65536);
    const int path = sq < BATCH ? 0 : 1, b = path ? sq - BATCH : sq, nck = path ? 1 : NCKP, ch0 = path ? BATCH * NCKP + b : b * NCKP;
    float C = path ? p.state_C[(((size_t)b * 4 + h) * 128 + d) * 128 + v] : 0.f;
    float n = path ? p.state_n[((size_t)b * 4 + h) * 128 + d] : 0.f;
    const float* __restrict__ dC = p.dC + (((size_t)ch0 * 4 + h) * 128 + d) * 128 + v; float* __restrict__ cp = p.cprev + (((size_t)ch0 * 4 + h) * 128 + d) * 128 + v;
    const float* __restrict__ dn = p.dn + ((size_t)ch0 * 4 + h) * 128 + d; float* __restrict__ np_ = p.nprev + ((size_t)ch0 * 4 + h) * 128 + d;
    const float* __restrict__ cm = p.cmap + ((size_t)ch0 * 4 + h) * 2; const float* __restrict__ mp = p.mprev + (size_t)ch0 * 4 + h;
    float mpv = mp[0];
#pragma unroll 8
    for (int c = 0; c < nck; ++c) {
        const float L = cm[(size_t)c * 8], I = cm[(size_t)c * 8 + 1], mnew = fmaxf(mpv + L, I), decay = expf(L + mpv - mnew);
        const float t = dC[(size_t)c * 65536]; cp[(size_t)c * 65536] = C; C = decay * C + t;
        if (v == 0) { const float tn = dn[(size_t)c * 512]; np_[(size_t)c * 512] = n; n = decay * n + tn; }
        mpv = mnew;
    }
    const size_t oi = (((size_t)b * 4 + h) * 128 + d) * 128 + v;
    if (path) p.o_Cs[oi] = C; else p.o_Cp[oi] = C;
    if (v == 0) { const size_t ni = ((size_t)b * 4 + h) * 128 + d; if (path) p.o_ns[ni] = n; else p.o_np[ni] = n; }
}
DEV void b_dC(const P& p, long gid) {
    const int v = (int)(gid % 128), d = (int)((gid / 128) % 128), h = (int)((gid / 16384) % 4), ch = (int)(gid / 65536);
    int path, b, c, r0, cl; chunk_info(ch, path, b, c, r0, cl);
    const float bend = p.gb[(size_t)(r0 + cl - 1) * 4 + h], mnew = p.gm[(size_t)(r0 + cl - 1) * 4 + h];
    float acc = 0.f, accn = 0.f;
    for (int s = 0; s < cl; ++s) {
        const size_t row = r0 + s;
        const float wk = expf(bend - p.gb[row * 4 + h] + p.proj[row * PROJ + C_MIF + h] - mnew);
        const float kk = p.qk[row * 1024 + 512 + h * 128 + d];
        acc += wk * kk * p.proj[row * PROJ + C_MV + h * 128 + v]; accn += wk * kk;
    }
    p.dC[gid] = acc;
    if (v == 0) p.dn[((size_t)ch * 4 + h) * 128 + d] = accn;
}
DEV void b_scan(const P& p, long gid) {
    const int v = (int)(gid % 128), d = (int)((gid / 128) % 128), h = (int)((gid / 16384) % 4), sq = (int)(gid / 65536);
    const int path = sq < BATCH ? 0 : 1, b = path ? sq - BATCH : sq, nck = path ? 1 : NCKP;
    float C = path ? p.state_C[(((size_t)b * 4 + h) * 128 + d) * 128 + v] : 0.f;
    float n = path ? p.state_n[((size_t)b * 4 + h) * 128 + d] : 0.f;
    for (int c = 0; c < nck; ++c) {
        const int ch = path ? BATCH * NCKP + b : b * NCKP + c; int pp, bb, cc, r0, cl; chunk_info(ch, pp, bb, cc, r0, cl);
        const float bend = p.gb[(size_t)(r0 + cl - 1) * 4 + h], mnew = p.gm[(size_t)(r0 + cl - 1) * 4 + h], mprev = chunk_mprev(p, path, b, c, r0, h);
        const float decay = expf(bend + mprev - mnew);
        const size_t ci = (((size_t)ch * 4 + h) * 128 + d) * 128 + v;
        const float t = p.dC[ci]; p.dC[ci] = C; C = decay * C + t;
        if (v == 0) { const size_t ni = ((size_t)ch * 4 + h) * 128 + d; const float tn = p.dn[ni]; p.dn[ni] = n; n = decay * n + tn; }
    }
    const size_t oi = (((size_t)b * 4 + h) * 128 + d) * 128 + v;
    if (path) p.o_Cs[oi] = C; else p.o_Cp[oi] = C;
    if (v == 0) { const size_t ni = ((size_t)b * 4 + h) * 128 + d; if (path) p.o_ns[ni] = n; else p.o_np[ni] = n; }
}
DEV void b_S(const P& p, long gid) {
    const int s = (int)(gid % 64), h = (int)((gid / 64) % 4), row = (int)(gid / 256); const Row r = row_info(row);
    const int cl = r.path ? DS : CLP, tl = r.t % cl, rs = row - tl + s;
    float o = 0.f;
    if (s <= tl) {
        const float* qp = p.qk + (size_t)row * 1024 + h * 128; const float* kp = p.qk + (size_t)rs * 1024 + 512 + h * 128;
        float dt = 0.f; for (int d = 0; d < 128; ++d) dt += qp[d] * kp[d];
        o = dt * expf(p.gb[(size_t)row * 4 + h] - p.gb[(size_t)rs * 4 + h] + p.proj[(size_t)rs * PROJ + C_MIF + h] - p.gm[(size_t)row * 4 + h]);
    }
    p.S[gid] = o;
}
DEV void b_hout(const P& p, long gid) {
    const int v = (int)(gid % 128), h = (int)((gid / 128) % 4), row = (int)(gid / 512); const Row r = row_info(row);
    const int cl = r.path ? DS : CLP, tl = r.t % cl, c = r.t / cl, r0 = row - tl;
    const int ch = r.path ? BATCH * NCKP + r.b : r.b * NCKP + c;
    const float mt = p.gm[(size_t)row * 4 + h], inter = expf(p.gb[(size_t)row * 4 + h] + chunk_mprev(p, r.path, r.b, c, r0, h) - mt);
    const float* Sr = p.S + ((size_t)row * 4 + h) * 64;
    float num = 0.f, den = 0.f;
    for (int s = 0; s <= tl; ++s) { num += Sr[s] * p.proj[(size_t)(r0 + s) * PROJ + C_MV + h * 128 + v]; den += Sr[s]; }
    const float* qp = p.qk + (size_t)row * 1024 + h * 128;
    const float* Cp = p.cprev + ((size_t)ch * 4 + h) * 16384; const float* np_ = p.nprev + ((size_t)ch * 4 + h) * 128;
    float qc = 0.f, qn = 0.f;
    for (int d = 0; d < 128; ++d) { qc += qp[d] * Cp[d * 128 + v]; qn += qp[d] * np_[d]; }
    num += inter * qc; den += inter * qn;
    const float hv = num / fmaxf(fabsf(den), expf(-mt));
    p.hm_pre[(size_t)row * 512 + h * 128 + v] = sigmoidf_(p.proj[(size_t)row * PROJ + C_MO + h * 128 + v]) * hv;
}
DEV void b_hnorm(const P& p, long gid) {
    const int h = (int)(gid % 4), row = (int)(gid / 4);
    const float* x = p.hm_pre + (size_t)row * 512 + h * 128;
    float ss = 0.f; for (int k = 0; k < 128; ++k) ss += x[k] * x[k];
    const float rr = 1.0f / sqrtf(ss / 128 + 1e-6f);
    for (int k = 0; k < 128; ++k) p.mixb[(size_t)row * 1024 + 512 + h * 128 + k] = to_act(x[k] * rr * p.g_mnorm[h * 128 + k]);
}
DEV void b_post1(const P& p, long gid) {
    const int row = (int)gid; const float* x = xrow(p, row); const float* mx = p.mix + (size_t)row * D;
    float ss = 0.f; for (int k = 0; k < D; ++k) ss += mx[k] * mx[k];
    const float r1 = 1.0f / sqrtf(ss / D + 1e-6f);
    float s2 = 0.f;
    for (int k = 0; k < D; ++k) { const float v = x[k] + mx[k] * r1 * p.g_attn_post[k]; p.x1[(size_t)row * D + k] = v; s2 += v * v; }
    const float r2 = 1.0f / sqrtf(s2 / D + 1e-6f);
    for (int k = 0; k < D; ++k) p.h2b[(size_t)row * D + k] = to_act(p.x1[(size_t)row * D + k] * r2 * p.g_ffn_pre[k]);
}
DEV void b_swiglu(const P& p, long gid) {
    const long row = gid / DFF, c = gid % DFF; p.actb[gid] = to_act(siluf_(p.gate[row * 2 * DFF + c]) * p.gate[row * 2 * DFF + DFF + c]);
}
DEV void b_wt(const float* w, act_t* bt, int K, int N, int col0, long gid) { const int n = (int)(gid % N), k = (int)(gid / N); bt[(size_t)(col0 + n) * K + k] = to_act(w[gid]); }
DEV void b_wt_in(const P& p, long gid) { b_wt(p.w_in, p.bt_in, D, PROJ, 0, gid); }
DEV void b_wt_inpad(const P& p, long gid) { p.bt_in[(size_t)PROJ * D + gid] = to_act(0.f); }
DEV void b_wt_out(const P& p, long gid) { b_wt(p.w_out, p.bt_out, 1024, D, 0, gid); }
DEV void b_wt_gate(const P& p, long gid) { b_wt(p.w_gate, p.bt_gu, D, DFF, 0, gid); }
DEV void b_wt_up(const P& p, long gid) { b_wt(p.w_up, p.bt_gu, D, DFF, DFF, gid); }
DEV void b_wt_down(const P& p, long gid) { b_wt(p.w_down, p.bt_down, DFF, D, 0, gid); }
DEV void b_post2(const P& p, long gid) {
    const int row = (int)gid; const float* fx = p.f + (size_t)row * D;
    float ss = 0.f; for (int k = 0; k < D; ++k) ss += fx[k] * fx[k];
    const float r1 = 1.0f / sqrtf(ss / D + 1e-6f);
    float* y = row < TOKP ? p.o_yp + (size_t)row * D : p.o_ys + (size_t)(row - TOKP) * D;
    for (int k = 0; k < D; ++k) y[k] = p.x1[(size_t)row * D + k] + fx[k] * r1 * p.g_ffn_post[k];
}


constexpr float LOG2E = 1.4426950408889634f;
DEV int clampi3(int x, int lo, int hi) { return x < lo ? lo : (x > hi ? hi : x); }
DEV int perm16(int t) { return (t & ~15) | (t & 3) | ((t & 4) << 1) | ((t & 8) >> 1); }
DEV void b_prep_q(const P& p, long gid) {
    p.qb[gid] = to_act(p.proj[(size_t)(gid / 512) * PROJ + C_Q + (gid % 512)] * (0.125f * LOG2E));
}
DEV void b_prep_kv(const P& p, long gid) {
    const int d = (int)(gid % 64), kvh = (int)((gid / 64) % 2), t = (int)((gid / 128) % SEQ), b = (int)(gid / (128 * (long)SEQ));
    const float* pr = p.proj + (size_t)(b * SEQ + t) * PROJ;
    const size_t bh = (size_t)b * 2 + kvh;
    p.ks[(bh * SEQ + t) * 64 + d] = to_act(pr[C_KVP + 2 * 128 + kvh * 64 + d]);
    p.vst[(bh * 64 + d) * SEQ + perm16(t)] = to_act(pr[C_KVP + 3 * 128 + kvh * 64 + d]);
    p.kw[(bh * SEQ + t) * 64 + d] = to_act(pr[C_KVW + kvh * 64 + d]);
    p.vwt[(bh * 64 + d) * SEQ + perm16(t)] = to_act(pr[C_KVW + 128 + kvh * 64 + d]);
}
constexpr int NCPAD = (NC_P + 64) / 64 * 64, NCSPAD = (NC_S + 64) / 64 * 64;
DEV void b_prep_c(const P& p, long gid) {
    const int d = (int)(gid % 64), c = (int)((gid / 64) % NCPAD), kvh = (int)((gid / (64 * NCPAD)) % 2), b = (int)(gid / (128 * (long)NCPAD));
    const size_t bh = (size_t)b * 2 + kvh;
    float kv = 0.f, vv = 0.f;
    if (c < NC_P) { kv = p.kcmp[kcmp_off(0, 0) + ((size_t)(b * NC_P + c) * 2 + kvh) * 64 + d]; vv = p.kcmp[kcmp_off(0, 1) + ((size_t)(b * NC_P + c) * 2 + kvh) * 64 + d]; }
    p.kc[(bh * NCPAD + c) * 64 + d] = to_act(kv);
    p.vct[(bh * 64 + d) * NCPAD + perm16(c)] = to_act(vv);
}
DEV void b_prep_cs(const P& p, long gid) {
    const int d = (int)(gid % 64), c = (int)((gid / 64) % NCSPAD), kvh = (int)((gid / (64 * NCSPAD)) % 2), b = (int)(gid / (128 * (long)NCSPAD));
    const size_t bh = (size_t)b * 2 + kvh;
    float kv = 0.f, vv = 0.f;
    if (c < NC_S) { kv = p.kcmp[kcmp_off(1, 0) + ((size_t)(b * NC_S + c) * 2 + kvh) * 64 + d]; vv = p.kcmp[kcmp_off(1, 1) + ((size_t)(b * NC_S + c) * 2 + kvh) * 64 + d]; }
    p.kcs[(bh * NCSPAD + c) * 64 + d] = to_act(kv);
    p.vcts[(bh * 64 + d) * NCSPAD + perm16(c)] = to_act(vv);
}


DEV void b_scan3(const P& p, long gid) {
    typedef float f32x4 __attribute__((ext_vector_type(4))); typedef unsigned u32x2 __attribute__((ext_vector_type(2)));
    const int dq = (int)(gid % 32), v = (int)((gid / 32) % 128), h = (int)((gid / 4096) % 4), sq = (int)(gid / 16384);
    const int path = sq < BATCH ? 0 : 1, b = path ? sq - BATCH : sq, nck = path ? 1 : NCKP, ch0 = path ? BATCH * NCKP + b : b * NCKP;
    float C[4], n[4] = {0.f, 0.f, 0.f, 0.f};
#pragma unroll
    for (int e = 0; e < 4; ++e) C[e] = path ? p.state_C[(((size_t)b * 4 + h) * 128 + dq * 4 + e) * 128 + v] : 0.f;
    const bool don = (v == 0);
    if (don && path) { const f32x4 t = *(const f32x4*)(p.state_n + ((size_t)b * 4 + h) * 128 + dq * 4); n[0] = t[0]; n[1] = t[1]; n[2] = t[2]; n[3] = t[3]; }
    const act_t* __restrict__ dC = p.dct + ((size_t)ch0 * 4 + h) * 16384 + v * 128 + dq * 4; act_t* __restrict__ cp = p.cpt + ((size_t)ch0 * 4 + h) * 16384 + v * 128 + dq * 4;
    const float* __restrict__ dn = p.dn + ((size_t)ch0 * 4 + h) * 128 + dq * 4; float* __restrict__ np_ = p.nprev + ((size_t)ch0 * 4 + h) * 128 + dq * 4;
    const float* __restrict__ cm = p.cmap + ((size_t)ch0 * 4 + h) * 2;
    float mpv = p.mprev[(size_t)ch0 * 4 + h];
    constexpr int BT = 8;
    float Lc[BT], Ic[BT], Ln[BT], In[BT]; u32x2 tc[BT], tn_[BT];
#pragma unroll
    for (int i = 0; i < BT; ++i) { const int c = i < nck ? i : nck - 1; Lc[i] = cm[(size_t)c * 8]; Ic[i] = cm[(size_t)c * 8 + 1]; tc[i] = *(const u32x2*)(dC + (size_t)c * 65536); Ln[i] = Lc[i]; In[i] = Ic[i]; tn_[i] = tc[i]; }
    for (int cb = 0; cb < nck; cb += BT) {
        if (cb + BT < nck) {
#pragma unroll
            for (int i = 0; i < BT; ++i) { const int c = cb + BT + i < nck ? cb + BT + i : nck - 1; Ln[i] = cm[(size_t)c * 8]; In[i] = cm[(size_t)c * 8 + 1]; tn_[i] = *(const u32x2*)(dC + (size_t)c * 65536); }
        }
#pragma unroll
        for (int i = 0; i < BT; ++i) {
            const int c = cb + i;
            if (c < nck) {
                const float L = Lc[i], I = Ic[i], mnew = fmaxf(mpv + L, I), decay = expf(L + mpv - mnew);
                const u32x2 t = tc[i];
                u32x2 o; o[0] = pkbf(C[0], C[1]); o[1] = pkbf(C[2], C[3]);
                *(u32x2*)(cp + (size_t)c * 65536) = o;
                C[0] = decay * C[0] + __uint_as_float(t[0] << 16); C[1] = decay * C[1] + __uint_as_float(t[0] & 0xffff0000u);
                C[2] = decay * C[2] + __uint_as_float(t[1] << 16); C[3] = decay * C[3] + __uint_as_float(t[1] & 0xffff0000u);
                if (don) { const f32x4 tn = *(const f32x4*)(dn + (size_t)c * 512); *(f32x4*)(np_ + (size_t)c * 512) = (f32x4){n[0], n[1], n[2], n[3]};
#pragma unroll
                    for (int e = 0; e < 4; ++e) n[e] = decay * n[e] + tn[e]; }
                mpv = mnew;
            }
        }
#pragma unroll
        for (int i = 0; i < BT; ++i) { Lc[i] = Ln[i]; Ic[i] = In[i]; tc[i] = tn_[i]; }
    }
    float* oC = path ? p.o_Cs : p.o_Cp; float* on = path ? p.o_ns : p.o_np;
#pragma unroll
    for (int e = 0; e < 4; ++e) oC[(((size_t)b * 4 + h) * 128 + dq * 4 + e) * 128 + v] = C[e];
    if (don) *(f32x4*)(on + ((size_t)b * 4 + h) * 128 + dq * 4) = (f32x4){n[0], n[1], n[2], n[3]};
}

constexpr int NCH_P = SEQ / 16, NCH_S = PAST / 16;
constexpr int CROWS_P = BATCH * 2 * NCH_P, CROWS_S = DB * 2 * NCH_S;
static_assert(CROWS_P % 256 == 0 && CROWS_S % 256 == 0 && NCH_P == NCPAD && NCH_S == NCSPAD, "compression GEMM shapes");
DEV void b_cmp_const(const P& p, long gid) {
    const int e = (int)(gid % 128), tensor = (int)(gid / 128);
    float acc = p.cmp_b1[tensor * 128 + e];
    for (int k = 0; k < 2048; ++k) acc += p.cmp_pos[tensor * 2048 + k] * p.cmp_w1[((size_t)tensor * 2048 + k) * 128 + e];
    p.cmpc[gid] = acc;
}
DEV void b_w2t(const P& p, long gid) {
    const int e = (int)(gid % 128), d = (int)((gid / 128) % 64), tensor = (int)(gid / 8192);
    p.w2t[gid] = to_act(p.cmp_w2[((size_t)tensor * 128 + e) * 64 + d]);
}
DEV void cmpA_store(act_t* dst, const float* src) {
    typedef float f32x4 __attribute__((ext_vector_type(4))); typedef unsigned u32x4 __attribute__((ext_vector_type(4)));
    const f32x4 a = *(const f32x4*)src, b = *(const f32x4*)(src + 4);
    u32x4 o; o[0] = pkbf(a[0], a[1]); o[1] = pkbf(a[2], a[3]);
    o[2] = pkbf(b[0], b[1]); o[3] = pkbf(b[2], b[3]);
    *(u32x4*)dst = o;
}
DEV void b_cmpA_s(const P& p, long gid) {
    const int q = (int)(gid % 128), cidx = (int)((gid / 128) % NCH_S), h = (int)((gid / (128L * NCH_S)) % 2), b = (int)((gid / (256L * NCH_S)) % DB), tensor = (int)(gid / (256L * NCH_S * DB));
    const int T = 16 * cidx + (q >> 3);
    const float* src = p.cache_kv + ((((size_t)p.page_table[b * NPAGES + T / PAGE] * PAGE + T % PAGE) * 4 + tensor) * 128) + h * 64 + (q & 7) * 8;
    cmpA_store(p.cas + ((size_t)tensor * CROWS_S + (size_t)(b * 2 + h) * NCH_S + cidx) * 1024 + q * 8, src);
}
DEV void b_cmpA_p(const P& p, long gid) {
    const int q = (int)(gid % 128), cidx = (int)((gid / 128) % NCH_P), h = (int)((gid / (128L * NCH_P)) % 2), b = (int)((gid / (256L * NCH_P)) % BATCH), tensor = (int)(gid / (256L * NCH_P * BATCH));
    const int T = 16 * cidx + (q >> 3);
#ifdef CPU_EMU
    const float* src = p.proj + (size_t)(b * SEQ + T) * PROJ + C_KVP + tensor * 128 + h * 64 + (q & 7) * 8;
    cmpA_store(p.cap + ((size_t)tensor * CROWS_P + (size_t)(b * 2 + h) * NCH_P + cidx) * 1024 + q * 8, src);
#else
    typedef unsigned u32x4 __attribute__((ext_vector_type(4)));
    *(u32x4*)(p.cap + ((size_t)tensor * CROWS_P + (size_t)(b * 2 + h) * NCH_P + cidx) * 1024 + q * 8) = *(const u32x4*)(p.kvb + (size_t)(b * SEQ + T) * 512 + tensor * 128 + h * 64 + (q & 7) * 8);
#endif
}

DEV void g_out_winp(const P& p, long gid) {
    typedef float f32x4 __attribute__((ext_vector_type(4)));
    const int c = (int)(gid % 64) * 4, r = (int)((gid / 64) % WBP), b = (int)(gid / (64 * WBP));
    *(f32x4*)(p.o_winp + gid * 4) = *(const f32x4*)(p.kvwf + (size_t)(b * SEQ + SEQ - WBP + r) * 256 + c);
}
DEV void g_out_wins(const P& p, long gid) {
    typedef float f32x4 __attribute__((ext_vector_type(4)));
    const int c = (int)(gid % 64) * 4, r = (int)((gid / 64) % WBS), b = (int)(gid / (64 * WBS));
    const int pr = DS + r;
    *(f32x4*)(p.o_wins + gid * 4) = pr < WBS ? *(const f32x4*)(p.cache_win + ((size_t)b * WBS + pr) * 256 + c) : *(const f32x4*)(p.kvwf + (size_t)(TOKP + b * DS + pr - WBS) * 256 + c);
}
DEV void g_out_conv(const P& p, long gid) {
    const int c = (int)(gid % 1024), j = (int)((gid / 1024) % 3), sq = (int)(gid / 3072);
    (void)c; (void)j; (void)sq;
}
DEV void b_cmp_attn_s(const P& p, long gid) { b_cmp_attn(p, (gid / TOKS) * TOK + TOKP + gid % TOKS); }
DEV void b_imp_s(const P& p, long gid) { b_imp(p, (long)TOKP * 2 * NSB_MAX + gid); }
DEV void b_topk_s(const P& p, long gid) { b_topk(p, (long)TOKP * 2 + gid); }
DEV void b_sel_win_s(const P& p, long gid) { b_sel_win(p, (gid / TOKS) * TOK + TOKP + gid % TOKS); }

#ifndef CPU_EMU
#define XB_TMO      128
#define XB_XCNT(j)  (256  + 64 * (j))
#define XB_XSUB(j)  (1280 + 64 * (j))
#define XB_XGEN(j)  (2304 + 64 * (j))
#define XB_TOP      3328
#define XB_TOPGEN   3392
#define XCD_BAR_WORDS 3456
constexpr int CMPS_CNT_WORD = 3584, WS_ZERO_BYTES = 16384;
#define XB_SPIN_CAP (1u << 22)
#define LAS __attribute__((address_space(3)))
__device__ __forceinline__ unsigned xb_ld(unsigned* p)              { return __hip_atomic_load(p, __ATOMIC_RELAXED, __HIP_MEMORY_SCOPE_AGENT); }
__device__ __forceinline__ unsigned xb_add(unsigned* p, unsigned v) { return __hip_atomic_fetch_add(p, v, __ATOMIC_RELAXED, __HIP_MEMORY_SCOPE_AGENT); }
__device__ __forceinline__ unsigned xb_xcc_id() { return (unsigned)__builtin_amdgcn_s_getreg((3 << 11) | 20) & 0xFu; }
#define XB_SPIN(cond, bar) do { unsigned _sp = 0; while (cond) { __builtin_amdgcn_s_sleep(1); \
    if ((++_sp & 255u) == 0u) { if (xb_ld(&(bar)[XB_TMO])) break; if (_sp > XB_SPIN_CAP) { atomicAdd(&(bar)[XB_TMO], 1u); break; } } } } while (0)
struct XcdBarrier { unsigned* bar; unsigned x; volatile LAS unsigned* st; };
__device__ __forceinline__ XcdBarrier xcd_barrier_post(unsigned* bar, volatile LAS unsigned* st) {
    XcdBarrier b; b.bar = bar; b.x = xb_xcc_id(); b.st = st;
    if (threadIdx.x == 0) (void)xb_add(&bar[XB_XCNT(b.x)], 1u);
    return b;
}
__device__ __forceinline__ void xcd_barrier_complete(unsigned* bar, unsigned x, unsigned& nloc, unsigned& nx) {
    const unsigned G = gridDim.x * gridDim.y * gridDim.z;
    unsigned sum, cnt, mine, sp = 0u;
    for (;;) {
        sum = 0u; cnt = 0u; mine = 0u;
#pragma unroll
        for (unsigned j = 0; j < 16; ++j) { const unsigned c = xb_ld(&bar[XB_XCNT(j)]); sum += c; cnt += (c > 0u) ? 1u : 0u; mine = (j == x) ? c : mine; }
        if (sum == G) break;
        __builtin_amdgcn_s_sleep(1);
        if ((++sp & 255u) == 0u) { if (xb_ld(&bar[XB_TMO])) break; if (sp > XB_SPIN_CAP) { atomicAdd(&bar[XB_TMO], 1u); break; } }
    }
    nloc = mine > 0u ? mine : 1u; nx = cnt > 0u ? cnt : 1u;
}
__device__ __forceinline__ void xcd_barrier(const XcdBarrier& b) {
    asm volatile("s_waitcnt vmcnt(0)" ::: "memory");
    __syncthreads();
    if (threadIdx.x == 0) {
        unsigned* bar = b.bar;
        __builtin_amdgcn_s_waitcnt(0);
        unsigned nloc = b.st[0], nx = b.st[1];
        if (nloc == 0u) { xcd_barrier_complete(bar, b.x, nloc, nx); b.st[0] = nloc; b.st[1] = nx; }
        const unsigned old = xb_add(&bar[XB_XSUB(b.x)], 1u);
        const unsigned gen = old / nloc;
        if (old + 1u == (gen + 1u) * nloc) {
            __builtin_amdgcn_fence(__ATOMIC_RELEASE, "agent");
            asm volatile("s_waitcnt vmcnt(0)" ::: "memory");
            const unsigned og = xb_add(&bar[XB_TOP], 1u);
            const unsigned tg = og / nx;
            if (og + 1u == (tg + 1u) * nx) xb_add(&bar[XB_TOPGEN], 1u);
            else XB_SPIN(xb_ld(&bar[XB_TOPGEN]) == tg, bar);
            __builtin_amdgcn_fence(__ATOMIC_ACQUIRE, "agent");
            xb_add(&bar[XB_XGEN(b.x)], 1u);
            asm volatile("s_waitcnt vmcnt(0)" ::: "memory");
        } else {
            XB_SPIN(xb_ld(&bar[XB_XGEN(b.x)]) == gen, bar);
            __builtin_amdgcn_fence(__ATOMIC_ACQUIRE, "agent");
            asm volatile("s_waitcnt vmcnt(0)" ::: "memory");
        }
    }
    __syncthreads();
}

DEV int fresh_tid() { int t = threadIdx.x; asm volatile("" : "+v"(t)); return t; }
namespace pg8 {
#define PG8_LAS __attribute__((address_space(3)))
typedef unsigned short bf16_t;
typedef short bf16x8 __attribute__((ext_vector_type(8)));
typedef float f32x4 __attribute__((ext_vector_type(4)));
constexpr int BM = 256, BK = 64, HALF = 128, HTB = HALF * BK * 2, STAGE_BYTES = 8 * HTB, NXCD = 8, WGM = 8;
__host__ __device__ __forceinline__ int lds_byte(int r, int c) { const int st = (r >> 4) * 2 + (c >> 5), rr = r & 15, cc = c & 31, ob = rr * 64 + cc * 2; return st * 1024 + (ob ^ (((ob >> 9) & 1) << 5)); }
__host__ __device__ __forceinline__ void stage_rc(int b, int& R, int& C) { const int st = b / 1024, sb = b % 1024, swz = sb ^ (((sb >> 9) & 1) << 5); R = (st >> 1) * 16 + swz / 64; C = (st & 1) * 32 + (swz % 64) / 2; }
__host__ __device__ __forceinline__ int perm32(int rho) { const int n = rho >> 4, i = rho & 15; return 8 * (i >> 2) + 4 * n + (i & 3); }
struct Unit { int pm, pn; };
struct Gemm { const bf16_t* A; const bf16_t* Bt; int M, N, K; int ld = 0; };
struct StaticOrder {
    int nM, nN, nwg, G, c;
    __host__ __device__ void init(int M, int N, int G_, int c_) { nM = M / BM; nN = N / BM; nwg = nM * nN; G = G_; c = c_; }
    __host__ __device__ bool next(int i, Unit& u) const {
        const long L = (long)i * G + c; if (L >= nwg) return false;
        int wgid = (int)L; { const int q = nwg / NXCD, r = nwg % NXCD, xcd = wgid % NXCD, off = wgid / NXCD; wgid = (xcd < r ? xcd * (q + 1) : r * (q + 1) + (xcd - r) * q) + off; }
        const int nig = WGM * nN, gid = wgid / nig, fm = gid * WGM, gsz = (nM - fm) < WGM ? (nM - fm) : WGM;
        u.pm = fm + ((wgid % nig) % gsz); u.pn = (wgid % nig) / gsz; return true;
    }
    __device__ __forceinline__ void a_ready(const Unit&) const {}
    __device__ __forceinline__ void done(const Unit&) const {}
};
struct EpiF32 {
    static constexpr bool PERM = false, AFTER_DRAIN = false;
    float* C; int ldc; const float* bias; int ncols;
    __device__ __forceinline__ void operator()(const f32x4 (&acc)[2][2][4][2], const Unit& u, int wr, int wc, int fr, int fq) const {
        const int row0 = u.pm * BM + wr * 64 + fr, col0 = u.pn * BM + wc * 32 + 4 * fq;
        f32x4 bv[2][2];
#pragma unroll
        for (int bj = 0; bj < 2; ++bj)
#pragma unroll
            for (int n = 0; n < 2; ++n) { const int c = col0 + bj * HALF + n * 16; bv[bj][n] = (bias && c < ncols) ? *(const f32x4*)(bias + c) : (f32x4){0.f, 0.f, 0.f, 0.f}; }
#pragma unroll
        for (int ai = 0; ai < 2; ++ai)
#pragma unroll
            for (int m = 0; m < 4; ++m) { float* rowp = C + (size_t)(row0 + ai * HALF + m * 16) * ldc + col0;
#pragma unroll
                for (int bj = 0; bj < 2; ++bj)
#pragma unroll
                    for (int n = 0; n < 2; ++n) if (col0 + bj * HALF + n * 16 < ncols) *(f32x4*)(rowp + bj * HALF + n * 16) = acc[ai][bj][m][n] + bv[bj][n]; }
    }
};
__host__ __device__ __forceinline__ int remap_in(int n) { return n < 1280 ? n : n < 1304 ? n + 2048 : n < 2840 ? n - 24 : n < 2848 ? n + 512 : n - 32; }
struct EpiProj {
    static constexpr bool PERM = true, AFTER_DRAIN = false;
    const float* bias; bf16_t *qb, *kvb, *kwb, *mqkb, *mvb, *mob; float *okvp, *okvs, *kvwf, *gatef, *mif, *oconvp, *oconvs; float qscale;
    __device__ __forceinline__ static void st8b(bf16_t* d, f32x4 a, f32x4 b) { typedef unsigned u32x4 __attribute__((ext_vector_type(4))); u32x4 o;
        o[0] = pkbf(a[0], a[1]); o[1] = pkbf(a[2], a[3]);
        o[2] = pkbf(b[0], b[1]); o[3] = pkbf(b[2], b[3]); *(u32x4*)d = o; }
    __device__ __forceinline__ static void st8f(float* d, f32x4 a, f32x4 b) { *(f32x4*)d = a; *(f32x4*)(d + 4) = b; }
    __device__ __forceinline__ void operator()(const f32x4 (&acc)[2][2][4][2], const Unit& u, int wr, int wc, int fr, int fq) const {
        static_assert(TOKP % BM == 0 && SEQ % BM == 0 && WBP % BM == 0 && WBP >= 3, "EpiProj panel tests");
        const unsigned row0 = (unsigned)(u.pm * BM + wr * 64 + fr); const int cl = wc * 32 + 8 * fq, pn = u.pn;
        const bool sp = u.pm * BM >= TOKP, winp = sp || ((u.pm * BM) % SEQ) >= SEQ - WBP, convp = sp || ((u.pm * BM) % SEQ) == SEQ - BM;
#define EP_LOOP(BJ, DELTA, ...) { const int c = pn * BM + (BJ) * HALF + cl; const f32x4 b0 = *(const f32x4*)(bias + c + (DELTA)), b1 = *(const f32x4*)(bias + c + (DELTA) + 4); \
        _Pragma("unroll") for (int ai = 0; ai < 2; ++ai) _Pragma("unroll") for (int m = 0; m < 4; ++m) { const unsigned r = row0 + ai * HALF + m * 16; const f32x4 v0 = acc[ai][BJ][m][0] + b0, v1 = acc[ai][BJ][m][1] + b1; __VA_ARGS__ } }
        if (pn < 2) {
            EP_LOOP(0, 0, st8b(qb + (size_t)r * 512 + c, v0 * qscale, v1 * qscale);) EP_LOOP(1, 0, st8b(qb + (size_t)r * 512 + c, v0 * qscale, v1 * qscale);)
        } else if (pn < 4) {
            float* okv = sp ? okvs - (size_t)TOKP * 512 : okvp;
            const bool hb0 = !sp, hb1 = !sp && pn == 2;
            EP_LOOP(0, 0, st8f(okv + (size_t)r * 512 + (c - 512), v0, v1); if (hb0) st8b(kvb + (size_t)r * 512 + (c - 512), v0, v1);)
            EP_LOOP(1, 0, st8f(okv + (size_t)r * 512 + (c - 512), v0, v1); if (hb1) st8b(kvb + (size_t)r * 512 + (c - 512), v0, v1);)
        } else if (pn == 4) {
            EP_LOOP(0, 0, if (!sp) st8b(kwb + (size_t)r * 256 + (c - 1024), v0, v1); if (winp) st8f(kvwf + (size_t)r * 256 + (c - 1024), v0, v1);)
            EP_LOOP(1, 0, st8f(kvwf + (size_t)r * 256 + (c - 1024), v0, v1);)
        } else if (pn < 9) {
#define EP_MQK(BJ) EP_LOOP(BJ, 24, st8b(mqkb + (size_t)r * 1024 + (c - 1280), v0, v1); \
            if (convp) { const int ri = (int)r; const int len = sp ? DS : SEQ, loc = sp ? (ri - TOKP) % DS : ri % SEQ, sq = sp ? (ri - TOKP) / DS : ri / SEQ;     \
                if (loc >= len - 3) st8f((sp ? oconvs : oconvp) + ((size_t)sq * 3 + (loc - (len - 3))) * 1024 + (c - 1280), v0, v1); })
            EP_MQK(0) EP_MQK(1)
#undef EP_MQK
        } else if (pn < 11) {
            EP_LOOP(0, 24, st8b(mvb + (size_t)r * 512 + (c - 2304), v0, v1);) EP_LOOP(1, 24, st8b(mvb + (size_t)r * 512 + (c - 2304), v0, v1);)
        } else if (pn < 13) {
            EP_LOOP(0, 32, st8b(mob + (size_t)r * 512 + (c - 2816), v0, v1);) EP_LOOP(1, 32, st8b(mob + (size_t)r * 512 + (c - 2816), v0, v1);)
        } else if (wc == 0) {
            const int dl = fq < 3 ? -2048 : -512;
            EP_LOOP(0, dl, st8f(fq < 3 ? gatef + (size_t)r * 32 + (c - 3328) : mif + (size_t)r * 8, v0, v1);)
        }
#undef EP_LOOP
    }
};
struct EpiB16 {
    static constexpr bool PERM = true, AFTER_DRAIN = false;
    bf16_t* O; int ldo;
    __device__ __forceinline__ void operator()(const f32x4 (&acc)[2][2][4][2], const Unit& u, int wr, int wc, int fr, int fq) const {
        const int row0 = u.pm * BM + wr * 64 + fr, col0 = u.pn * BM + wc * 32 + 8 * fq;
#pragma unroll
        for (int ai = 0; ai < 2; ++ai)
#pragma unroll
            for (int m = 0; m < 4; ++m) { bf16_t* rowp = O + (size_t)(row0 + ai * HALF + m * 16) * ldo + col0;
#pragma unroll
                for (int bj = 0; bj < 2; ++bj) { const f32x4 a = acc[ai][bj][m][0], b = acc[ai][bj][m][1]; typedef unsigned u32x4 __attribute__((ext_vector_type(4))); u32x4 o;
                    o[0] = pkbf(a[0], a[1]); o[1] = pkbf(a[2], a[3]);
                    o[2] = pkbf(b[0], b[1]); o[3] = pkbf(b[2], b[3]);
                    *(u32x4*)(rowp + bj * HALF) = o; }
            }
    }
};
struct EpiSwiglu {
    static constexpr bool PERM = true, AFTER_DRAIN = false;
    bf16_t* O; int ldo;
    __device__ __forceinline__ void operator()(const f32x4 (&acc)[2][2][4][2], const Unit& u, int wr, int wc, int fr, int fq) const {
        const int row0 = u.pm * BM + wr * 64 + fr, col0 = u.pn * HALF + wc * 32 + 8 * fq;
#pragma unroll
        for (int ai = 0; ai < 2; ++ai)
#pragma unroll
            for (int m = 0; m < 4; ++m) {
                float a[8];
#pragma unroll
                for (int n = 0; n < 2; ++n)
#pragma unroll
                    for (int e = 0; e < 4; ++e) { const float g = acc[ai][0][m][n][e]; a[4 * n + e] = g * fsigmoid_(g) * acc[ai][1][m][n][e]; }
                typedef unsigned u32x4 __attribute__((ext_vector_type(4))); u32x4 o;
#pragma unroll
                for (int e = 0; e < 4; ++e) o[e] = pkbf(a[2 * e], a[2 * e + 1]);
                *(u32x4*)(O + (size_t)(row0 + ai * HALF + m * 16) * ldo + col0) = o;
            }
    }
};
template <class Epi, class Sched>
__device__ __forceinline__ void gemm_phase(PG8_LAS unsigned char* lds, const Gemm g, const Sched& S, const Epi& E) {
    const int tid = fresh_tid(), wid = __builtin_amdgcn_readfirstlane(tid >> 6), lane = tid & 63, wr = wid >> 2, wc = wid & 3, fr = lane & 15, fq = lane >> 4;
    const int K = g.K, nt = K / BK, ld = g.ld ? g.ld : K;
    unsigned voffA[2], voffB[2];
#pragma unroll
    for (int i = 0; i < 2; ++i) { int R, C; stage_rc(tid * 16 + i * 8192, R, C); const int Rb = Epi::PERM ? ((R & ~31) + perm32(R & 31)) : R;
        voffA[i] = (unsigned)(R * ld + C) * 2u; voffB[i] = (unsigned)(Rb * ld + C) * 2u; }
    const size_t kstep = (size_t)(BK * 2);
    const size_t hstep = (size_t)HALF * ld * 2;
    const size_t tstep = 2 * hstep;
    const unsigned ldsw = (unsigned)wid * 1024u;
    const int aoff = lds_byte(wr * 64 + fr, fq * 8), boff = lds_byte(wc * 32 + fr, fq * 8);
#define PG8_SA(b, h) (((b) * 2 + (h)) * HTB)
#define PG8_SB(b, h) ((4 + (b) * 2 + (h)) * HTB)
#define PG8_STAGE(bufoff, gbase, voff) do { _Pragma("unroll") for (int _i = 0; _i < 2; ++_i) \
        __builtin_amdgcn_global_load_lds((const unsigned*)((const char*)(gbase) + (voff)[_i]), (PG8_LAS unsigned*)(lds + (bufoff) + ldsw + _i * 8192), 16, 0, 0); } while (0)
#define PG8_LDA(dst, b, h) do { _Pragma("unroll") for (int m = 0; m < 4; ++m) _Pragma("unroll") for (int k = 0; k < 2; ++k) dst[m][k] = *(const PG8_LAS bf16x8*)(lds + PG8_SA(b, h) + aoff + m * 2048 + k * 1024); } while (0)
#define PG8_LDB(dst, b, h) do { _Pragma("unroll") for (int n = 0; n < 2; ++n) _Pragma("unroll") for (int k = 0; k < 2; ++k) dst[n][k] = *(const PG8_LAS bf16x8*)(lds + PG8_SB(b, h) + boff + n * 2048 + k * 1024); } while (0)
#define PG8_MMA(ai, bj, At, Bt) do { __builtin_amdgcn_s_setprio(1); _Pragma("unroll") for (int m = 0; m < 4; ++m) _Pragma("unroll") for (int n = 0; n < 2; ++n) _Pragma("unroll") for (int k = 0; k < 2; ++k) \
        acc[ai][bj][m][n] = __builtin_amdgcn_mfma_f32_16x16x32_bf16(Bt[n][k], At[m][k], acc[ai][bj][m][n], 0, 0, 0); __builtin_amdgcn_s_setprio(0); } while (0)
#define PG8_WAIT_V(n) asm volatile("s_waitcnt vmcnt(" #n ")" ::: "memory")
#define PG8_WAIT_L(n) asm volatile("s_waitcnt lgkmcnt(" #n ")" ::: "memory")
#define PG8_BAR __builtin_amdgcn_s_barrier()
#define PG8_SCHED __builtin_amdgcn_sched_barrier(0)
    Unit cur, nxt; int ui = 0;
    if (!S.next(0, cur)) return;
    f32x4 acc[2][2][4][2];
#pragma unroll
    for (int a = 0; a < 2; ++a)
#pragma unroll
        for (int b = 0; b < 2; ++b)
#pragma unroll
            for (int m = 0; m < 4; ++m)
#pragma unroll
                for (int n = 0; n < 2; ++n) acc[a][b][m][n] = (f32x4){0.f, 0.f, 0.f, 0.f};
    bf16x8 At[4][2], B0[2][2], B1[2][2];
    const char* cA = (const char*)g.A + (size_t)cur.pm * tstep; const char* cB = (const char*)g.Bt + (size_t)cur.pn * tstep;
    S.a_ready(cur);
    PG8_STAGE(PG8_SB(0, 0), cB, voffB); PG8_STAGE(PG8_SA(0, 0), cA, voffA); PG8_STAGE(PG8_SB(0, 1), cB + hstep, voffB); PG8_STAGE(PG8_SA(0, 1), cA + hstep, voffA);
    if (wr == 1) PG8_BAR;
    PG8_WAIT_V(4); PG8_BAR;
    PG8_STAGE(PG8_SB(1, 0), cB + kstep, voffB); PG8_STAGE(PG8_SA(1, 0), cA + kstep, voffA); PG8_STAGE(PG8_SB(1, 1), cB + hstep + kstep, voffB);
    PG8_WAIT_V(6); PG8_BAR;
    for (;;) {
        const bool has_next = S.next(ui + 1, nxt);
        const char* nA = has_next ? (const char*)g.A + (size_t)nxt.pm * tstep : cA; const char* nB = has_next ? (const char*)g.Bt + (size_t)nxt.pn * tstep : cB;
        for (int t = 0; t < nt; t += 2) {
            const bool last = (t == nt - 2);
            const char* a1 = cA + (size_t)(t + 1) * kstep;
            const char* a2 = last ? nA : cA + (size_t)(t + 2) * kstep; const char* b2 = last ? nB : cB + (size_t)(t + 2) * kstep;
            const char* a3 = a2 + kstep; const char* b3 = b2 + kstep;
            if (last && has_next) S.a_ready(nxt);
            PG8_LDB(B0, 0, 0); PG8_SCHED; PG8_LDA(At, 0, 0); PG8_STAGE(PG8_SA(1, 1), a1 + hstep, voffA);
            PG8_WAIT_L(8); PG8_BAR; PG8_WAIT_L(0); PG8_MMA(0, 0, At, B0); PG8_BAR; PG8_SCHED;
            PG8_LDB(B1, 0, 1); PG8_STAGE(PG8_SB(0, 0), b2, voffB);
            PG8_BAR; PG8_WAIT_L(0); PG8_MMA(0, 1, At, B1); PG8_BAR;
            PG8_LDA(At, 0, 1); PG8_STAGE(PG8_SA(0, 0), a2, voffA);
            PG8_BAR; PG8_WAIT_L(0); PG8_MMA(1, 0, At, B0); PG8_BAR; PG8_SCHED;
            PG8_STAGE(PG8_SB(0, 1), b2 + hstep, voffB);
            PG8_WAIT_V(6); PG8_BAR; PG8_MMA(1, 1, At, B1); PG8_BAR;
            PG8_LDB(B0, 1, 0); PG8_SCHED; PG8_LDA(At, 1, 0); PG8_STAGE(PG8_SA(0, 1), a2 + hstep, voffA);
            PG8_WAIT_L(8); PG8_BAR; PG8_WAIT_L(0); PG8_MMA(0, 0, At, B0); PG8_BAR; PG8_SCHED;
            PG8_LDB(B1, 1, 1); PG8_STAGE(PG8_SB(1, 0), b3, voffB);
            PG8_BAR; PG8_WAIT_L(0); PG8_MMA(0, 1, At, B1); PG8_BAR;
            PG8_LDA(At, 1, 1); PG8_STAGE(PG8_SA(1, 0), a3, voffA);
            PG8_BAR; PG8_WAIT_L(0); PG8_MMA(1, 0, At, B0); PG8_BAR; PG8_SCHED;
            PG8_STAGE(PG8_SB(1, 1), b3 + hstep, voffB);
            PG8_WAIT_V(6); PG8_BAR; PG8_MMA(1, 1, At, B1); PG8_BAR;
        }
        E(acc, cur, wr, wc, fr, fq); S.done(cur);
        if (!has_next) break;
#pragma unroll
        for (int a = 0; a < 2; ++a)
#pragma unroll
            for (int b = 0; b < 2; ++b)
#pragma unroll
                for (int m = 0; m < 4; ++m)
#pragma unroll
                    for (int n = 0; n < 2; ++n) acc[a][b][m][n] = (f32x4){0.f, 0.f, 0.f, 0.f};
        cur = nxt; cA = nA; cB = nB; ++ui;
    }
    PG8_WAIT_V(0);
    if (wr == 0) PG8_BAR;
    PG8_BAR;
#undef PG8_SA
#undef PG8_SB
#undef PG8_STAGE
#undef PG8_LDA
#undef PG8_LDB
#undef PG8_MMA
#undef PG8_WAIT_V
#undef PG8_WAIT_L
#undef PG8_BAR
#undef PG8_SCHED
}
}


constexpr int NTHR_ = 512;
namespace att {
typedef short bf16x8 __attribute__((ext_vector_type(8)));
typedef float f32x16 __attribute__((ext_vector_type(16)));
typedef __bf16 bf16v2 __attribute__((ext_vector_type(2)));
typedef float f32v2 __attribute__((ext_vector_type(2)));
constexpr int PADF = 64, TS = PADF + 1024, TW = PADF + 512 + 64;
constexpr int IMPS = 129;
constexpr int L_TAB = 0, L_TABW = 17408, L_IMP = 27648, L_MASK = 60672, L_K = 61696, L_V = 78080, L_ML = 94464;
#define MFMA32(a, b, c) __builtin_amdgcn_mfma_f32_32x32x16_bf16((a), (b), (c), 0, 0, 0)
DEV unsigned pk2(float lo, float hi) { f32v2 v = {lo, hi}; bf16v2 r = __builtin_convertvector(v, bf16v2); return __builtin_bit_cast(unsigned, r); }
DEV bf16x8 pack8(const f32x16& x, int s) {
    typedef unsigned u32x4 __attribute__((ext_vector_type(4)));
    u32x4 q; q[0] = pk2(x[8 * s], x[8 * s + 1]); q[1] = pk2(x[8 * s + 2], x[8 * s + 3]); q[2] = pk2(x[8 * s + 4], x[8 * s + 5]); q[3] = pk2(x[8 * s + 6], x[8 * s + 7]);
    return __builtin_bit_cast(bf16x8, q);
}
DEV float xmax32(float x) { const auto r = __builtin_amdgcn_permlane32_swap(__float_as_uint(x), __float_as_uint(x), false, false); return fmaxf(__uint_as_float(r[0]), __uint_as_float(r[1])); }
constexpr float DEFER_THR = 8.0f;
struct Ctx {
    PG8_LAS unsigned char* lds; int tid, lane, l32, h, g, half, xr; int t, t0, tok; bf16x8 qf[4];
};
struct Acc { f32x16 o0, o1; float m, l; };
DEV void acc_init(Acc& a) {
#pragma unroll
    for (int i = 0; i < 16; ++i) { a.o0[i] = 0.f; a.o1[i] = 0.f; }
    a.m = -1e30f; a.l = 0.f;
}
typedef unsigned u32x4 __attribute__((ext_vector_type(4)));
DEV u32x4 tile_load(const act_t* base, size_t row_stride, int tid) { const int row = tid >> 3, ch = tid & 7; return *(const u32x4*)(base + (size_t)row * row_stride + ch * 8); }
DEV void tile_store(PG8_LAS unsigned char* buf, u32x4 v, int tid) { const int row = tid >> 3, ch = tid & 7; *(PG8_LAS u32x4*)(buf + row * 128 + ((ch ^ (row & 7)) << 4)) = v; }
DEV bf16x8 frag(const PG8_LAS unsigned char* buf, int row, int ch, int xr) { return *(const PG8_LAS bf16x8*)(buf + row * 128 + ((ch ^ xr) << 4)); }

template <int MODE>
DEV void attend(const Ctx& c, Acc& a, const act_t* Kb, size_t kstride, const act_t* Vtb, size_t vstride, int jlo, int jhi, int jd, unsigned m0, unsigned m1, unsigned m2, unsigned m3, float mfin, float invl) {
    PG8_LAS unsigned char* lds = c.lds;
    const PG8_LAS float* tab = (MODE == 3) ? (const PG8_LAS float*)(lds + L_TABW) + c.g * TW : (const PG8_LAS float*)(lds + L_TAB) + c.g * TS;
    u32x4 kreg = tile_load(Kb + (size_t)jlo * 64 * kstride, kstride, c.tid), vreg = {0u, 0u, 0u, 0u};
    if (MODE != 0) vreg = tile_load(Vtb + (size_t)jlo * 64, vstride, c.tid);
    tile_store(lds + L_K, kreg, c.tid); if (MODE != 0) tile_store(lds + L_V, vreg, c.tid);
    __syncthreads();
    int cur = 0;
    for (int j = jlo; j <= jhi; ++j) {
        const bool more = j < jhi;
        if (more) { kreg = tile_load(Kb + (size_t)(j + 1) * 64 * kstride, kstride, c.tid); if (MODE != 0) vreg = tile_load(Vtb + (size_t)(j + 1) * 64, vstride, c.tid); }
        const PG8_LAS unsigned char* kb = lds + L_K + cur * 8192; const PG8_LAS unsigned char* vb = lds + L_V + cur * 8192;
        f32x16 s0, s1;
#pragma unroll
        for (int i = 0; i < 16; ++i) { s0[i] = 0.f; s1[i] = 0.f; }
#pragma unroll
        for (int ks = 0; ks < 4; ++ks) { s0 = MFMA32(frag(kb, c.l32, 2 * ks + c.h, c.xr), c.qf[ks], s0); s1 = MFMA32(frag(kb, 32 + c.l32, 2 * ks + c.h, c.xr), c.qf[ks], s1); }
        bool sel = true;
        if (MODE == 2) { const unsigned w = (j < 32) ? m0 : (j < 64) ? m1 : (j < 96) ? m2 : m3; sel = (w >> (j & 31)) & 1u; }
        const bool far = (MODE == 2) ? (64 * j <= c.t0 - 853) : (MODE <= 1) ? (16 * (64 * j + 63) + 31 + 790 <= c.t0) : false;
        float cf = 0.f;
        if (far) cf = tab[PADF + 1023];
        else if (MODE >= 2) {
            const PG8_LAS float* tp = tab + (PADF + c.t - j * 64 - 4 * c.h);
            float tb[32];
#pragma unroll
            for (int i = 0; i < 32; ++i) tb[i] = tp[-((i >> 4) * 32 + (i & 3) + 8 * ((i & 15) >> 2))];
#pragma unroll
            for (int i = 0; i < 16; ++i) { s0[i] += tb[i]; s1[i] += tb[16 + i]; }
        } else {
#pragma unroll
            for (int kt = 0; kt < 2; ++kt)
#pragma unroll
                for (int i = 0; i < 16; ++i) {
                    const int kidx = j * 64 + kt * 32 + (i & 3) + 8 * (i >> 2) + 4 * c.h;
                    const int dist = c.t - 16 * kidx - 31;
                    const int ix = PADF + clampi3(dist, -1, 1023);
                    if (kt) s1[i] += tab[ix]; else s0[i] += tab[ix];
                }
        }
        if (MODE == 1) {
            const float mr = mfin - cf;
#pragma unroll
            for (int i = 0; i < 16; ++i) { s0[i] = __builtin_amdgcn_exp2f(s0[i] - mr) * invl; s1[i] = __builtin_amdgcn_exp2f(s1[i] - mr) * invl; }
            PG8_LAS float* imp = (PG8_LAS float*)(lds + L_IMP) + c.tok * IMPS;
#pragma unroll
            for (int kt = 0; kt < 2; ++kt)
#pragma unroll
                for (int i = 0; i < 4; ++i) {
                    const float p0 = kt ? s1[4 * i] : s0[4 * i], p1 = kt ? s1[4 * i + 1] : s0[4 * i + 1], p2 = kt ? s1[4 * i + 2] : s0[4 * i + 2], p3 = kt ? s1[4 * i + 3] : s0[4 * i + 3];
                    float gs = (p0 + p1) + (p2 + p3), ps = p3;
                    gs += __shfl_xor(gs, 8); ps += __shfl_xor(ps, 8); gs += __shfl_xor(gs, 16); ps += __shfl_xor(ps, 16);
                    const int jb = (j * 64 + kt * 32 + 8 * i + 4 * c.h) >> 2;
                    if (c.l32 < 8) { imp[jb] += gs; }
                    if (c.l32 < 8 && jb + 1 < 128) { imp[jb + 1] += ps; }
                }
        } else {
            float mx = s0[0];
#pragma unroll
            for (int i = 1; i < 16; ++i) mx = fmaxf(mx, s0[i]);
#pragma unroll
            for (int i = 0; i < 16; ++i) mx = fmaxf(mx, s1[i]);
            mx = xmax32(mx) + cf;
            if (MODE == 2 && !sel) mx = -INFINITY;
            const bool grow = mx > a.m + DEFER_THR;
            if (__any(grow)) {
                const float mn = grow ? mx : a.m, alpha = __builtin_amdgcn_exp2f(a.m - mn);
                a.m = mn; a.l *= alpha;
                if (MODE != 0) {
#pragma unroll
                    for (int i = 0; i < 16; ++i) { a.o0[i] *= alpha; a.o1[i] *= alpha; }
                }
            }
            const float mref = (MODE == 2 && !sel) ? 1e30f : a.m - cf;
            float ls = 0.f;
#pragma unroll
            for (int i = 0; i < 16; ++i) { s0[i] = __builtin_amdgcn_exp2f(s0[i] - mref); s1[i] = __builtin_amdgcn_exp2f(s1[i] - mref); ls += s0[i] + s1[i]; }
            a.l += ls;
        }
        if (MODE != 0) {
#pragma unroll
            for (int kt = 0; kt < 2; ++kt)
#pragma unroll
                for (int sp = 0; sp < 2; ++sp) {
                    const bf16x8 pf = pack8(kt ? s1 : s0, sp);
                    a.o0 = MFMA32(frag(vb, c.l32, kt * 4 + 2 * sp + c.h, c.xr), pf, a.o0);
                    a.o1 = MFMA32(frag(vb, 32 + c.l32, kt * 4 + 2 * sp + c.h, c.xr), pf, a.o1);
                }
        }
        if (more) { tile_store(lds + L_K + (cur ^ 1) * 8192, kreg, c.tid); if (MODE != 0) tile_store(lds + L_V + (cur ^ 1) * 8192, vreg, c.tid); }
        __syncthreads();
        cur ^= 1;
    }
}

DEV void topk_pair(PG8_LAS unsigned char* lds, int tokL, int jd, int lane) {
    const int hf = lane >> 5, l = lane & 31, tk = tokL + hf;
    const PG8_LAS float* imp = (const PG8_LAS float*)(lds + L_IMP) + tk * IMPS;
    PG8_LAS unsigned* mk = (PG8_LAS unsigned*)(lds + L_MASK) + tk * 4;
    const unsigned hsh = hf * 32;
    if (jd + 1 <= 16) { const unsigned bb = (unsigned)(__ballot(l <= jd) >> hsh); if (l == 0) { mk[0] = bb; mk[1] = 0u; mk[2] = 0u; mk[3] = 0u; } return; }
    unsigned v[4]; bool cd[4];
#pragma unroll
    for (int k = 0; k < 4; ++k) { const int j = l + 32 * k; cd[k] = j >= 1 && j < jd; v[k] = cd[k] ? __float_as_uint(imp[j]) : 0u; }
    const int K = 14; unsigned thr = 0u;
    for (int bit = 30; bit >= 0; --bit) {
        const unsigned cand = thr | (1u << bit); int cnt = 0;
#pragma unroll
        for (int k = 0; k < 4; ++k) cnt += __popc((unsigned)(__ballot(cd[k] && v[k] >= cand) >> hsh));
        if (cnt >= K) thr = cand;
    }
    int ngt = 0;
#pragma unroll
    for (int k = 0; k < 4; ++k) ngt += __popc((unsigned)(__ballot(cd[k] && v[k] > thr) >> hsh));
    const int need = K - ngt; const unsigned below = (1u << l) - 1u; int before = 0;
#pragma unroll
    for (int k = 0; k < 4; ++k) { const int j = l + 32 * k; const unsigned eq = (unsigned)(__ballot(cd[k] && v[k] == thr) >> hsh);
        const bool sl = (j == 0) || (j == jd) || (cd[k] && (v[k] > thr || (v[k] == thr && before + __popc(eq & below) < need)));
        before += __popc(eq);
        const unsigned bb = (unsigned)(__ballot(sl) >> hsh);
        if (l == 0) mk[k] = bb; }
}

DEV void topk_oct(PG8_LAS unsigned char* lds, int tok0, int jd, int lane) {
    const int hf = lane >> 5, l = lane & 31; const unsigned hsh = hf * 32;
    PG8_LAS unsigned* mk0 = (PG8_LAS unsigned*)(lds + L_MASK) + (tok0 + hf) * 4;
    if (jd + 1 <= 16) { const unsigned bb = (unsigned)(__ballot(l <= jd) >> hsh);
        if (l == 0) {
#pragma unroll
            for (int pr = 0; pr < 4; ++pr) { mk0[pr * 8] = bb; mk0[pr * 8 + 1] = 0u; mk0[pr * 8 + 2] = 0u; mk0[pr * 8 + 3] = 0u; } }
        return; }
    bool cd[4]; unsigned v[4][4];
#pragma unroll
    for (int k = 0; k < 4; ++k) { const int j = l + 32 * k; cd[k] = j >= 1 && j < jd; }
#pragma unroll
    for (int pr = 0; pr < 4; ++pr) { const PG8_LAS float* imp = (const PG8_LAS float*)(lds + L_IMP) + (tok0 + 2 * pr + hf) * IMPS;
#pragma unroll
        for (int k = 0; k < 4; ++k) v[pr][k] = cd[k] ? __float_as_uint(imp[l + 32 * k]) : 0u; }
    const int K = 14; unsigned thr[4] = {0u, 0u, 0u, 0u};
    for (int bit = 30; bit >= 0; --bit) {
#pragma unroll
        for (int pr = 0; pr < 4; ++pr) {
            const unsigned cand = thr[pr] | (1u << bit); int cnt = 0;
#pragma unroll
            for (int k = 0; k < 4; ++k) cnt += __popc((unsigned)(__ballot(cd[k] && v[pr][k] >= cand) >> hsh));
            if (cnt >= K) thr[pr] = cand;
        }
    }
#pragma unroll
    for (int pr = 0; pr < 4; ++pr) {
        int ngt = 0;
#pragma unroll
        for (int k = 0; k < 4; ++k) ngt += __popc((unsigned)(__ballot(cd[k] && v[pr][k] > thr[pr]) >> hsh));
        const int need = K - ngt; const unsigned below = (1u << l) - 1u; int before = 0;
#pragma unroll
        for (int k = 0; k < 4; ++k) { const int j = l + 32 * k; const unsigned eq = (unsigned)(__ballot(cd[k] && v[pr][k] == thr[pr]) >> hsh);
            const bool sl = (j == 0) || (j == jd) || (cd[k] && (v[pr][k] > thr[pr] || (v[pr][k] == thr[pr] && before + __popc(eq & below) < need)));
            before += __popc(eq);
            const unsigned bb = (unsigned)(__ballot(sl) >> hsh);
            if (l == 0) mk0[pr * 8 + k] = bb; }
    }
}

DEV void unit(const P& p, PG8_LAS unsigned char* lds, int b, int kvh, int tile, bool build_tab) {
    Ctx c; c.lds = lds; c.tid = fresh_tid(); c.lane = c.tid & 63; c.l32 = c.lane & 31; c.h = c.lane >> 5; c.xr = c.l32 & 7;
    const int wid = __builtin_amdgcn_readfirstlane(c.tid >> 6); c.g = wid & 3; c.half = wid >> 2;
    c.t0 = tile * 64; c.t = c.t0 + c.half * 32 + c.l32;
    const int head = kvh * 4 + c.g, jd = tile; const size_t row = (size_t)b * SEQ + c.t;
#pragma unroll
    for (int s = 0; s < 4; ++s) c.qf[s] = *(const bf16x8*)(p.qb + row * 512 + head * 64 + 16 * s + 8 * c.h);
    const float g0 = sigmoidf_(p.gatef[row * 32 + head * 3]), g1 = sigmoidf_(p.gatef[row * 32 + head * 3 + 1]), g2 = sigmoidf_(p.gatef[row * 32 + head * 3 + 2]);
    __syncthreads();
    if (build_tab) {
    for (int i = c.tid; i < 4 * TS; i += NTHR_) { const int gg = i / TS, dd = i % TS - PADF; ((PG8_LAS float*)(lds + L_TAB))[i] = dd < 0 ? -INFINITY : p.rel_bias[rel_bucket(dd) * 8 + kvh * 4 + gg] * LOG2E; }
    for (int i = c.tid; i < 4 * TW; i += NTHR_) { const int gg = i / TW, dd = i % TW - PADF; ((PG8_LAS float*)(lds + L_TABW))[i] = (dd < 0 || dd >= 512) ? -INFINITY : p.rel_bias[rel_bucket(dd) * 8 + kvh * 4 + gg] * LOG2E; }
    }
    for (int i = c.tid; i < 64 * IMPS; i += NTHR_) ((PG8_LAS float*)(lds + L_IMP))[i] = 0.f;
    __syncthreads();
    const size_t bh = (size_t)b * 2 + kvh;
    const act_t* Kc = p.kc + bh * NCPAD * 64; const act_t* Vct = p.vct + bh * 64 * NCPAD;
    const act_t* Ks = p.kvb + (size_t)b * SEQ * 512 + 256 + kvh * 64; const act_t* Vst = p.vst + bh * 64 * SEQ;
    const act_t* Kw = p.kwb + (size_t)b * SEQ * 256 + kvh * 64;       const act_t* Vwt = p.vwt + bh * 64 * SEQ;
    const int cjhi = ((c.t0 + 32) / 16) / 64;
    c.tok = c.half * 32 + c.l32;
    Acc a; acc_init(a);
    attend<0>(c, a, Kc, 64, Vct, NCPAD, 0, cjhi, jd, 0, 0, 0, 0, 0.f, 0.f);
    {
        const float lt0 = a.l + __shfl_xor(a.l, 32);
        PG8_LAS float* ml = (PG8_LAS float*)(lds + L_ML);
        if (c.h == 0) { ml[(c.tok * 4 + c.g) * 2] = a.m; ml[(c.tok * 4 + c.g) * 2 + 1] = lt0 > 0.f ? 1.0f / lt0 : 0.f; }
    }
    __syncthreads();
    typedef float f32x4 __attribute__((ext_vector_type(4)));
    {
        Ctx c2 = c; c2.g = c.l32 >> 3; c2.tok = wid * 8 + (c.l32 & 7); c2.t = c.t0 + c2.tok;
        const int head2 = kvh * 4 + c2.g; const size_t row2 = (size_t)b * SEQ + c2.t;
#pragma unroll
        for (int s2 = 0; s2 < 4; ++s2) c2.qf[s2] = *(const bf16x8*)(p.qb + row2 * 512 + head2 * 64 + 16 * s2 + 8 * c.h);
        const PG8_LAS float* ml = (const PG8_LAS float*)(lds + L_ML);
        const float mfin = ml[(c2.tok * 4 + c2.g) * 2], invl = ml[(c2.tok * 4 + c2.g) * 2 + 1];
        const float g0b = sigmoidf_(p.gatef[row2 * 32 + head2 * 3]);
        acc_init(a);
        attend<1>(c2, a, Kc, 64, Vct, NCPAD, 0, cjhi, jd, 0, 0, 0, 0, mfin, invl);
        float* tr2 = p.oc + row2 * 512 + head2 * 64 + 4 * c.h;
#pragma unroll
        for (int i = 0; i < 4; ++i) {
            *(f32x4*)(tr2 + 8 * i) = (f32x4){g0b * a.o0[4 * i], g0b * a.o0[4 * i + 1], g0b * a.o0[4 * i + 2], g0b * a.o0[4 * i + 3]};
            *(f32x4*)(tr2 + 32 + 8 * i) = (f32x4){g0b * a.o1[4 * i], g0b * a.o1[4 * i + 1], g0b * a.o1[4 * i + 2], g0b * a.o1[4 * i + 3]};
        }
        __builtin_amdgcn_fence(__ATOMIC_RELEASE, "workgroup");
    }
    float* trow = p.oc + row * 512 + head * 64 + 4 * c.h;
    float lt;
    topk_oct(lds, wid * 8, jd, c.lane);
    __syncthreads();
    const PG8_LAS unsigned* mk = (const PG8_LAS unsigned*)(lds + L_MASK) + (c.half * 32 + c.l32) * 4;
    const unsigned m0 = mk[0], m1 = mk[1], m2 = mk[2], m3 = mk[3];
    acc_init(a);
    attend<2>(c, a, Ks, 512, Vst, SEQ, 0, jd, jd, m0, m1, m2, m3, 0.f, 0.f);
    lt = a.l + __shfl_xor(a.l, 32);
    { const float sc = g1 / lt;
#pragma unroll
      for (int i = 0; i < 4; ++i) {
          f32x4 u = *(f32x4*)(trow + 8 * i), v = *(f32x4*)(trow + 32 + 8 * i);
#pragma unroll
          for (int r = 0; r < 4; ++r) { u[r] += sc * a.o0[4 * i + r]; v[r] += sc * a.o1[4 * i + r]; }
          *(f32x4*)(trow + 8 * i) = u; *(f32x4*)(trow + 32 + 8 * i) = v;
      } }
    acc_init(a);
    attend<3>(c, a, Kw, 256, Vwt, SEQ, jd >= 8 ? jd - 8 : 0, jd, jd, 0, 0, 0, 0, 0.f, 0.f);
    lt = a.l + __shfl_xor(a.l, 32);
    act_t* orow = p.mixb + row * 1024 + head * 64;
    { const float sc = g2 / lt;
      typedef unsigned u32x2 __attribute__((ext_vector_type(2)));
#pragma unroll
      for (int i = 0; i < 4; ++i) {
          f32x4 u = *(f32x4*)(trow + 8 * i), v = *(f32x4*)(trow + 32 + 8 * i);
#pragma unroll
          for (int r = 0; r < 4; ++r) { u[r] += sc * a.o0[4 * i + r]; v[r] += sc * a.o1[4 * i + r]; }
          u32x2 w0; w0[0] = pk2(u[0], u[1]); w0[1] = pk2(u[2], u[3]); *(u32x2*)(orow + 8 * i + 4 * c.h) = w0;
          u32x2 w1; w1[0] = pk2(v[0], v[1]); w1[1] = pk2(v[2], v[3]); *(u32x2*)(orow + 32 + 8 * i + 4 * c.h) = w1;
      } }
}
}


namespace atts {
using att::bf16x8; using att::f32x16; using att::Acc; using att::acc_init; using att::pack8; using att::pk2; using att::frag;
typedef float f32x4 __attribute__((ext_vector_type(4)));
typedef unsigned u32x4 __attribute__((ext_vector_type(4)));
constexpr int TABN = 856;
constexpr int L_TAB = 131088, L_MASK = L_TAB + 4 * TABN * 4;
constexpr int L_IMP = 0, IMPW = 321;
constexpr int L_XCH = 0;
static_assert(L_MASK + 8 * 12 * 4 <= 147440 && NSB_S <= 288 && NSB_S > 256 && NC_S + 1 == NCSPAD, "sample attention LDS map / shapes");
struct Cs { PG8_LAS unsigned char* lds; int lane, l32, h, xr, wid, i, g, t; const PG8_LAS float* tabp; const act_t* qp; };
DEV bf16x8 qfrag(const Cs& c, int ks) { return *(const bf16x8*)(c.qp + 16 * ks); }

template <int MODE>
DEV void smath(const Cs& c, Acc& a, f32x16& s0, f32x16& s1, int kbase, bool sel, float mfin, float invl) {
#pragma unroll
    for (int kt = 0; kt < 2; ++kt)
#pragma unroll
        for (int r = 0; r < 16; ++r) {
            const int kidx = kbase + kt * 32 + (r & 3) + 8 * (r >> 2) + 4 * c.h;
            const int dist = (MODE <= 1) ? c.t - 16 * kidx - 31 : c.t - kidx;
            int ix = clampi3(dist + 1, 0, TABN - 1);
            if (MODE == 3) ix = dist >= 512 ? 0 : ix;
            if (kt) s1[r] += c.tabp[ix]; else s0[r] += c.tabp[ix];
        }
    if (MODE == 1) {
#pragma unroll
        for (int r = 0; r < 16; ++r) { s0[r] = __builtin_amdgcn_exp2f(s0[r] - mfin) * invl; s1[r] = __builtin_amdgcn_exp2f(s1[r] - mfin) * invl; }
        return;
    }
    float mx = s0[0];
#pragma unroll
    for (int r = 1; r < 16; ++r) mx = fmaxf(mx, s0[r]);
#pragma unroll
    for (int r = 0; r < 16; ++r) mx = fmaxf(mx, s1[r]);
    mx = att::xmax32(mx);
    if (MODE == 2 && !sel) mx = -INFINITY;
    const bool grow = mx > a.m + att::DEFER_THR;
    if (__any(grow)) {
        const float mn = grow ? mx : a.m, alpha = __builtin_amdgcn_exp2f(a.m - mn);
        a.m = mn; a.l *= alpha;
        if (MODE != 0) {
#pragma unroll
            for (int r = 0; r < 16; ++r) { a.o0[r] *= alpha; a.o1[r] *= alpha; }
        }
    }
    const float mref = (MODE == 2 && !sel) ? 1e30f : a.m;
    float ls = 0.f;
#pragma unroll
    for (int r = 0; r < 16; ++r) { s0[r] = __builtin_amdgcn_exp2f(s0[r] - mref); s1[r] = __builtin_amdgcn_exp2f(s1[r] - mref); ls += s0[r] + s1[r]; }
    a.l += ls;
}
DEV void stage_rows(PG8_LAS unsigned char* kt_, PG8_LAS unsigned char* vt_, const float* krow0, const float* vrow0, const float* krow1, const float* vrow1, int l32, int hh) {
#pragma unroll
    for (int ps = 0; ps < 2; ++ps) {
        const float* kr = ps ? krow1 : krow0; const float* vr = ps ? vrow1 : vrow0; const int row = ps * 32 + l32;
        {
            f32x4 kv[8];
#pragma unroll
            for (int q = 0; q < 8; ++q) kv[q] = kr ? *(const f32x4*)(kr + hh * 32 + q * 4) : (f32x4){0.f, 0.f, 0.f, 0.f};
#pragma unroll
            for (int q = 0; q < 4; ++q) { u32x4 o; o[0] = pk2(kv[2 * q][0], kv[2 * q][1]); o[1] = pk2(kv[2 * q][2], kv[2 * q][3]); o[2] = pk2(kv[2 * q + 1][0], kv[2 * q + 1][1]); o[3] = pk2(kv[2 * q + 1][2], kv[2 * q + 1][3]);
                *(PG8_LAS u32x4*)(kt_ + row * 128 + (((hh * 4 + q) ^ (row & 7)) << 4)) = o; }
        }
        __builtin_amdgcn_sched_barrier(0);
        {
            f32x4 vv[8];
#pragma unroll
            for (int q = 0; q < 8; ++q) vv[q] = vr ? *(const f32x4*)(vr + hh * 32 + q * 4) : (f32x4){0.f, 0.f, 0.f, 0.f};
            const int pos = perm16(row);
#pragma unroll
            for (int q = 0; q < 8; ++q)
#pragma unroll
                for (int e = 0; e < 4; ++e) { const int d = hh * 32 + q * 4 + e; *(PG8_LAS unsigned short*)(vt_ + d * 128 + (((pos >> 3) ^ (d & 7)) << 4) + (pos & 7) * 2) = to_act(vv[q][e]); }
        }
        __builtin_amdgcn_sched_barrier(0);
    }
}
DEV void qk_lds(const Cs& c, const PG8_LAS unsigned char* kb, f32x16& s0, f32x16& s1) {
#pragma unroll
    for (int r = 0; r < 16; ++r) { s0[r] = 0.f; s1[r] = 0.f; }
#pragma unroll
    for (int ks = 0; ks < 4; ++ks) { s0 = MFMA32(frag(kb, c.l32, 2 * ks + c.h, c.xr), qfrag(c, ks), s0); s1 = MFMA32(frag(kb, 32 + c.l32, 2 * ks + c.h, c.xr), qfrag(c, ks), s1); }
}
DEV void pv_lds(const Cs& c, const PG8_LAS unsigned char* vb, Acc& a, const f32x16& s0, const f32x16& s1) {
#pragma unroll
    for (int kt = 0; kt < 2; ++kt)
#pragma unroll
        for (int sp = 0; sp < 2; ++sp) { const bf16x8 pf = pack8(kt ? s1 : s0, sp);
            a.o0 = MFMA32(frag(vb, c.l32, kt * 4 + 2 * sp + c.h, c.xr), pf, a.o0); a.o1 = MFMA32(frag(vb, 32 + c.l32, kt * 4 + 2 * sp + c.h, c.xr), pf, a.o1); }
}
template <bool NORM = true>
DEV void merge(const Cs& c, Acc& a, float gate) {
    PG8_LAS float* x = (PG8_LAS float*)(c.lds + L_XCH);
    const float lp = a.l + __shfl_xor(a.l, 32);
    __syncthreads();
    PG8_LAS float* mine = x + (c.wid * 64 + c.lane) * 34;
    mine[0] = a.m; mine[1] = lp;
#pragma unroll
    for (int r = 0; r < 16; ++r) { mine[2 + r] = a.o0[r]; mine[18 + r] = a.o1[r]; }
    __syncthreads();
    float M = -1e30f;
#pragma unroll
    for (int w = 0; w < 8; ++w) M = fmaxf(M, x[(w * 64 + c.lane) * 34]);
    float L = 0.f;
#pragma unroll
    for (int r = 0; r < 16; ++r) { a.o0[r] = 0.f; a.o1[r] = 0.f; }
#pragma unroll 1
    for (int w = 0; w < 8; ++w) { const PG8_LAS float* q = x + (w * 64 + c.lane) * 34; const float sc = __builtin_amdgcn_exp2f(q[0] - M); L += q[1] * sc;
#pragma unroll
        for (int r = 0; r < 16; ++r) { a.o0[r] += sc * q[2 + r]; a.o1[r] += sc * q[18 + r]; } }
    if (NORM) { const float f = L > 0.f ? gate / L : 0.f;
#pragma unroll
        for (int r = 0; r < 16; ++r) { a.o0[r] *= f; a.o1[r] *= f; } }
    a.m = M; a.l = L;
}
constexpr int NPART = 4;
DEV void unit(const P& p, PG8_LAS unsigned char* lds, int b, int kvh, int part) {
    Cs c; c.lds = lds; const int tid = fresh_tid(); c.lane = tid & 63; c.l32 = c.lane & 31; c.h = c.lane >> 5; c.xr = c.l32 & 7;
    c.wid = __builtin_amdgcn_readfirstlane(tid >> 6); c.i = c.l32 & 7; c.g = c.l32 >> 3; c.t = PAST + c.i;
    const int head = kvh * 4 + c.g; const size_t row = (size_t)TOKP + b * DS + c.i;
    c.qp = p.qb + row * 512 + head * 64 + 8 * c.h;
    const float g0 = sigmoidf_(p.gatef[row * 32 + head * 3]), g1 = sigmoidf_(p.gatef[row * 32 + head * 3 + 1]), g2 = sigmoidf_(p.gatef[row * 32 + head * 3 + 2]);
    __syncthreads();
    for (int k = tid; k < 4 * TABN; k += NTHR_) { const int e = k % TABN; ((PG8_LAS float*)(lds + L_TAB))[k] = e == 0 ? -INFINITY : p.rel_bias[rel_bucket(e - 1) * 8 + kvh * 4 + k / TABN] * LOG2E; }
    for (int k = tid; k < 8 * IMPW; k += NTHR_) ((PG8_LAS float*)(lds + L_IMP))[k] = 0.f;
    __syncthreads();
    c.tabp = (const PG8_LAS float*)(lds + L_TAB) + c.g * TABN;
    const size_t bh = (size_t)b * 2 + kvh;
    const act_t* Kc = p.kcs + bh * NCSPAD * 64; const act_t* Vct = p.vcts + bh * 64 * NCSPAD;
    constexpr int NCB = NCSPAD / 64;
    Acc a; acc_init(a); f32x16 s0, s1;
    static_assert(NCB == 16, "each wave owns compressed key blocks wid and wid + 8");
    bf16x8 kf[2][8];
#pragma unroll
    for (int bl = 0; bl < 2; ++bl)
#pragma unroll
        for (int ks = 0; ks < 4; ++ks) { const int jb = c.wid + 8 * bl;
            kf[bl][2 * ks] = *(const bf16x8*)(Kc + (size_t)(jb * 64 + c.l32) * 64 + 16 * ks + 8 * c.h); kf[bl][2 * ks + 1] = *(const bf16x8*)(Kc + (size_t)(jb * 64 + 32 + c.l32) * 64 + 16 * ks + 8 * c.h); }
#pragma unroll
    for (int bl = 0; bl < 2; ++bl) { const int jb = c.wid + 8 * bl;
#pragma unroll
        for (int r = 0; r < 16; ++r) { s0[r] = 0.f; s1[r] = 0.f; }
#pragma unroll
        for (int ks = 0; ks < 4; ++ks) { const bf16x8 qf = qfrag(c, ks); s0 = MFMA32(kf[bl][2 * ks], qf, s0); s1 = MFMA32(kf[bl][2 * ks + 1], qf, s1); }
        smath<0>(c, a, s0, s1, jb * 64, true, 0.f, 0.f);
    }
    merge(c, a, 1.0f);
    const float mfin = a.m, invl = a.l > 0.f ? 1.0f / a.l : 0.f;
    __syncthreads();
    for (int k = tid; k < 8 * IMPW; k += NTHR_) ((PG8_LAS float*)(lds + L_IMP))[k] = 0.f;
    __syncthreads();
    acc_init(a);
    bf16x8 vf[2][8];
#pragma unroll
    for (int bl = 0; bl < 2; ++bl)
#pragma unroll
        for (int q = 0; q < 4; ++q) { const int jb = c.wid + 8 * bl;
            vf[bl][2 * q] = *(const bf16x8*)(Vct + (size_t)c.l32 * NCSPAD + jb * 64 + 16 * q + 8 * c.h); vf[bl][2 * q + 1] = *(const bf16x8*)(Vct + (size_t)(32 + c.l32) * NCSPAD + jb * 64 + 16 * q + 8 * c.h); }
#pragma unroll
    for (int bl = 0; bl < 2; ++bl) { const int jb = c.wid + 8 * bl;
#pragma unroll
        for (int r = 0; r < 16; ++r) { s0[r] = 0.f; s1[r] = 0.f; }
#pragma unroll
        for (int ks = 0; ks < 4; ++ks) { const bf16x8 qf = qfrag(c, ks); s0 = MFMA32(kf[bl][2 * ks], qf, s0); s1 = MFMA32(kf[bl][2 * ks + 1], qf, s1); }
        smath<1>(c, a, s0, s1, jb * 64, true, mfin, invl);
        PG8_LAS float* imp = (PG8_LAS float*)(lds + L_IMP) + c.i * IMPW;
#pragma unroll
        for (int kt = 0; kt < 2; ++kt)
#pragma unroll
            for (int q = 0; q < 4; ++q) {
                const float p0 = kt ? s1[4 * q] : s0[4 * q], p1 = kt ? s1[4 * q + 1] : s0[4 * q + 1], p2 = kt ? s1[4 * q + 2] : s0[4 * q + 2], p3 = kt ? s1[4 * q + 3] : s0[4 * q + 3];
                const int jbk = (jb * 64 + kt * 32 + 8 * q + 4 * c.h) >> 2;
                __hip_atomic_fetch_add(imp + jbk, (p0 + p1) + (p2 + p3), __ATOMIC_RELAXED, __HIP_MEMORY_SCOPE_WORKGROUP);
                __hip_atomic_fetch_add(imp + jbk + 1, p3, __ATOMIC_RELAXED, __HIP_MEMORY_SCOPE_WORKGROUP);
            }
#pragma unroll
        for (int kt = 0; kt < 2; ++kt)
#pragma unroll
            for (int sp = 0; sp < 2; ++sp) { const bf16x8 pf = pack8(kt ? s1 : s0, sp);
                a.o0 = MFMA32(vf[bl][2 * (kt * 2 + sp)], pf, a.o0);
                a.o1 = MFMA32(vf[bl][2 * (kt * 2 + sp) + 1], pf, a.o1); }
    }
    __syncthreads();
    {
        const PG8_LAS float* imp = (const PG8_LAS float*)(lds + L_IMP) + c.wid * IMPW; constexpr int jd = NSB_S - 1, K = 14;
        unsigned v[5]; bool cd[5];
#pragma unroll
        for (int k = 0; k < 5; ++k) { const int j = c.lane + 64 * k; cd[k] = j >= 1 && j < jd; v[k] = cd[k] ? __float_as_uint(imp[j]) : 0u; }
        unsigned thr = 0u;
        for (int bit = 30; bit >= 0; --bit) { const unsigned cand = thr | (1u << bit); int cnt = 0;
#pragma unroll
            for (int k = 0; k < 5; ++k) cnt += __popcll(__ballot(cd[k] && v[k] >= cand));
            if (cnt >= K) thr = cand; }
        int ngt = 0;
#pragma unroll
        for (int k = 0; k < 5; ++k) ngt += __popcll(__ballot(cd[k] && v[k] > thr));
        const int need = K - ngt; const unsigned long long below = (1ull << c.lane) - 1ull; int before = 0;
        PG8_LAS unsigned* mk = (PG8_LAS unsigned*)(lds + L_MASK) + c.wid * 12;
#pragma unroll
        for (int k = 0; k < 5; ++k) { const int j = c.lane + 64 * k; const unsigned long long eq = __ballot(cd[k] && v[k] == thr);
            const bool sl = (j == 0) || (j == jd) || (cd[k] && (v[k] > thr || (v[k] == thr && before + __popcll(eq & below) < need)));
            before += __popcll(eq);
            const unsigned long long bb = __ballot(sl);
            if (c.lane == 0) { mk[2 * k] = (unsigned)bb; mk[2 * k + 1] = (unsigned)(bb >> 32); } }
    }
    { a.m = 0.f; a.l = 0.5f; }
    merge(c, a, g0 * 8.0f);
    float* trow = p.oc + row * 512 + head * 64 + 4 * c.h;
    if (c.wid == 0 && part == 0) {
#pragma unroll
        for (int q = 0; q < 4; ++q) { *(f32x4*)(trow + 8 * q) = (f32x4){a.o0[4 * q], a.o0[4 * q + 1], a.o0[4 * q + 2], a.o0[4 * q + 3]}; *(f32x4*)(trow + 32 + 8 * q) = (f32x4){a.o1[4 * q], a.o1[4 * q + 1], a.o1[4 * q + 2], a.o1[4 * q + 3]}; }
    }
    __syncthreads();
    const PG8_LAS unsigned* mkAll = (const PG8_LAS unsigned*)(lds + L_MASK);
    PG8_LAS unsigned char* kt_ = lds + c.wid * 16384; PG8_LAS unsigned char* vt_ = kt_ + 8192;
    const int hh = c.h;
    acc_init(a);
    {
        int cnt = 0;
        for (int wd = 0; wd < 9; ++wd) {
            unsigned un = 0u;
#pragma unroll
            for (int tk = 0; tk < 8; ++tk) un |= mkAll[tk * 12 + wd];
            un = __builtin_amdgcn_readfirstlane(un);
            const unsigned mine = mkAll[c.i * 12 + wd];
            while (un) {
                const int bit = __builtin_ctz(un); un &= un - 1u; const int j = wd * 32 + bit;
                if (((cnt++) % (8 * NPART)) != part * 8 + c.wid) continue;
                const float *k0 = nullptr, *v0 = nullptr, *k1 = nullptr, *v1 = nullptr;
                if (j < PAST / 64) {
                    const int T0 = j * 64 + c.l32, T1 = T0 + 32;
                    const float* r0 = p.cache_kv + (((size_t)p.page_table[b * NPAGES + T0 / PAGE] * PAGE + T0 % PAGE) * 4) * 128 + kvh * 64;
                    const float* r1 = p.cache_kv + (((size_t)p.page_table[b * NPAGES + T1 / PAGE] * PAGE + T1 % PAGE) * 4) * 128 + kvh * 64;
                    k0 = r0 + 2 * 128; v0 = r0 + 3 * 128; k1 = r1 + 2 * 128; v1 = r1 + 3 * 128;
                } else if (c.l32 < DS) { const float* r0 = p.o_kvs + (size_t)(b * DS + c.l32) * 512 + kvh * 64; k0 = r0 + 2 * 128; v0 = r0 + 3 * 128; }
                stage_rows(kt_, vt_, k0, v0, k1, v1, c.l32, hh);
                __builtin_amdgcn_wave_barrier();
                qk_lds(c, kt_, s0, s1);
                smath<2>(c, a, s0, s1, j * 64, (mine >> bit) & 1u, 0.f, 0.f);
                pv_lds(c, vt_, a, s0, s1);
                __builtin_amdgcn_wave_barrier();
            }
        }
    }
    merge<false>(c, a, 1.0f);
    float* sp = p.spart + ((((size_t)(b * 2 + kvh) * NPART + part) * 2 + 0) * 64 + c.lane) * 34;
    if (c.wid == 0) { sp[0] = a.m; sp[1] = a.l;
#pragma unroll
        for (int r = 0; r < 16; ++r) { sp[2 + r] = a.o0[r]; sp[18 + r] = a.o1[r]; } }
    __syncthreads();
    acc_init(a);
    for (int wj = part * 8 + c.wid; wj < 9; wj += 8 * NPART) {
        const float *k0 = nullptr, *v0 = nullptr, *k1 = nullptr, *v1 = nullptr;
        { const int w0 = wj * 64 + c.l32, w1 = w0 + 32;
          if (w0 < WBS) { const float* r = p.cache_win + ((size_t)b * WBS + w0) * 256 + kvh * 64; k0 = r; v0 = r + 128; }
          else if (w0 < WBS + DS) { const float* r = p.kvwf + (size_t)(TOKP + b * DS + w0 - WBS) * 256 + kvh * 64; k0 = r; v0 = r + 128; }
          if (w1 < WBS) { const float* r = p.cache_win + ((size_t)b * WBS + w1) * 256 + kvh * 64; k1 = r; v1 = r + 128; }
          else if (w1 < WBS + DS) { const float* r = p.kvwf + (size_t)(TOKP + b * DS + w1 - WBS) * 256 + kvh * 64; k1 = r; v1 = r + 128; } }
        stage_rows(kt_, vt_, k0, v0, k1, v1, c.l32, hh);
        __builtin_amdgcn_wave_barrier();
        qk_lds(c, kt_, s0, s1);
        smath<3>(c, a, s0, s1, PAST - WBS + wj * 64, true, 0.f, 0.f);
        pv_lds(c, vt_, a, s0, s1);
        __builtin_amdgcn_wave_barrier();
    }
    merge<false>(c, a, 1.0f);
    if (c.wid == 0) { float* sw = sp + 64 * 34; sw[0] = a.m; sw[1] = a.l;
#pragma unroll
        for (int r = 0; r < 16; ++r) { sw[2 + r] = a.o0[r]; sw[18 + r] = a.o1[r]; } }
    __syncthreads();
}
DEV void finish(const P& p, int gw, int nw, int lane) {
    typedef unsigned u32x2 __attribute__((ext_vector_type(2)));
    for (int u = gw; u < DB * 2; u += nw) {
        const int b = u >> 1, kvh = u & 1, l32 = lane & 31, hh = lane >> 5, i = l32 & 7, g = l32 >> 3, head = kvh * 4 + g; const size_t row = (size_t)TOKP + b * DS + i;
        const float gs = sigmoidf_(p.gatef[row * 32 + head * 3 + 1]), gwn = sigmoidf_(p.gatef[row * 32 + head * 3 + 2]);
        float tot[32]; const float* trow = p.oc + row * 512 + head * 64 + 4 * hh;
#pragma unroll
        for (int q = 0; q < 4; ++q) { const f32x4 x = *(const f32x4*)(trow + 8 * q), y = *(const f32x4*)(trow + 32 + 8 * q);
#pragma unroll
            for (int e = 0; e < 4; ++e) { tot[4 * q + e] = x[e]; tot[16 + 4 * q + e] = y[e]; } }
#pragma unroll 1
        for (int br = 0; br < 2; ++br) {
            const float* base = p.spart + (((size_t)u * NPART) * 2 + br) * 64 * 34 + (size_t)lane * 34;
            float M = -1e30f;
#pragma unroll
            for (int pt = 0; pt < NPART; ++pt) M = fmaxf(M, base[(size_t)pt * 2 * 64 * 34]);
            float L = 0.f, acc[32];
#pragma unroll
            for (int r = 0; r < 32; ++r) acc[r] = 0.f;
#pragma unroll 1
            for (int pt = 0; pt < NPART; ++pt) { const float* q = base + (size_t)pt * 2 * 64 * 34; const float sc = __builtin_amdgcn_exp2f(q[0] - M); L += q[1] * sc;
#pragma unroll
                for (int r = 0; r < 32; ++r) acc[r] += sc * q[2 + r]; }
            const float f = (br ? gwn : gs) / L;
#pragma unroll
            for (int r = 0; r < 32; ++r) tot[r] += f * acc[r];
        }
        act_t* orow = p.mixb + row * 1024 + head * 64;
#pragma unroll
        for (int q = 0; q < 4; ++q) {
            u32x2 w0; w0[0] = att::pk2(tot[4 * q], tot[4 * q + 1]); w0[1] = att::pk2(tot[4 * q + 2], tot[4 * q + 3]); *(u32x2*)(orow + 8 * q + 4 * hh) = w0;
            u32x2 w1; w1[0] = att::pk2(tot[16 + 4 * q], tot[16 + 4 * q + 1]); w1[1] = att::pk2(tot[16 + 4 * q + 2], tot[16 + 4 * q + 3]); *(u32x2*)(orow + 32 + 8 * q + 4 * hh) = w1;
        }
    }
}
}


namespace mls {
using att::bf16x8; using att::f32x16; using att::pack8; using att::pk2;
typedef float f32x4 __attribute__((ext_vector_type(4)));
typedef unsigned u32x4 __attribute__((ext_vector_type(4)));
typedef unsigned u32x2 __attribute__((ext_vector_type(2)));
constexpr int L_Q = 0, L_K = 16384, L_VT = 32768, L_KWT = 49152, L_CT = 65536, L_G = 98304;
constexpr int G_WK = 0, G_IBL = 64, G_BML = 128, G_INT = 192, G_EMT = 256, G_NP = 320, G_SSQ = 448;
DEV PG8_LAS float* gf(PG8_LAS unsigned char* lds) { return (PG8_LAS float*)(lds + L_G); }
DEV bf16x8 frag256(const PG8_LAS unsigned char* buf, int row, int ch) { return *(const PG8_LAS bf16x8*)(buf + row * 256 + ((ch ^ (row & 15)) << 4)); }
DEV bf16x8 frag128(const PG8_LAS unsigned char* buf, int row, int ch) { return *(const PG8_LAS bf16x8*)(buf + row * 128 + ((ch ^ (row & 7)) << 4)); }
DEV float bf2f(unsigned short u) { return __uint_as_float((unsigned)u << 16); }
DEV void put_t(PG8_LAS unsigned char* img, int s, int c0, const float* f, float scale) {
    const int pos = perm16(s);
#pragma unroll
    for (int e = 0; e < 8; ++e) { const int c = c0 + e; *(PG8_LAS unsigned short*)(img + c * 128 + (((pos >> 3) ^ (c & 7)) << 4) + (pos & 7) * 2) = to_act(f[e] * scale); }
}
DEV void stage_vT(const P& p, PG8_LAS unsigned char* lds, int r0, int cl, int h, int tid) {
#pragma unroll
    for (int i = 0; i < 2; ++i) { const int it = tid + 512 * i, srow = it >> 4, ch = it & 15; float f[8];
        if (srow < cl) { const u32x4 raw = *(const u32x4*)(p.mvb + (size_t)(r0 + srow) * 512 + h * 128 + ch * 8);
#pragma unroll
            for (int e = 0; e < 4; ++e) { f[2 * e] = __uint_as_float(raw[e] << 16); f[2 * e + 1] = __uint_as_float(raw[e] & 0xffff0000u); } }
        else {
#pragma unroll
            for (int e = 0; e < 8; ++e) f[e] = 0.f; }
        put_t(lds + L_VT, srow, ch * 8, f, 1.0f); }
}
struct PreA { u32x4 k[2], v[2]; float bs, ig, mp; };
DEV void load_a(const P& p, int u, int tid, PreA& r) {
    const int ch = u >> 2, h = u & 3; int path, b, c, r0, cl; chunk_info(ch, path, b, c, r0, cl);
    const act_t* kb = p.qkb + (size_t)r0 * 1024 + 512 + h * 128; const act_t* vb = p.mvb + (size_t)r0 * 512 + h * 128;
#pragma unroll
    for (int i = 0; i < 2; ++i) { const unsigned it = tid + 512 * i, srow = it >> 4, chk = it & 15; r.k[i] = (u32x4){0u, 0u, 0u, 0u}; r.v[i] = (u32x4){0u, 0u, 0u, 0u};
        if ((int)srow < cl) { r.k[i] = *(const u32x4*)(kb + (srow * 1024u + chk * 8u)); r.v[i] = *(const u32x4*)(vb + (srow * 512u + chk * 8u)); } }
    const int lane = tid & 63; const bool act = tid < 64 && lane < cl; const unsigned lr = act ? lane : 0;
    r.bs = act ? (p.gb + (size_t)r0 * 4 + h)[lr * 4u] : 0.f; r.ig = act ? (p.mif + (size_t)r0 * 8 + h)[lr * 8u] : 0.f; r.mp = p.mprev[(size_t)ch * 4 + h];
}
DEV void unpack8(const u32x4 raw, float* f) {
#pragma unroll
    for (int e = 0; e < 4; ++e) { f[2 * e] = __uint_as_float(raw[e] << 16); f[2 * e + 1] = __uint_as_float(raw[e] & 0xffff0000u); }
}
DEV void phase_a(const P& p, PG8_LAS unsigned char* lds) {
    const int tid = fresh_tid(), lane = tid & 63, l32 = lane & 31, hh = lane >> 5, wid = __builtin_amdgcn_readfirstlane(tid >> 6);
    PG8_LAS float* G = gf(lds);
    int u = blockIdx.x; if (u >= NCHUNK * 4) return;
    PreA r; load_a(p, u, tid, r);
    for (; u < NCHUNK * 4; u += gridDim.x) {
        const int ch = u >> 2, h = u & 3; int path, b, c, r0, cl; chunk_info(ch, path, b, c, r0, cl);
        __syncthreads();
        if (wid == 0) {
            const bool act = lane < cl;
            float pm = act ? r.ig - r.bs : -INFINITY;
#pragma unroll
            for (int o = 32; o; o >>= 1) pm = fmaxf(pm, __shfl_xor(pm, o));
            const float bend = __shfl(r.bs, cl - 1), mnew = bend + fmaxf(r.mp, pm);
            G[G_WK + lane] = act ? expf(bend - r.bs + r.ig - mnew) : 0.f;
        }
        __syncthreads();
#pragma unroll
        for (int i = 0; i < 2; ++i) { const int it = tid + 512 * i, srow = it >> 4, chk = it & 15; float f[8];
            unpack8(r.k[i], f); put_t(lds + L_KWT, srow, chk * 8, f, G[G_WK + srow]);
            unpack8(r.v[i], f); put_t(lds + L_VT, srow, chk * 8, f, 1.0f); }
        __syncthreads();
        if (u + (int)gridDim.x < NCHUNK * 4) load_a(p, u + gridDim.x, tid, r);
        const int dt = wid & 3;
        f32x16 acc[2];
#pragma unroll
        for (int j = 0; j < 2; ++j)
#pragma unroll
            for (int q = 0; q < 16; ++q) acc[j][q] = 0.f;
#pragma unroll
        for (int ks = 0; ks < 4; ++ks) { const bf16x8 af = frag128(lds + L_KWT, dt * 32 + l32, 2 * ks + hh);
#pragma unroll
            for (int j = 0; j < 2; ++j) acc[j] = MFMA32(af, frag128(lds + L_VT, ((wid >> 2) * 2 + j) * 32 + l32, 2 * ks + hh), acc[j]); }
        act_t* out = p.dct + ((size_t)ch * 4 + h) * 16384;
#pragma unroll
        for (int j = 0; j < 2; ++j) { const int vp = ((wid >> 2) * 2 + j) * 32 + l32;
#pragma unroll
            for (int q = 0; q < 4; ++q) { u32x2 o; o[0] = pk2(acc[j][4 * q], acc[j][4 * q + 1]); o[1] = pk2(acc[j][4 * q + 2], acc[j][4 * q + 3]); *(u32x2*)(out + (size_t)vp * 128 + dt * 32 + 8 * q + 4 * hh) = o; } }
        if (tid < 128) { float sn = 0.f;
#pragma unroll
            for (int cq = 0; cq < 8; ++cq) { const bf16x8 v = frag128(lds + L_KWT, tid, cq);
#pragma unroll
                for (int e = 0; e < 8; ++e) sn += bf2f((unsigned short)v[e]); }
            p.dn[((size_t)ch * 4 + h) * 128 + tid] = sn; }
    }
}
struct PreB { u32x4 q[2], k[2], v[2], ct[4]; float bs, ig, mp, np; };
DEV void load_b(const P& p, int u, int tid, PreB& r) {
    const int ch = u >> 2, h = u & 3; int path, b, c, r0, cl; chunk_info(ch, path, b, c, r0, cl);
    const act_t* qb_ = p.qkb + (size_t)r0 * 1024 + h * 128; const act_t* vb = p.mvb + (size_t)r0 * 512 + h * 128; const act_t* cb = p.cpt + ((size_t)ch * 4 + h) * 16384;
#pragma unroll
    for (int i = 0; i < 2; ++i) { const unsigned it = tid + 512 * i, srow = it >> 4, chk = it & 15; r.q[i] = (u32x4){0u, 0u, 0u, 0u}; r.k[i] = r.q[i]; r.v[i] = r.q[i];
        if ((int)srow < cl) { r.q[i] = *(const u32x4*)(qb_ + (srow * 1024u + chk * 8u)); r.k[i] = *(const u32x4*)(qb_ + (srow * 1024u + chk * 8u + 512u)); r.v[i] = *(const u32x4*)(vb + (srow * 512u + chk * 8u)); } }
#pragma unroll
    for (int i = 0; i < 4; ++i) { const unsigned it = tid + 512 * i; r.ct[i] = *(const u32x4*)(cb + it * 8u); }
    const int lane = tid & 63; const bool act = tid < 64 && lane < cl; const unsigned lr = act ? lane : 0;
    r.bs = act ? (p.gb + (size_t)r0 * 4 + h)[lr * 4u] : 0.f; r.ig = act ? (p.mif + (size_t)r0 * 8 + h)[lr * 8u] : 0.f; r.mp = p.mprev[(size_t)ch * 4 + h];
    r.np = (tid >= 64 && tid < 192) ? (p.nprev + ((size_t)ch * 4 + h) * 128)[(unsigned)(tid - 64)] : 0.f;
}
DEV void phase_b(const P& p, PG8_LAS unsigned char* lds) {
    const int tid = fresh_tid(), lane = tid & 63, l32 = lane & 31, hh = lane >> 5, wid = __builtin_amdgcn_readfirstlane(tid >> 6);
    PG8_LAS float* G = gf(lds);
    int u = blockIdx.x; if (u >= NCHUNK * 4) return;
    PreB r; load_b(p, u, tid, r);
    const int vt = wid & 3, tt = wid >> 2, tl = tt * 32 + l32;
    for (; u < NCHUNK * 4; u += gridDim.x) {
        const int ch = u >> 2, h = u & 3; int path, b, c, r0, cl; chunk_info(ch, path, b, c, r0, cl);
        int tlo = tl, l32o = l32; asm volatile("" : "+v"(tlo), "+v"(l32o));
        const bool live = tl < cl;
        const int head_col = h * 128 + vt * 32 + 4 * hh;
        u32x2 mor[4];
#pragma unroll
        for (int q = 0; q < 4; ++q) mor[q] = *(const u32x2*)((p.mob + (size_t)r0 * 512) + ((unsigned)(live ? tl : 0) * 512u + head_col + 8 * q));
        __syncthreads();
        if (wid == 0) {
            const bool act = lane < cl;
            float pm = act ? r.ig - r.bs : -INFINITY;
#pragma unroll
            for (int o = 1; o < 64; o <<= 1) { const float t = __shfl_up(pm, o); if (lane >= o) pm = fmaxf(pm, t); }
            const float mt = r.bs + fmaxf(r.mp, pm);
            G[G_IBL + lane] = act ? (r.ig - r.bs) * LOG2E : -INFINITY; G[G_BML + lane] = (r.bs - mt) * LOG2E; G[G_INT + lane] = act ? expf(r.bs + r.mp - mt) : 0.f; G[G_EMT + lane] = expf(-mt);
        }
        if (tid >= 64 && tid < 192) G[G_NP + tid - 64] = r.np;
#pragma unroll
        for (int i = 0; i < 2; ++i) { const int it = tid + 512 * i, srow = it >> 4, chk = it & 15; float f[8];
            *(PG8_LAS u32x4*)(lds + L_Q + srow * 256 + ((chk ^ (srow & 15)) << 4)) = r.q[i]; *(PG8_LAS u32x4*)(lds + L_K + srow * 256 + ((chk ^ (srow & 15)) << 4)) = r.k[i];
            unpack8(r.v[i], f); put_t(lds + L_VT, srow, chk * 8, f, 1.0f); }
#pragma unroll
        for (int i = 0; i < 4; ++i) { const int it = tid + 512 * i, vrow = it >> 4, chk = it & 15; *(PG8_LAS u32x4*)(lds + L_CT + vrow * 256 + ((chk ^ (vrow & 15)) << 4)) = r.ct[i]; }
        __syncthreads();
        if (u + (int)gridDim.x < NCHUNK * 4) load_b(p, u + gridDim.x, tid, r);
        f32x16 o1;
        const float inter = G[G_INT + tlo];
        {
            f32x16 o2;
#pragma unroll
            for (int q = 0; q < 16; ++q) o2[q] = 0.f;
#pragma unroll
            for (int ks = 0; ks < 8; ++ks) o2 = MFMA32(frag256(lds + L_CT, vt * 32 + l32o, 2 * ks + hh), frag256(lds + L_Q, tlo, 2 * ks + hh), o2);
#pragma unroll
            for (int q = 0; q < 16; ++q) o1[q] = inter * o2[q];
        }
        const float bml = G[G_BML + tl]; float den = 0.f;
#pragma unroll 1
        for (int st = 0; st < 2; ++st) {
            f32x16 sc;
#pragma unroll
            for (int q = 0; q < 16; ++q) sc[q] = 0.f;
#pragma unroll
            for (int ks = 0; ks < 8; ++ks) sc = MFMA32(frag256(lds + L_K, st * 32 + l32o, 2 * ks + hh), frag256(lds + L_Q, tlo, 2 * ks + hh), sc);
#pragma unroll
            for (int q = 0; q < 16; ++q) { const int sidx = st * 32 + (q & 3) + 8 * (q >> 2) + 4 * hh;
                const float w = __builtin_amdgcn_exp2f(bml + G[G_IBL + sidx] + (sidx <= tlo ? 0.f : -INFINITY));
                sc[q] *= w; den += sc[q]; }
#pragma unroll
            for (int sp = 0; sp < 2; ++sp) o1 = MFMA32(frag128(lds + L_VT, vt * 32 + l32o, st * 4 + 2 * sp + hh), pack8(sc, sp), o1);
        }
        float qn = 0.f;
#pragma unroll 2
        for (int cq = 0; cq < 8; ++cq) { const bf16x8 qv = frag256(lds + L_Q, tlo, hh * 8 + cq);
#pragma unroll
            for (int e = 0; e < 8; ++e) qn += bf2f((unsigned short)qv[e]) * G[G_NP + hh * 64 + cq * 8 + e]; }
        den += __shfl_xor(den, 32); qn += __shfl_xor(qn, 32);
        den += inter * qn;
        const float inv = 1.0f / fmaxf(fabsf(den), G[G_EMT + tl]);
        float ss = 0.f;
#pragma unroll
        for (int q = 0; q < 4; ++q) {
            const float mo[4] = {__uint_as_float(mor[q][0] << 16), __uint_as_float(mor[q][0] & 0xffff0000u), __uint_as_float(mor[q][1] << 16), __uint_as_float(mor[q][1] & 0xffff0000u)};
#pragma unroll
            for (int e = 0; e < 4; ++e) { const float hv = o1[4 * q + e] * inv * fsigmoid_(mo[e]); o1[4 * q + e] = hv; ss += hv * hv; } }
        ss += __shfl_xor(ss, 32);
        if (hh == 0) G[G_SSQ + (tt * 4 + vt) * 32 + l32] = ss;
        __syncthreads();
        const float tot = G[G_SSQ + (tt * 4 + 0) * 32 + l32] + G[G_SSQ + (tt * 4 + 1) * 32 + l32] + G[G_SSQ + (tt * 4 + 2) * 32 + l32] + G[G_SSQ + (tt * 4 + 3) * 32 + l32];
        const float rr = 1.0f / sqrtf(tot / 128 + 1e-6f);
        if (live) {
#pragma unroll
            for (int q = 0; q < 4; ++q) { const f32x4 g = *(const f32x4*)(p.g_mnorm + head_col + 8 * q);
                u32x2 o; o[0] = pk2(o1[4 * q] * rr * g[0], o1[4 * q + 1] * rr * g[1]); o[1] = pk2(o1[4 * q + 2] * rr * g[2], o1[4 * q + 3] * rr * g[3]);
                *(u32x2*)((p.mixb + (size_t)r0 * 1024 + 512) + ((unsigned)tl * 1024u + head_col + 8 * q)) = o; }
        }
    }
}
}

namespace coop {
typedef float f32x4 __attribute__((ext_vector_type(4)));
typedef unsigned u32x2 __attribute__((ext_vector_type(2)));
typedef unsigned u32x4 __attribute__((ext_vector_type(4)));
DEV float wave_sum(float v) {
#pragma unroll
    for (int o = 32; o; o >>= 1) v += __shfl_xor(v, o);
    return v;
}
DEV unsigned pk2(float lo, float hi) { return pkbf(lo, hi); }
DEV f32x4 ldb4(const act_t* q) { const u32x2 r = *(const u32x2*)q; return (f32x4){__uint_as_float(r[0] << 16), __uint_as_float(r[0] & 0xffff0000u), __uint_as_float(r[1] << 16), __uint_as_float(r[1] & 0xffff0000u)}; }
DEV f32x4 cvb4(u32x2 r) { return (f32x4){__uint_as_float(r[0] << 16), __uint_as_float(r[0] & 0xffff0000u), __uint_as_float(r[1] << 16), __uint_as_float(r[1] & 0xffff0000u)}; }
static_assert(D == 1024, "wave-per-row helpers assume d_model 1024 (16 floats per lane)");
DEV void rmsnorm_in(const P& p, int gw, int nw, int lane) {
    f32x4 gv[4];
#pragma unroll
    for (int i = 0; i < 4; ++i) gv[i] = *(const f32x4*)(p.g_attn_pre + i * 256 + lane * 4);
    int row = gw; if (row >= TOK) return;
    f32x4 v[4], nv[4];
#pragma unroll
    for (int i = 0; i < 4; ++i) v[i] = *(const f32x4*)(xrow(p, row) + i * 256 + lane * 4);
    for (; row < TOK; row += nw) {
        const int nr = row + nw < TOK ? row + nw : row;
#pragma unroll
        for (int i = 0; i < 4; ++i) nv[i] = *(const f32x4*)(xrow(p, nr) + i * 256 + lane * 4);
        float ss = 0.f;
#pragma unroll
        for (int i = 0; i < 4; ++i) ss += v[i][0] * v[i][0] + v[i][1] * v[i][1] + v[i][2] * v[i][2] + v[i][3] * v[i][3];
        const float r = 1.0f / sqrtf(wave_sum(ss) / D + 1e-6f);
#pragma unroll
        for (int i = 0; i < 4; ++i) { const f32x4 g = gv[i];
            u32x2 o; o[0] = pk2(v[i][0] * r * g[0], v[i][1] * r * g[1]); o[1] = pk2(v[i][2] * r * g[2], v[i][3] * r * g[3]); *(u32x2*)(p.hb + (size_t)row * D + i * 256 + lane * 4) = o; }
#pragma unroll
        for (int i = 0; i < 4; ++i) v[i] = nv[i];
    }
}
DEV void post1(const P& p, int lo, int hi, int gw, int nw, int lane) {
    int row = lo + gw; if (row >= hi) return;
    f32x4 v[4], xv[4], nv[4], nx[4], ga[4], gf[4];
#pragma unroll
    for (int i = 0; i < 4; ++i) { ga[i] = *(const f32x4*)(p.g_attn_post + i * 256 + lane * 4); gf[i] = *(const f32x4*)(p.g_ffn_pre + i * 256 + lane * 4); }
#pragma unroll
    for (int i = 0; i < 4; ++i) { v[i] = ldb4(p.mixh + (size_t)row * D + i * 256 + lane * 4); xv[i] = *(const f32x4*)(xrow(p, row) + i * 256 + lane * 4); }
    for (; row < hi; row += nw) {
        const int nr = row + nw < hi ? row + nw : row;
#pragma unroll
        for (int i = 0; i < 4; ++i) { nv[i] = ldb4(p.mixh + (size_t)nr * D + i * 256 + lane * 4); nx[i] = *(const f32x4*)(xrow(p, nr) + i * 256 + lane * 4); }
        float ss = 0.f;
#pragma unroll
        for (int i = 0; i < 4; ++i) ss += v[i][0] * v[i][0] + v[i][1] * v[i][1] + v[i][2] * v[i][2] + v[i][3] * v[i][3];
        const float r1 = 1.0f / sqrtf(wave_sum(ss) / D + 1e-6f); float s2 = 0.f;
#pragma unroll
        for (int i = 0; i < 4; ++i) { const f32x4 g = ga[i];
            v[i] = xv[i] + v[i] * r1 * g; *(f32x4*)(p.x1 + (size_t)row * D + i * 256 + lane * 4) = v[i]; s2 += v[i][0] * v[i][0] + v[i][1] * v[i][1] + v[i][2] * v[i][2] + v[i][3] * v[i][3]; }
        const float r2 = 1.0f / sqrtf(wave_sum(s2) / D + 1e-6f);
#pragma unroll
        for (int i = 0; i < 4; ++i) { const f32x4 g = gf[i];
            u32x2 o; o[0] = pk2(v[i][0] * r2 * g[0], v[i][1] * r2 * g[1]); o[1] = pk2(v[i][2] * r2 * g[2], v[i][3] * r2 * g[3]); *(u32x2*)(p.h2b + (size_t)row * D + i * 256 + lane * 4) = o; }
#pragma unroll
        for (int i = 0; i < 4; ++i) { v[i] = nv[i]; xv[i] = nx[i]; }
    }
}
template <bool TWO>
DEV void post2(const P& p, int lo, int hi, int gw, int nw, int lane) {
    int row = lo + gw; if (row >= hi) return;
    f32x4 v[4], xv[4], nv[4], nx[4], gp[4];
#pragma unroll
    for (int i = 0; i < 4; ++i) gp[i] = *(const f32x4*)(p.g_ffn_post + i * 256 + lane * 4);
#pragma unroll
    for (int i = 0; i < 4; ++i) { v[i] = ldb4(p.fh + (size_t)row * D + i * 256 + lane * 4); if (TWO) v[i] += ldb4(p.fh2 + (size_t)(row - TOKP) * D + i * 256 + lane * 4); xv[i] = *(const f32x4*)(p.x1 + (size_t)row * D + i * 256 + lane * 4); }
    for (; row < hi; row += nw) {
        const int nr = row + nw < hi ? row + nw : row;
#pragma unroll
        for (int i = 0; i < 4; ++i) { nv[i] = ldb4(p.fh + (size_t)nr * D + i * 256 + lane * 4); if (TWO) nv[i] += ldb4(p.fh2 + (size_t)(nr - TOKP) * D + i * 256 + lane * 4); nx[i] = *(const f32x4*)(p.x1 + (size_t)nr * D + i * 256 + lane * 4); }
        float ss = 0.f;
#pragma unroll
        for (int i = 0; i < 4; ++i) ss += v[i][0] * v[i][0] + v[i][1] * v[i][1] + v[i][2] * v[i][2] + v[i][3] * v[i][3];
        const float r1 = 1.0f / sqrtf(wave_sum(ss) / D + 1e-6f);
        float* y = row < TOKP ? p.o_yp + (size_t)row * D : p.o_ys + (size_t)(row - TOKP) * D;
#pragma unroll
        for (int i = 0; i < 4; ++i) { const f32x4 g = gp[i]; *(f32x4*)(y + i * 256 + lane * 4) = xv[i] + v[i] * r1 * g; }
#pragma unroll
        for (int i = 0; i < 4; ++i) { v[i] = nv[i]; xv[i] = nx[i]; }
    }
}
DEV void hnorm(const P& p, int gw, int nw, int lane) {
    for (int row = gw; row < TOK; row += nw) {
        const float* x = p.hm_pre + (size_t)row * 512 + lane * 8; const f32x4 a = *(const f32x4*)x, b = *(const f32x4*)(x + 4);
        float ss = a[0] * a[0] + a[1] * a[1] + a[2] * a[2] + a[3] * a[3] + b[0] * b[0] + b[1] * b[1] + b[2] * b[2] + b[3] * b[3];
#pragma unroll
        for (int o = 8; o; o >>= 1) ss += __shfl_xor(ss, o);
        const float rr = 1.0f / sqrtf(ss / 128 + 1e-6f);
        const f32x4 g0 = *(const f32x4*)(p.g_mnorm + lane * 8), g1 = *(const f32x4*)(p.g_mnorm + lane * 8 + 4);
        u32x4 o; o[0] = pk2(a[0] * rr * g0[0], a[1] * rr * g0[1]); o[1] = pk2(a[2] * rr * g0[2], a[3] * rr * g0[3]); o[2] = pk2(b[0] * rr * g1[0], b[1] * rr * g1[1]); o[3] = pk2(b[2] * rr * g1[2], b[3] * rr * g1[3]);
        *(u32x4*)(p.mixb + (size_t)row * 1024 + 512 + lane * 8) = o;
    }
}
constexpr int WT_BYTES = 64 * 65 * 4;
template <bool PERM, int MAP = 0>
DEV void transpose_tile_w(PG8_LAS float* tl, const float* src, size_t lds_, int nr, int nc, act_t* dst, size_t ldd, int lane, int nbase = 0) {
#pragma unroll
    for (int i = 0; i < 16; ++i) { const int r = (lane >> 4) + 4 * i, c = (lane & 15) * 4;
        f32x4 v = {0.f, 0.f, 0.f, 0.f};
        if (r < nr && c < nc) v = *(const f32x4*)(src + (size_t)r * lds_ + c);
        tl[r * 65 + c] = v[0]; tl[r * 65 + c + 1] = v[1]; tl[r * 65 + c + 2] = v[2]; tl[r * 65 + c + 3] = v[3]; }
    __builtin_amdgcn_wave_barrier();
#pragma unroll
    for (int i = 0; i < 8; ++i) { const int c = (lane >> 3) + 8 * i, rb = (lane & 7) * 8;
        if (c < nc && rb < nr) {
            float v[8];
#pragma unroll
            for (int e = 0; e < 8; ++e) { const int pos = rb + e, r = PERM ? ((pos & ~15) | (pos & 3) | ((pos & 4) << 1) | ((pos & 8) >> 1)) : pos; v[e] = tl[r * 65 + c]; }
            u32x4 o; o[0] = pk2(v[0], v[1]); o[1] = pk2(v[2], v[3]); o[2] = pk2(v[4], v[5]); o[3] = pk2(v[6], v[7]);
            const int cd = MAP == 0 ? c : MAP == 3 ? pg8::remap_in(nbase + c) : (c + (MAP == 2 ? 128 : 0));
            *(u32x4*)(dst + (size_t)cd * ldd + rb) = o;
        } }
    __builtin_amdgcn_wave_barrier();
}
template <int MAP = 0>
DEV void weight_t(PG8_LAS float* lds0, const float* w, int K, int N, act_t* bt, int row0, int tid) {
    const int tk = K / 64, tn = (N + 63) / 64, wv = tid >> 6, lane = tid & 63; PG8_LAS float* tl = lds0 + wv * (WT_BYTES / 4);
    for (int t = (int)blockIdx.x * (NTHR_ / 64) + wv; t < tk * tn; t += (int)gridDim.x * (NTHR_ / 64)) { const int k0 = (t / tn) * 64, n0 = (t % tn) * 64;
        transpose_tile_w<false, MAP>(tl, w + (size_t)k0 * N + n0, N, 64, N - n0 < 64 ? N - n0 : 64, bt + (size_t)(row0 + (MAP == 3 ? 0 : MAP ? 256 * (n0 / 128) + (n0 % 128) : n0)) * K + k0, K, lane, n0); }
}
DEV void prep_prompt(const P& p, PG8_LAS float* lds0, int tid) {
    constexpr int NT = SEQ / 64; const int wv = tid >> 6, lane = tid & 63; PG8_LAS float* tl = lds0 + wv * (WT_BYTES / 4);
    for (int u = (int)blockIdx.x * (NTHR_ / 64) + wv; u < BATCH * 2 * NT * 2; u += (int)gridDim.x * (NTHR_ / 64)) {
        const int which = u & 1, tt = (u >> 1) % NT, bh = (u >> 1) / NT, b = bh >> 1, kvh = bh & 1;
        const float* src = which ? p.kvwf + (size_t)(b * SEQ + tt * 64) * 256 + 128 + kvh * 64 : p.o_kvp + (size_t)(b * SEQ + tt * 64) * 512 + 3 * 128 + kvh * 64;
        act_t* dst = (which ? p.vwt : p.vst) + (size_t)bh * 64 * SEQ + tt * 64;
        transpose_tile_w<true>(tl, src, which ? 256 : 512, 64, 64, dst, SEQ, lane);
    }
}
DEV void conv_rows(const P& p, int gw, int nw, int lane) {
    const int c0 = lane * 16;
    f32x4 wv[4][4], bv[4];
#pragma unroll
    for (int q = 0; q < 4; ++q) { bv[q] = *(const f32x4*)(p.conv_b + c0 + 4 * q);
#pragma unroll
        for (int j = 0; j < 4; ++j) wv[j][q] = *(const f32x4*)(p.conv_w + j * 1024 + c0 + 4 * q); }
    int row = gw; if (row >= TOK) return;
    u32x4 ta[4], tb[4], na[4], nb[4];
    auto ldt = [&](int rw, u32x4 (&A)[4], u32x4 (&B)[4]) {
        const int t = row_info(rw).t;
#pragma unroll
        for (int j = 0; j < 4; ++j) {
            if (t - 3 + j >= 0) { A[j] = *(const u32x4*)(p.mqkb + (size_t)(rw - 3 + j) * 1024 + c0); B[j] = *(const u32x4*)(p.mqkb + (size_t)(rw - 3 + j) * 1024 + c0 + 8); }
            else { A[j] = (u32x4){0u, 0u, 0u, 0u}; B[j] = (u32x4){0u, 0u, 0u, 0u}; } }
    };
    ldt(row, ta, tb);
    for (; row < TOK; row += nw) {
        const int nr = row + nw < TOK ? row + nw : row;
        ldt(nr, na, nb);
        const Row r = row_info(row);
        float acc[16];
#pragma unroll
        for (int q = 0; q < 4; ++q) { acc[4 * q] = bv[q][0]; acc[4 * q + 1] = bv[q][1]; acc[4 * q + 2] = bv[q][2]; acc[4 * q + 3] = bv[q][3]; }
#pragma unroll
        for (int j = 0; j < 4; ++j) { const int tt = r.t - 3 + j; float v[16];
#pragma unroll
            for (int e = 0; e < 4; ++e) { v[2 * e] = __uint_as_float(ta[j][e] << 16); v[2 * e + 1] = __uint_as_float(ta[j][e] & 0xffff0000u); v[8 + 2 * e] = __uint_as_float(tb[j][e] << 16); v[8 + 2 * e + 1] = __uint_as_float(tb[j][e] & 0xffff0000u); }
            if (tt < 0 && r.path) { const float* src = p.state_conv + ((size_t)r.b * 3 + (r.t + j)) * 1024 + c0;
#pragma unroll
                for (int q = 0; q < 4; ++q) { const f32x4 t = *(const f32x4*)(src + 4 * q); v[4 * q] = t[0]; v[4 * q + 1] = t[1]; v[4 * q + 2] = t[2]; v[4 * q + 3] = t[3]; } }
#pragma unroll
            for (int q = 0; q < 4; ++q) {
#pragma unroll
                for (int e = 0; e < 4; ++e) acc[4 * q + e] += v[4 * q + e] * wv[j][q][e]; } }
        const float sc = c0 >= 512 ? 0.08838834764831845f : 1.0f;
        u32x4 o[2];
#pragma unroll
        for (int q = 0; q < 4; ++q) { float v[4];
#pragma unroll
            for (int e = 0; e < 4; ++e) v[e] = acc[4 * q + e] * fsigmoid_(acc[4 * q + e]) * sc;
            o[q >> 1][(q & 1) * 2] = pk2(v[0], v[1]); o[q >> 1][(q & 1) * 2 + 1] = pk2(v[2], v[3]); }
        *(u32x4*)(p.qkb + (size_t)row * 1024 + c0) = o[0]; *(u32x4*)(p.qkb + (size_t)row * 1024 + c0 + 8) = o[1];
#pragma unroll
        for (int j = 0; j < 4; ++j) { ta[j] = na[j]; tb[j] = nb[j]; }
    }
}
DEV void out_kv_rows(const P& p, int gw, int nw, int lane) {
    for (int row = gw; row < TOK; row += nw) {
        const float* src = p.proj + (size_t)row * PROJ + C_KVP + lane * 8; float* dst = (row < TOKP ? p.o_kvp + (size_t)row * 512 : p.o_kvs + (size_t)(row - TOKP) * 512) + lane * 8;
        const f32x4 a = *(const f32x4*)src, b = *(const f32x4*)(src + 4); *(f32x4*)dst = a; *(f32x4*)(dst + 4) = b;
    }
}
DEV void cmpA_rows_s(const P& p, int gw, int nw, int lane) {
    const int j = lane >> 2, qd = lane & 3;
    for (int r = gw; r < 2 * CROWS_S; r += nw) {
        const int cidx = r % NCH_S, bh = (r / NCH_S) % (DB * 2), tensor = r / CROWS_S, b = bh >> 1, h = bh & 1, T = 16 * cidx + j;
        const float* src = p.cache_kv + ((((size_t)p.page_table[b * NPAGES + T / PAGE] * PAGE + T % PAGE) * 4 + tensor) * 128) + h * 64 + qd * 16;
        f32x4 v[4];
#pragma unroll
        for (int q = 0; q < 4; ++q) v[q] = *(const f32x4*)(src + 4 * q);
        u32x4 o0, o1; o0[0] = pk2(v[0][0], v[0][1]); o0[1] = pk2(v[0][2], v[0][3]); o0[2] = pk2(v[1][0], v[1][1]); o0[3] = pk2(v[1][2], v[1][3]);
        o1[0] = pk2(v[2][0], v[2][1]); o1[1] = pk2(v[2][2], v[2][3]); o1[2] = pk2(v[3][0], v[3][1]); o1[3] = pk2(v[3][2], v[3][3]);
        act_t* dst = p.cas + (size_t)r * 1024 + j * 64 + qd * 16; *(u32x4*)dst = o0; *(u32x4*)(dst + 8) = o1;
    }
}

DEV void cmp_const_w(const P& p, int gw, int nw, int lane) {
    for (int u = gw; u < 256; u += nw) {
        const int e = u % 128, tensor = u / 128; float acc = 0.f;
#pragma unroll 8
        for (int k = lane; k < 2048; k += 64) acc += p.cmp_pos[tensor * 2048 + k] * p.cmp_w1[((size_t)tensor * 2048 + k) * 128 + e];
        acc = wave_sum(acc);
        if (lane == 0) p.cmpc[u] = acc + p.cmp_b1[tensor * 128 + e];
    }
}
DEV void gates1(const P& p, int gw, int nw, int lane) {
    for (int ch = gw; ch < NCHUNK; ch += nw) {
        int path, b, c, r0, cl; chunk_info(ch, path, b, c, r0, cl);
        const bool act = lane < cl; const size_t row = r0 + (act ? lane : 0);
        const f32x4 iv4 = *(const f32x4*)(p.mif + row * 8), fv4 = *(const f32x4*)(p.mif + row * 8 + 4);
        float bs[4], ig[4];
#pragma unroll
        for (int h = 0; h < 4; ++h) { ig[h] = act ? iv4[h] : 0.f; bs[h] = act ? logsigmoidf_(fv4[h]) : 0.f; }
#pragma unroll
        for (int o = 1; o < 64; o <<= 1) {
#pragma unroll
            for (int h = 0; h < 4; ++h) { const float t = __shfl_up(bs[h], o); if (lane >= o) bs[h] += t; } }
        float bend[4], iv[4];
#pragma unroll
        for (int h = 0; h < 4; ++h) { bend[h] = __shfl(bs[h], cl - 1); iv[h] = act ? ig[h] + bend[h] - bs[h] : -INFINITY; }
#pragma unroll
        for (int o = 32; o; o >>= 1) {
#pragma unroll
            for (int h = 0; h < 4; ++h) iv[h] = fmaxf(iv[h], __shfl_xor(iv[h], o)); }
        if (act) *(f32x4*)(p.gb + row * 4) = (f32x4){bs[0], bs[1], bs[2], bs[3]};
        if (lane < 4) { const float be = lane == 0 ? bend[0] : lane == 1 ? bend[1] : lane == 2 ? bend[2] : bend[3], im = lane == 0 ? iv[0] : lane == 1 ? iv[1] : lane == 2 ? iv[2] : iv[3];
            p.cmap[((size_t)ch * 4 + lane) * 2] = be; p.cmap[((size_t)ch * 4 + lane) * 2 + 1] = im; }
    }
}
DEV void gates2(const P& p, int gw, int nw, int lane) {
    for (int u = gw; u < NSEQ * 4; u += nw) {
        const int h = u & 3, sq = u >> 2, path = sq < BATCH ? 0 : 1, b = path ? sq - BATCH : sq, nck = path ? 1 : NCKP, ch0 = path ? BATCH * NCKP + b : b * NCKP;
        const float m0 = path ? p.state_m[b * 4 + h] : 0.f;
        const int c0 = 2 * lane, c1 = 2 * lane + 1;
        float L0 = 0.f, I0 = -INFINITY, L1 = 0.f, I1 = -INFINITY;
        if (c0 < nck) { L0 = p.cmap[((size_t)(ch0 + c0) * 4 + h) * 2]; I0 = p.cmap[((size_t)(ch0 + c0) * 4 + h) * 2 + 1]; }
        if (c1 < nck) { L1 = p.cmap[((size_t)(ch0 + c1) * 4 + h) * 2]; I1 = p.cmap[((size_t)(ch0 + c1) * 4 + h) * 2 + 1]; }
        float L = L0 + L1, I = fmaxf(I0 + L1, I1);
#pragma unroll
        for (int o = 1; o < 64; o <<= 1) { const float pl = __shfl_up(L, o), pi = __shfl_up(I, o); if (lane >= o) { I = fmaxf(pi + L, I); L = pl + L; } }
        float eL = __shfl_up(L, 1), eI = __shfl_up(I, 1); if (lane == 0) { eL = 0.f; eI = -INFINITY; }
        const float mb0 = fmaxf(m0 + eL, eI), mb1 = fmaxf(mb0 + L0, I0);
        if (c0 < nck) p.mprev[(size_t)(ch0 + c0) * 4 + h] = mb0;
        if (c1 < nck) p.mprev[(size_t)(ch0 + c1) * 4 + h] = mb1;
        const float mfin = __shfl(fmaxf(m0 + L, I), 63);
        if (lane == 0) { if (path) p.o_ms[b * 4 + h] = mfin; else p.o_mp[b * 4 + h] = mfin; }
    }
}
DEV void gates3(const P& p, int gw, int nw, int lane) {
    for (int u = gw; u < NCHUNK * 4; u += nw) {
        const int h = u & 3, ch = u >> 2; int path, b, c, r0, cl; chunk_info(ch, path, b, c, r0, cl);
        const bool act = lane < cl; const size_t row = r0 + (act ? lane : 0);
        const float bs = act ? p.gb[row * 4 + h] : 0.f; float pm = act ? p.proj[row * PROJ + C_MIF + h] - bs : -INFINITY;
#pragma unroll
        for (int o = 1; o < 64; o <<= 1) { const float t = __shfl_up(pm, o); if (lane >= o) pm = fmaxf(pm, t); }
        if (act) p.gm[row * 4 + h] = bs + fmaxf(p.mprev[(size_t)ch * 4 + h], pm);
    }
}

DEV void cmp_combine(const P& p, int path, int gw, int nw, int lane) {
    typedef short bf16x8 __attribute__((ext_vector_type(8))); typedef float f32x16 __attribute__((ext_vector_type(16)));
    const int nch = path ? NCH_S : NCH_P, nb = path ? DB : BATCH; const act_t* C = path ? p.ccs : p.ccp; const size_t crows = path ? CROWS_S : CROWS_P;
    act_t* kc = path ? p.kcs : p.kc; act_t* vct = path ? p.vcts : p.vct;
    const int l32 = lane & 31, hh = lane >> 5, upr = nch / 32;
    for (int u = gw; u < 2 * nb * 2 * upr; u += nw) {
        const int c0 = (u % upr) * 32, bh = (u / upr) % (nb * 2), tensor = u / (upr * nb * 2), c = c0 + l32;
        const bool live = c < nch - 1;
        const act_t* lo = C + ((size_t)tensor * crows + (size_t)bh * nch + (live ? c : 0)) * 256; const act_t* hi = lo + 256 + 128;
        f32x16 o0, o1;
#pragma unroll
        for (int r = 0; r < 16; ++r) { o0[r] = 0.f; o1[r] = 0.f; }
#pragma unroll
        for (int half = 0; half < 2; ++half) {
            u32x2 ar[4][4]; f32x4 cv[4][2]; bf16x8 wf[4][2];
#pragma unroll
            for (int k4 = 0; k4 < 4; ++k4) { const int e0 = 16 * (half * 4 + k4) + 8 * hh;
                ar[k4][0] = *(const u32x2*)(lo + e0); ar[k4][1] = *(const u32x2*)(lo + e0 + 4); ar[k4][2] = *(const u32x2*)(hi + e0); ar[k4][3] = *(const u32x2*)(hi + e0 + 4);
                cv[k4][0] = *(const f32x4*)(p.cmpc + tensor * 128 + e0); cv[k4][1] = *(const f32x4*)(p.cmpc + tensor * 128 + e0 + 4);
                wf[k4][0] = *(const bf16x8*)(p.w2t + ((size_t)tensor * 64 + l32) * 128 + e0); wf[k4][1] = *(const bf16x8*)(p.w2t + ((size_t)tensor * 64 + 32 + l32) * 128 + e0); }
#pragma unroll
            for (int k4 = 0; k4 < 4; ++k4) {
                const f32x4 a0 = cvb4(ar[k4][0]), a1 = cvb4(ar[k4][1]), b0 = cvb4(ar[k4][2]), b1 = cvb4(ar[k4][3]);
                float hv[8];
#pragma unroll
                for (int e = 0; e < 4; ++e) { const float x0 = live ? a0[e] + b0[e] + cv[k4][0][e] : 0.f, x1 = live ? a1[e] + b1[e] + cv[k4][1][e] : 0.f; hv[e] = gelu_tanh(x0); hv[4 + e] = gelu_tanh(x1); }
                u32x4 q; q[0] = pk2(hv[0], hv[1]); q[1] = pk2(hv[2], hv[3]); q[2] = pk2(hv[4], hv[5]); q[3] = pk2(hv[6], hv[7]);
                const bf16x8 af = __builtin_bit_cast(bf16x8, q);
                o0 = __builtin_amdgcn_mfma_f32_32x32x16_bf16(af, wf[k4][0], o0, 0, 0, 0);
                o1 = __builtin_amdgcn_mfma_f32_32x32x16_bf16(af, wf[k4][1], o1, 0, 0, 0);
            }
        }
        const float bb0 = p.cmp_b2[tensor * 64 + l32], bb1 = p.cmp_b2[tensor * 64 + 32 + l32];
#pragma unroll
        for (int q = 0; q < 4; ++q) {
            const int cb = c0 + 8 * q + 4 * hh;
            float v0[4], v1[4];
#pragma unroll
            for (int e = 0; e < 4; ++e) { const bool lv = cb + e < nch - 1; v0[e] = lv ? o0[4 * q + e] + bb0 : 0.f; v1[e] = lv ? o1[4 * q + e] + bb1 : 0.f; }
            if (tensor == 0) {
#pragma unroll
                for (int e = 0; e < 4; ++e) { kc[((size_t)bh * nch + cb + e) * 64 + l32] = to_act(v0[e]); kc[((size_t)bh * nch + cb + e) * 64 + 32 + l32] = to_act(v1[e]); }
            } else {
                const int pos = perm16(cb);
                u32x2 w0; w0[0] = pk2(v0[0], v0[1]); w0[1] = pk2(v0[2], v0[3]); *(u32x2*)(vct + ((size_t)bh * 64 + l32) * nch + pos) = w0;
                u32x2 w1; w1[0] = pk2(v1[0], v1[1]); w1[1] = pk2(v1[2], v1[3]); *(u32x2*)(vct + ((size_t)bh * 64 + 32 + l32) * nch + pos) = w1;
            }
        }
    }
}
DEV void cmp_combine_s(const P& p, int gw, int nw, int lane) { cmp_combine(p, 1, gw, nw, lane); }
DEV void cmp_combine_p(const P& p, int gw, int nw, int lane) { cmp_combine(p, 0, gw, nw, lane); }
}

constexpr int NTHR = 512, LDS_BYTES = 147456, LDS_BAR_OFF = 147440;
DEV void run_gemm_proj(PG8_LAS unsigned char* lds, const P& p) {
    pg8::Gemm g{p.hb, p.bt_in, TOK, PROJP, D}; pg8::StaticOrder S; S.init(TOK, PROJP, (int)gridDim.x, (int)blockIdx.x);
    pg8::EpiProj E{p.b_in, p.qb, p.kvb, p.kwb, p.mqkb, p.mvb, p.mob, p.o_kvp, p.o_kvs, p.kvwf, p.gatef, p.mif, p.o_convp, p.o_convs, 0.125f * LOG2E};
    pg8::gemm_phase<pg8::EpiProj, pg8::StaticOrder>(lds, g, S, E);
}
DEV void run_gemm_b16(PG8_LAS unsigned char* lds, const act_t* A, const act_t* Bt, int M, int N, int K, act_t* O, int ldo, int rot = 0, int ld = 0) {
    pg8::Gemm g{A, Bt, M, N, K, ld}; pg8::StaticOrder S; S.init(M, N, (int)gridDim.x, ((int)blockIdx.x + (int)gridDim.x - rot) % (int)gridDim.x);
    pg8::EpiB16 E{O, ldo};
    pg8::gemm_phase<pg8::EpiB16, pg8::StaticOrder>(lds, g, S, E);
}
DEV void run_gemm_swiglu(PG8_LAS unsigned char* lds, const act_t* A, const act_t* Bt, int M, int N, int K, act_t* O, int ldo) {
    pg8::Gemm g{A, Bt, M, N, K}; pg8::StaticOrder S; S.init(M, N, (int)gridDim.x, (int)blockIdx.x);
    pg8::EpiSwiglu E{O, ldo};
    pg8::gemm_phase<pg8::EpiSwiglu, pg8::StaticOrder>(lds, g, S, E);
}
DEV void run_gemm(PG8_LAS unsigned char* lds, const act_t* A, const act_t* Bt, int M, int N, int K, float* C, int ldc, const float* bias, int ncols, int rot = 0) {
    pg8::Gemm g{A, Bt, M, N, K}; pg8::StaticOrder S; S.init(M, N, (int)gridDim.x, ((int)blockIdx.x + (int)gridDim.x - rot) % (int)gridDim.x);
    pg8::EpiF32 E{C, ldc, bias, ncols};
    pg8::gemm_phase<pg8::EpiF32, pg8::StaticOrder>(lds, g, S, E);
}


namespace cmps {
using att::bf16x8; using att::f32x16; using att::tile_load; using att::tile_store; using att::frag;
typedef float f32x4 __attribute__((ext_vector_type(4)));
typedef unsigned u32x4 __attribute__((ext_vector_type(4)));
typedef unsigned u32x2 __attribute__((ext_vector_type(2)));
constexpr int NUNIT = 2 * CROWS_S / 256, L_Q = 65536;
static_assert(NCH_S % 32 == 0 && CROWS_S % 256 == 0 && 16 * NCH_S <= PAST && PAGE == 128, "sample compression shapes");
DEV void unit(const P& p, PG8_LAS unsigned char* lds, int u) {
    const int tid = fresh_tid(), lane = tid & 63, l32 = lane & 31, h = lane >> 5, wid = __builtin_amdgcn_readfirstlane(tid >> 6), xr = l32 & 7;
    const int tensor = u / (CROWS_S / 256), r = (u % (CROWS_S / 256)) * 256 + wid * 32 + l32;
    const int bh = r / NCH_S, cidx = r % NCH_S, b = bh >> 1, kvh = bh & 1;
    const int page = p.page_table[b * NPAGES + (cidx >> 3)];
    const float* arow = p.cache_kv + (((size_t)page * PAGE + 16 * (cidx & 7)) * 4 + tensor) * 128 + kvh * 64 + h * 32;
    const act_t* wsrc = p.btc + (size_t)tensor * 256 * 1024;
    f32x16 acc[8];
#pragma unroll
    for (int ct = 0; ct < 8; ++ct)
#pragma unroll
        for (int i = 0; i < 16; ++i) acc[ct][i] = 0.f;
    f32x4 xa[8]; u32x4 wreg[4];
#pragma unroll
    for (int q = 0; q < 8; ++q) xa[q] = *(const f32x4*)(arow + 4 * q);
#pragma unroll
    for (int q = 0; q < 4; ++q) wreg[q] = tile_load(wsrc + (size_t)q * 64 * 1024, 1024, tid);
#pragma unroll
    for (int q = 0; q < 4; ++q) tile_store(lds + q * 8192, wreg[q], tid);
    __syncthreads();
    int cur = 0;
#pragma unroll 1
    for (int j = 0; j < 16; ++j) {
        bf16x8 xf[4];
#pragma unroll
        for (int ks = 0; ks < 4; ++ks) { u32x4 t; t[0] = pkbf(xa[2 * ks][0], xa[2 * ks][1]); t[1] = pkbf(xa[2 * ks][2], xa[2 * ks][3]); t[2] = pkbf(xa[2 * ks + 1][0], xa[2 * ks + 1][1]); t[3] = pkbf(xa[2 * ks + 1][2], xa[2 * ks + 1][3]);
            xf[ks] = __builtin_bit_cast(bf16x8, t); }
        const bool more = j < 15;
        if (more) {
#pragma unroll
            for (int q = 0; q < 8; ++q) xa[q] = *(const f32x4*)(arow + (size_t)(j + 1) * 512 + 4 * q);
#pragma unroll
            for (int q = 0; q < 4; ++q) wreg[q] = tile_load(wsrc + (size_t)q * 64 * 1024 + (j + 1) * 64, 1024, tid);
        }
        const PG8_LAS unsigned char* wb = lds + cur * 32768;
#pragma unroll
        for (int ks = 0; ks < 4; ++ks)
#pragma unroll
            for (int ct = 0; ct < 8; ++ct) acc[ct] = MFMA32(frag(wb, ct * 32 + l32, 4 * h + ks, xr), xf[ks], acc[ct]);
        if (more) {
#pragma unroll
            for (int q = 0; q < 4; ++q) tile_store(lds + (cur ^ 1) * 32768 + q * 8192, wreg[q], tid);
        }
        __syncthreads();
        cur ^= 1;
    }
    act_t* orow = p.ccs + ((size_t)tensor * CROWS_S + r) * 256 + 4 * h;
#pragma unroll
    for (int ct = 0; ct < 8; ++ct)
#pragma unroll
        for (int q = 0; q < 4; ++q) { u32x2 w; w[0] = pkbf(acc[ct][4 * q], acc[ct][4 * q + 1]); w[1] = pkbf(acc[ct][4 * q + 2], acc[ct][4 * q + 3]); *(u32x2*)(orow + ct * 32 + 8 * q) = w; }
}
DEV void phase(const P& p, PG8_LAS unsigned char* lds, unsigned* counter) {
    for (;;) {
        if (threadIdx.x == 0) *(PG8_LAS unsigned*)(lds + L_Q) = atomicAdd(counter, 1u);
        __syncthreads();
        const int u = (int)*(const volatile PG8_LAS unsigned*)(lds + L_Q);
        __syncthreads();
        if (u >= NUNIT) break;
        unit(p, lds, u);
    }
}
}


namespace cmpp {
using att::bf16x8; using att::f32x16; using att::tile_load; using att::tile_store; using att::frag;
typedef unsigned u32x4 __attribute__((ext_vector_type(4)));
typedef unsigned u32x2 __attribute__((ext_vector_type(2)));
constexpr int NUNIT = 2 * (CROWS_P / 256) * 4;
static_assert(NCH_P % 32 == 0 && CROWS_P % 256 == 0 && 16 * NCH_P <= SEQ, "prompt compression shapes");
DEV void unit(const P& p, PG8_LAS unsigned char* lds, int u) {
    const int tid = fresh_tid(), lane = tid & 63, l32 = lane & 31, h = lane >> 5, wid = __builtin_amdgcn_readfirstlane(tid >> 6), xr = l32 & 7;
    const int nq = u & 3, rb = (u >> 2) % (CROWS_P / 256), tensor = u / (4 * (CROWS_P / 256)), r = rb * 256 + wid * 32 + l32;
    const int bh = r / NCH_P, cidx = r % NCH_P, b = bh >> 1, kvh = bh & 1;
    const act_t* arow = p.kvb + ((size_t)b * SEQ + 16 * cidx) * 512 + tensor * 128 + kvh * 64 + h * 32;
    const act_t* wsrc = p.btc + ((size_t)tensor * 256 + nq * 64) * 1024;
    f32x16 acc[2];
#pragma unroll
    for (int ct = 0; ct < 2; ++ct)
#pragma unroll
        for (int i = 0; i < 16; ++i) acc[ct][i] = 0.f;
    bf16x8 xa[4], xn[4]; u32x4 wreg;
#pragma unroll
    for (int ks = 0; ks < 4; ++ks) xa[ks] = *(const bf16x8*)(arow + 8 * ks);
    wreg = tile_load(wsrc, 1024, tid);
    __syncthreads();
    tile_store(lds, wreg, tid);
    __syncthreads();
    int cur = 0;
#pragma unroll 1
    for (int j = 0; j < 16; ++j) {
        const bool more = j < 15;
        if (more) {
#pragma unroll
            for (int ks = 0; ks < 4; ++ks) xn[ks] = *(const bf16x8*)(arow + (size_t)(j + 1) * 512 + 8 * ks);
            wreg = tile_load(wsrc + (j + 1) * 64, 1024, tid);
        }
        const PG8_LAS unsigned char* wb = lds + cur * 8192;
#pragma unroll
        for (int ks = 0; ks < 4; ++ks)
#pragma unroll
            for (int ct = 0; ct < 2; ++ct) acc[ct] = MFMA32(frag(wb, ct * 32 + l32, 4 * h + ks, xr), xa[ks], acc[ct]);
        if (more) tile_store(lds + (cur ^ 1) * 8192, wreg, tid);
        __syncthreads();
        cur ^= 1;
#pragma unroll
        for (int ks = 0; ks < 4; ++ks) xa[ks] = xn[ks];
    }
    act_t* orow = p.ccp + ((size_t)tensor * CROWS_P + r) * 256 + nq * 64 + 4 * h;
#pragma unroll
    for (int ct = 0; ct < 2; ++ct)
#pragma unroll
        for (int q = 0; q < 4; ++q) { u32x2 w; w[0] = pkbf(acc[ct][4 * q], acc[ct][4 * q + 1]); w[1] = pkbf(acc[ct][4 * q + 2], acc[ct][4 * q + 3]); *(u32x2*)(orow + ct * 32 + 8 * q) = w; }
}
}

struct MP { P p; unsigned* bar; };
#define PH(F, total) do { const int _tid = fresh_tid(); const long _t = (total); for (long gid = (long)blockIdx.x * NTHR + _tid; gid < _t; gid += (long)gridDim.x * NTHR) F(p, gid); } while (0)
#define COOP(fn) do { const int _tid = fresh_tid(); fn(p, (int)blockIdx.x * (NTHR / 64) + (_tid >> 6), (int)gridDim.x * (NTHR / 64), _tid & 63); } while (0)
#define BAR() xcd_barrier(xb)
__global__ void __launch_bounds__(NTHR, 2) k_mega(MP mp) {
    extern __shared__ __attribute__((aligned(16))) unsigned char shm[];
    PG8_LAS unsigned char* lds = (PG8_LAS unsigned char*)shm;
    const P& p = mp.p;
    if (threadIdx.x < 4) ((PG8_LAS unsigned*)(lds + LDS_BAR_OFF))[threadIdx.x] = 0u;
    __syncthreads();
    XcdBarrier xb = xcd_barrier_post(mp.bar, (volatile LAS unsigned*)(lds + LDS_BAR_OFF));
    PG8_LAS float* tl = (PG8_LAS float*)lds;
#ifndef DUP_MASK
#define DUP_MASK 0
#endif
#define REP(bit) for (int _rep = 0; _rep < 1 + 4 * ((DUP_MASK >> (bit)) & 1); ++_rep)
    REP(0) {
    COOP(coop::rmsnorm_in);
    __syncthreads();
    coop::weight_t<3>(tl, p.w_in, D, PROJ, p.bt_in, 0, fresh_tid()); PH(b_wt_inpad, (long)(PROJP - PROJ) * D);
    coop::weight_t(tl, p.w_out, 1024, D, p.bt_out, 0, fresh_tid());
    coop::weight_t<1>(tl, p.w_gate, D, DFF, p.bt_gu, 0, fresh_tid()); coop::weight_t<2>(tl, p.w_up, D, DFF, p.bt_gu, 0, fresh_tid());
    coop::weight_t(tl, p.w_down, DFF, D, p.bt_down, 0, fresh_tid());
    for (int ts = 0; ts < 2; ++ts) {
        coop::weight_t(tl, p.cmp_w1 + (size_t)ts * 2048 * 128, 1024, 128, p.btc + (size_t)ts * 256 * 1024, 0, fresh_tid());
        coop::weight_t(tl, p.cmp_w1 + (size_t)ts * 2048 * 128 + 1024 * 128, 1024, 128, p.btc + (size_t)ts * 256 * 1024, 128, fresh_tid());
    }
    COOP(coop::cmp_const_w); PH(b_w2t, 2 * 64 * 128);
    __syncthreads();
    }
    BAR();
    REP(2) {
    run_gemm_proj(lds, p);
    }
    cmps::phase(p, lds, mp.bar + CMPS_CNT_WORD);
    BAR();
    REP(4) {
    COOP(coop::gates1);
    PH(g_out_winp, (long)BATCH * WBP * 64); PH(g_out_wins, (long)DB * WBS * 64);
    COOP(coop::conv_rows);
    __syncthreads(); coop::prep_prompt(p, tl, fresh_tid()); __syncthreads();
    }
    REP(5) { COOP(coop::cmp_combine_s); }
    BAR();
    REP(16) { COOP(coop::gates2); }
    REP(9) {
    for (int u = (int)gridDim.x - 1 - (int)blockIdx.x; u < DB * 2 * atts::NPART; u += gridDim.x) atts::unit(p, lds, (u / atts::NPART) >> 1, (u / atts::NPART) & 1, u % atts::NPART);
    }
    REP(17) { for (int u = (int)blockIdx.x - 64; u >= 0 && u < cmpp::NUNIT; u += (int)gridDim.x) cmpp::unit(p, lds, u); }
    BAR();
    REP(18) { COOP(coop::cmp_combine_p); }
    REP(19) { const int t_ = fresh_tid(); const int g_ = ((int)blockIdx.x - ((int)gridDim.x - 8)) * (NTHR / 64) + (t_ >> 6); if (g_ >= 0) atts::finish(p, g_, 8 * (NTHR / 64), t_ & 63); }
    REP(6) {
    mls::phase_a(p, lds);
    }
    BAR();
    REP(7) { PH(b_scan3, (long)NSEQ * 16384); }
    BAR();
    REP(8) {
    mls::phase_b(p, lds);
    }
    REP(10) {
        constexpr int NT = SEQ / 64, NU = BATCH * 2 * NT;
        int tab_kvh = -1;
        for (int u = blockIdx.x; u < NU; u += gridDim.x) {
            const int k = u / (int)gridDim.x, per = (int)gridDim.x, lin = u % per;
            constexpr int NC8 = BATCH * 2;
            const int slot = lin / NC8, nslot = per / NC8;
            const int idx = k * per + ((k & 1) ? (nslot - 1 - slot) : slot) * NC8 + lin % NC8;
            if (idx < NU) { att::unit(p, lds, (idx % NC8) >> 1, idx & 1, idx / NC8, (idx & 1) != tab_kvh); tab_kvh = idx & 1; }
        }
    }
    BAR();
    constexpr int NSW = 4;
    const bool sw = (int)blockIdx.x < NSW; const int wgw = ((int)blockIdx.x - NSW) * (NTHR / 64), wnw = ((int)gridDim.x - NSW) * (NTHR / 64);
    REP(11) { run_gemm_b16(lds, p.mixb, p.bt_out, TOKP, D, 1024, p.mixh, D); }
    BAR();
    REP(12) {
        if (sw) run_gemm_b16(lds, p.mixb + (size_t)TOKP * 1024, p.bt_out, TOKS, D, 1024, p.mixh + (size_t)TOKP * D, D);
        else { const int t_ = fresh_tid(); coop::post1(p, 0, TOKP, wgw + (t_ >> 6), wnw, t_ & 63); }
    }
    BAR();
    REP(13) {
        { const int t_ = fresh_tid(); coop::post1(p, TOKP, TOK, (int)blockIdx.x * (NTHR / 64) + (t_ >> 6), (int)gridDim.x * (NTHR / 64), t_ & 63); }
        run_gemm_swiglu(lds, p.h2b, p.bt_gu, TOKP, 2 * DFF, D, p.actb, DFF);
    }
    BAR();
    REP(14) {
        run_gemm_swiglu(lds, p.h2b + (size_t)TOKP * D, p.bt_gu, TOKS, 2 * DFF, D, p.actb + (size_t)TOKP * DFF, DFF);
        run_gemm_b16(lds, p.actb, p.bt_down, TOKP, D, DFF, p.fh, D);
    }
    BAR();
    REP(15) {
        static_assert((DFF / 2) % 128 == 0, "K-half of the down projection");
        if ((int)blockIdx.x < NSW) run_gemm_b16(lds, p.actb + (size_t)TOKP * DFF, p.bt_down, TOKS, D, DFF / 2, p.fh + (size_t)TOKP * D, D, 0, DFF);
        else if ((int)blockIdx.x < 2 * NSW) run_gemm_b16(lds, p.actb + (size_t)TOKP * DFF + DFF / 2, p.bt_down + DFF / 2, TOKS, D, DFF / 2, p.fh2, D, NSW, DFF);
        else { const int t_ = fresh_tid(); coop::post2<false>(p, 0, TOKP, ((int)blockIdx.x - 2 * NSW) * (NTHR / 64) + (t_ >> 6), ((int)gridDim.x - 2 * NSW) * (NTHR / 64), t_ & 63); }
    }
    BAR();
    { const int t_ = fresh_tid(); coop::post2<true>(p, TOKP, TOK, (int)blockIdx.x * (NTHR / 64) + (t_ >> 6), (int)gridDim.x * (NTHR / 64), t_ & 63); }
}
#else
#define RUN(F, total) do { long _t = (total); _Pragma("omp parallel for schedule(dynamic, 64)") for (long g = 0; g < _t; ++g) F(p, g); } while (0)
static void cpu_gemm(const float* A, const float* B, const float* bias, float* C, int M, int N, int K) {
#pragma omp parallel for
    for (int m = 0; m < M; ++m) {
        for (int n = 0; n < N; ++n) C[(size_t)m * N + n] = bias ? bias[n] : 0.f;
        for (int k = 0; k < K; ++k) { const float a = A[(size_t)m * K + k]; for (int n = 0; n < N; ++n) C[(size_t)m * N + n] += a * B[(size_t)k * N + n]; }
    }
}
#define GEMM(A, B, bias, C, M, N, K) cpu_gemm(A, B, bias, C, M, N, K)
#endif
}

extern "C" void kernel_launch(void* const* d_in, const int* in_sizes, int n_in, void* d_out, int out_size, void* d_ws, size_t ws_size, hipStream_t stream) {
    P p{};
    p.x_prompt = (const float*)d_in[0]; p.x_sample = (const float*)d_in[1]; p.cache_kv = (const float*)d_in[2]; p.cache_win = (const float*)d_in[3];
    p.state_conv = (const float*)d_in[4]; p.state_C = (const float*)d_in[5]; p.state_n = (const float*)d_in[6]; p.state_m = (const float*)d_in[7];
    p.page_table = (const int*)d_in[8]; p.rel_bias = (const float*)d_in[9]; p.g_attn_pre = (const float*)d_in[10]; p.w_in = (const float*)d_in[11];
    p.b_in = (const float*)d_in[12]; p.cmp_pos = (const float*)d_in[13]; p.cmp_w1 = (const float*)d_in[14]; p.cmp_b1 = (const float*)d_in[15];
    p.cmp_w2 = (const float*)d_in[16]; p.cmp_b2 = (const float*)d_in[17]; p.conv_w = (const float*)d_in[18]; p.conv_b = (const float*)d_in[19];
    p.g_mnorm = (const float*)d_in[20]; p.w_out = (const float*)d_in[21]; p.g_attn_post = (const float*)d_in[22]; p.g_ffn_pre = (const float*)d_in[23];
    p.w_gate = (const float*)d_in[24]; p.w_up = (const float*)d_in[25]; p.w_down = (const float*)d_in[26]; p.g_ffn_post = (const float*)d_in[27];
    float* o = (float*)d_out;
    p.o_yp = o; o += (size_t)TOKP * D; p.o_ys = o; o += (size_t)TOKS * D; p.o_kvp = o; o += (size_t)TOKP * 512; p.o_kvs = o; o += (size_t)TOKS * 512;
    p.o_winp = o; o += (size_t)BATCH * WBP * 256; p.o_wins = o; o += (size_t)DB * WBS * 256; p.o_convp = o; o += (size_t)BATCH * 3072; p.o_convs = o; o += (size_t)DB * 3072;
    p.o_Cp = o; o += (size_t)BATCH * 65536; p.o_Cs = o; o += (size_t)DB * 65536; p.o_np = o; o += (size_t)BATCH * 512; p.o_ns = o; o += (size_t)DB * 512;
    p.o_mp = o; o += BATCH * 4; p.o_ms = o; o += DB * 4;
    float* w = (float*)d_ws + 4096;
    auto take = [&](size_t n) { float* r = w; w += (n + 63) / 64 * 64; return r; };
#ifdef CPU_EMU
    p.h = take((size_t)TOK * D); p.proj = take((size_t)TOK * PROJ); p.hid = take((size_t)(CMPROWS_P + CMPROWS_S) * 128); p.kcmp = take((size_t)(CMPROWS_P + CMPROWS_S) * 64);
    p.ml = take((size_t)TOK * 16); p.imp = take((size_t)TOK * 2 * NSB_MAX); p.idx = (int*)take((size_t)TOK * 32);
    p.mixin = take((size_t)TOK * 1024); p.qk = take((size_t)TOK * 1024); p.gm = take((size_t)TOK * 4);
    p.dC = take((size_t)NCHUNK * 65536); p.S = take((size_t)TOK * 256); p.hm_pre = take((size_t)TOK * 512);
    p.h2 = take((size_t)TOK * D); p.gate = take((size_t)TOK * 2 * DFF); p.up = p.gate; p.cprev = nullptr;
#endif
    p.oc = take((size_t)TOK * 512); p.gb = take((size_t)TOK * 4); p.dn = take((size_t)NCHUNK * 512);
    p.mix = take((size_t)TOK * D); p.x1 = take((size_t)TOK * D); p.f = take((size_t)TOK * D);
    auto takeb = [&](size_t n) { return (act_t*)take((n * sizeof(act_t) + 3) / 4); };
    p.hb = takeb((size_t)TOK * D); p.mixb = takeb((size_t)TOK * 1024); p.h2b = takeb((size_t)TOK * D); p.actb = takeb((size_t)TOK * DFF);
    p.qb = takeb((size_t)TOK * 512); p.kcs = takeb((size_t)DB * 2 * NCSPAD * 64); p.vcts = takeb((size_t)DB * 2 * NCSPAD * 64); p.vst = takeb((size_t)TOKP * 128); p.vwt = takeb((size_t)TOKP * 128);
    p.kc = takeb((size_t)BATCH * 2 * NCPAD * 64); p.vct = takeb((size_t)BATCH * 2 * NCPAD * 64);
    p.cmap = take((size_t)NCHUNK * 8); p.mprev = take((size_t)NCHUNK * 4); p.nprev = take((size_t)NCHUNK * 512);
    p.kvb = takeb((size_t)TOK * 512); p.kwb = takeb((size_t)TOK * 256); p.kvwf = take((size_t)TOK * 256); p.gatef = take((size_t)TOK * 32);
    p.mqkb = takeb((size_t)TOK * 1024); p.mvb = takeb((size_t)TOK * 512); p.mif = take((size_t)TOK * 8); p.mob = takeb((size_t)TOK * 512);
    p.mixh = takeb((size_t)TOK * D); p.fh = takeb((size_t)TOK * D); p.fh2 = takeb((size_t)TOKS * D);
    p.w2t = takeb((size_t)2 * 64 * 128);
    p.cas = takeb((size_t)2 * CROWS_S * 1024); p.cap = takeb((size_t)2 * CROWS_P * 1024); p.btc = takeb((size_t)2 * 256 * 1024);
    p.ccs = takeb((size_t)2 * CROWS_S * 256); p.ccp = takeb((size_t)2 * CROWS_P * 256); p.cmpc = take(256);
    p.qkb = takeb((size_t)TOK * 1024); p.dct = takeb((size_t)NCHUNK * 65536); p.cpt = takeb((size_t)NCHUNK * 65536);
    p.spart = take((size_t)DB * 2 * 4 * 2 * 64 * 34);
    p.bt_in = takeb((size_t)PROJP * D); p.bt_out = takeb((size_t)D * 1024); p.bt_gu = takeb((size_t)2 * DFF * D); p.bt_down = takeb((size_t)D * DFF);

#ifdef CPU_EMU
    p.cprev = p.dC; p.nprev = p.dn;
    RUN(b_rmsnorm_in, TOK);
    GEMM(p.hb, p.w_in, p.b_in, p.proj, TOK, PROJ, D);
    RUN(b_out_kv, (long)TOK * 512); RUN(b_out_winp, (long)BATCH * WBP * 256); RUN(b_out_wins, (long)DB * WBS * 256); RUN(b_out_conv, (long)NSEQ * 3072);
    RUN(b_cmp_hid, (CMPROWS_P + CMPROWS_S) * 128); RUN(b_cmp_out, (CMPROWS_P + CMPROWS_S) * 64);
    RUN(b_cmp_attn, (long)8 * TOK); RUN(b_imp, (long)TOK * 2 * NSB_MAX); RUN(b_topk, (long)TOK * 2); RUN(b_sel_win, (long)8 * TOK);
    RUN(b_conv, (long)TOK * 1024); RUN(b_gates, (long)NSEQ * 4); RUN(b_dC, (long)NCHUNK * 65536); RUN(b_scan, (long)NSEQ * 65536);
    RUN(b_S, (long)TOK * 256); RUN(b_hout, (long)TOK * 512); RUN(b_hnorm, (long)TOK * 4);
    GEMM(p.mixb, p.w_out, (const float*)nullptr, p.mix, TOK, D, 1024);
    RUN(b_post1, TOK);
    { float* g2 = p.gate;
      std::vector<float> tg((size_t)TOK * DFF), tu((size_t)TOK * DFF);
      GEMM(p.h2b, p.w_gate, (const float*)nullptr, tg.data(), TOK, DFF, D); GEMM(p.h2b, p.w_up, (const float*)nullptr, tu.data(), TOK, DFF, D);
      for (long r = 0; r < TOK; ++r) for (int c = 0; c < DFF; ++c) { g2[r * 2 * DFF + c] = tg[r * DFF + c]; g2[r * 2 * DFF + DFF + c] = tu[r * DFF + c]; } }
    RUN(b_swiglu, (long)TOK * DFF);
    GEMM(p.actb, p.w_down, (const float*)nullptr, p.f, TOK, D, DFF);
    RUN(b_post2, TOK);
#else
    static int grid = 0;
    if (grid == 0) {
        int dev = 0, cus = 0, per_cu = 0;
        if (hipGetDevice(&dev) != hipSuccess || hipDeviceGetAttribute(&cus, hipDeviceAttributeMultiprocessorCount, dev) != hipSuccess) { grid = -1; return; }
        if (hipFuncSetAttribute((const void*)k_mega, hipFuncAttributeMaxDynamicSharedMemorySize, LDS_BYTES) != hipSuccess) { grid = -1; return; }
        if (hipOccupancyMaxActiveBlocksPerMultiprocessor(&per_cu, (const void*)k_mega, NTHR, LDS_BYTES) != hipSuccess || per_cu < 1) (void)hipGetLastError();
        grid = cus;
    }
    if (grid < 0) return;
    (void)hipMemsetAsync(d_ws, 0, WS_ZERO_BYTES, stream);
    MP mp{}; mp.p = p; mp.bar = (unsigned*)d_ws;
    hipLaunchKernelGGL(k_mega, dim3(grid), dim3(NTHR), LDS_BYTES, stream, mp);
#endif
}
```

```cpp
#ifndef CPU_EMU
#include <hip/hip_runtime.h>
#else
#include <cmath>
#include <cstddef>
#include <vector>
#define __device__
#define __forceinline__ inline
typedef void* hipStream_t;
#endif
#include <stdint.h>

#ifndef CFG_D_MODEL
#define CFG_D_MODEL 1024
#define CFG_BATCH 4
#define CFG_SEQ 8192
#define CFG_DEC_BATCH 32
#define CFG_PAST_LEN 16384
#endif

namespace {
#ifdef CPU_EMU
typedef float act_t;
static inline act_t to_act(float f) { return f; }
#else
typedef unsigned short act_t;
typedef __bf16 hbf16v2_ __attribute__((ext_vector_type(2)));
typedef float hf32v2_ __attribute__((ext_vector_type(2)));
__device__ __forceinline__ unsigned pkbf(float lo, float hi) { hf32v2_ v = {lo, hi}; hbf16v2_ r = __builtin_convertvector(v, hbf16v2_); return __builtin_bit_cast(unsigned, r); }
__device__ __forceinline__ act_t to_act(float f) { return (act_t)(pkbf(f, 0.f) & 0xffffu); }
#endif
constexpr int D = CFG_D_MODEL, BATCH = CFG_BATCH, SEQ = CFG_SEQ, DB = CFG_DEC_BATCH, DS = 8, PAST = CFG_PAST_LEN;
constexpr int PAGE = 128, NPAGES = PAST / PAGE;
constexpr int TOKP = BATCH * SEQ, TOKS = DB * DS, TOK = TOKP + TOKS;
constexpr int PROJ = 3360, PROJP = 3584;
constexpr int DFF = ((-(-(8 * D) / 3)) + 255) / 256 * 256;
constexpr int C_Q = 0, C_KVP = 512, C_KVW = 1024, C_GATE = 1280, C_MQK = 1304, C_MV = 2328, C_MIF = 2840, C_MO = 2848;
constexpr int NC_P = SEQ / 16 - 1, NC_S = (PAST + DS) / 16 - 1;
constexpr int NSB_P = SEQ / 64, NSB_S = (PAST + DS + 63) / 64;
constexpr int NSB_MAX = NSB_P > NSB_S ? NSB_P : NSB_S;
constexpr int WBP = SEQ < 512 ? SEQ : 512, WBS = PAST < 512 ? PAST : 512;
constexpr int CLP = 64, NCKP = SEQ / CLP;
constexpr int NSEQ = BATCH + DB;
constexpr int NCHUNK = BATCH * NCKP + DB;
static_assert(SEQ % 128 == 0 && PAST % 128 == 0 && PAST >= 512 && DS == 8, "shape assumptions");
constexpr float NEGBIG = -1e9f, POSBIG = 1e9f;

struct P {
    const float *x_prompt, *x_sample, *cache_kv, *cache_win, *state_conv, *state_C, *state_n, *state_m;
    const int* page_table;
    const float *rel_bias, *g_attn_pre, *w_in, *b_in, *cmp_pos, *cmp_w1, *cmp_b1, *cmp_w2, *cmp_b2, *conv_w, *conv_b, *g_mnorm, *w_out,
        *g_attn_post, *g_ffn_pre, *w_gate, *w_up, *w_down, *g_ffn_post;
    float *o_yp, *o_ys, *o_kvp, *o_kvs, *o_winp, *o_wins, *o_convp, *o_convs, *o_Cp, *o_Cs, *o_np, *o_ns, *o_mp, *o_ms;
    float *h, *proj, *hid, *kcmp, *oc, *ml, *imp, *mixin, *qk, *gb, *gm, *dC, *dn, *S, *hm_pre, *mix, *x1, *h2, *gate, *up, *f;
    int* idx;
    float *cmap, *mprev, *cprev, *nprev, *spart;
    act_t *hb, *mixb, *h2b, *actb, *bt_in, *bt_out, *bt_gu, *bt_down;
    act_t *qb, *ks, *vst, *kw, *vwt, *kc, *vct, *kcs, *vcts;
    act_t *qkb, *dct, *cpt;
    act_t *kvb, *kwb, *mqkb, *mvb, *mob; float *kvwf, *gatef, *mif;
    act_t *mixh, *fh, *fh2;
    act_t *w2t;
    act_t *cas, *cap, *btc, *ccs, *ccp; float *cmpc;
};

#define DEV __device__ __forceinline__

struct Row { int path, b, t, pos; };
DEV Row row_info(int row) {
    Row r;
    if (row < TOKP) { r.path = 0; r.b = row / SEQ; r.t = row % SEQ; r.pos = r.t; }
    else { int q = row - TOKP; r.path = 1; r.b = q / DS; r.t = q % DS; r.pos = PAST + r.t; }
    return r;
}
DEV const float* xrow(const P& p, int row) { return row < TOKP ? p.x_prompt + (size_t)row * D : p.x_sample + (size_t)(row - TOKP) * D; }
DEV int seq_row0(int path, int b) { return path == 0 ? b * SEQ : TOKP + b * DS; }
DEV const float* kv_ptr(const P& p, int path, int b, int tpos, int which, int h) {
    if (path == 0) return p.proj + (size_t)(b * SEQ + tpos) * PROJ + C_KVP + which * 128 + h * 64;
    if (tpos < PAST) { int pg = p.page_table[b * NPAGES + tpos / PAGE]; return p.cache_kv + (((size_t)pg * PAGE + tpos % PAGE) * 4 + which) * 128 + h * 64; }
    return p.proj + (size_t)(TOKP + b * DS + (tpos - PAST)) * PROJ + C_KVP + which * 128 + h * 64;
}
DEV int rel_bucket(int n) {
    if (n < 16) return n;
    return 16 + (n >= 21) + (n >= 27) + (n >= 35) + (n >= 46) + (n >= 59) + (n >= 77) + (n >= 99) + (n >= 128) + (n >= 166) + (n >= 216) + (n >= 280) +
           (n >= 363) + (n >= 470) + (n >= 609) + (n >= 790);
}
DEV float sigmoidf_(float x) { return 1.0f / (1.0f + expf(-x)); }
DEV float siluf_(float x) { return x * sigmoidf_(x); }
DEV float fsigmoid_(float x) { return __builtin_amdgcn_rcpf(1.0f + __builtin_amdgcn_exp2f(x * -1.4426950408889634f)); }
DEV float logsigmoidf_(float x) { return fminf(x, 0.0f) - log1pf(expf(-fabsf(x))); }
#ifdef CPU_EMU
DEV float gelu_tanh(float x) { return 0.5f * x * (1.0f + tanhf(0.7978845608028654f * (x + 0.044715f * x * x * x))); }
#else
DEV float gelu_tanh(float x) { return x * fsigmoid_(1.5957691216057308f * (x + 0.044715f * x * x * x)); }
#endif
#ifdef CPU_EMU
#define SCHED_FENCE()
#else
#define SCHED_FENCE() __builtin_amdgcn_sched_barrier(0)
#endif
DEV float dot64(const float* q, const float* k) {
    float s = 0.f;
#pragma unroll
    for (int c = 0; c < 4; ++c) {
#pragma unroll
        for (int d = 0; d < 16; ++d) s += q[c * 16 + d] * k[c * 16 + d];
        SCHED_FENCE();
    }
    return s;
}
DEV void axpy64(float* acc, float a, float e, const float* v) {
#pragma unroll
    for (int c = 0; c < 4; ++c) {
#pragma unroll
        for (int d = 0; d < 16; ++d) acc[c * 16 + d] = acc[c * 16 + d] * a + e * v[c * 16 + d];
        SCHED_FENCE();
    }
}
DEV size_t kcmp_off(int path, int tensor) {
    size_t o = 0;
    if (path == 1) o += (size_t)2 * BATCH * NC_P * 128;
    o += (size_t)tensor * (path == 0 ? (size_t)BATCH * NC_P * 128 : (size_t)DB * NC_S * 128);
    return o;
}
DEV size_t hid_off(int path, int tensor) {
    size_t o = 0;
    if (path == 1) o += (size_t)2 * BATCH * NC_P * 256;
    o += (size_t)tensor * (path == 0 ? (size_t)BATCH * NC_P * 256 : (size_t)DB * NC_S * 256);
    return o;
}

DEV void b_rmsnorm_in(const P& p, long gid) {
    const int row = (int)gid; const float* x = xrow(p, row);
    float ss = 0.f; for (int k = 0; k < D; ++k) ss += x[k] * x[k];
    const float r = 1.0f / sqrtf(ss / D + 1e-6f);
    for (int k = 0; k < D; ++k) p.hb[(size_t)row * D + k] = to_act(x[k] * r * p.g_attn_pre[k]);
}
DEV void b_out_kv(const P& p, long gid) {
    const int row = (int)(gid / 512), c = (int)(gid % 512);
    const float v = p.proj[(size_t)row * PROJ + C_KVP + c];
    if (row < TOKP) p.o_kvp[(size_t)row * 512 + c] = v; else p.o_kvs[(size_t)(row - TOKP) * 512 + c] = v;
}
DEV void b_out_winp(const P& p, long gid) {
    const int c = (int)(gid % 256), r = (int)((gid / 256) % WBP), b = (int)(gid / (256 * WBP));
    p.o_winp[gid] = p.proj[(size_t)(b * SEQ + SEQ - WBP + r) * PROJ + C_KVW + c];
}
DEV void b_out_wins(const P& p, long gid) {
    const int c = (int)(gid % 256), r = (int)((gid / 256) % WBS), b = (int)(gid / (256 * WBS));
    const int pr = DS + r;
    p.o_wins[gid] = pr < WBS ? p.cache_win[((size_t)b * WBS + pr) * 256 + c] : p.proj[(size_t)(TOKP + b * DS + pr - WBS) * PROJ + C_KVW + c];
}
DEV void b_out_conv(const P& p, long gid) {
    const int c = (int)(gid % 1024), j = (int)((gid / 1024) % 3), sq = (int)(gid / 3072);
    if (sq < BATCH) p.o_convp[gid] = p.proj[(size_t)(sq * SEQ + SEQ - 3 + j) * PROJ + C_MQK + c];
    else p.o_convs[gid - (size_t)BATCH * 3072] = p.proj[(size_t)(TOKP + (sq - BATCH) * DS + DS - 3 + j) * PROJ + C_MQK + c];
}
constexpr long CMPROWS_P = (long)2 * BATCH * NC_P * 2, CMPROWS_S = (long)2 * DB * NC_S * 2;
DEV void cmp_decode(long r, int& path, int& tensor, int& b, int& c, int& h) {
    if (r < CMPROWS_P) { path = 0; h = (int)(r % 2); c = (int)((r / 2) % NC_P); b = (int)((r / (2 * NC_P)) % BATCH); tensor = (int)(r / ((long)2 * NC_P * BATCH)); }
    else { r -= CMPROWS_P; path = 1; h = (int)(r % 2); c = (int)((r / 2) % NC_S); b = (int)((r / (2 * NC_S)) % DB); tensor = (int)(r / ((long)2 * NC_S * DB)); }
}
DEV void b_cmp_hid(const P& p, long gid) {
    const int e = (int)(gid % 128); int path, tensor, b, c, h; cmp_decode(gid / 128, path, tensor, b, c, h);
    const float* w1 = p.cmp_w1 + (size_t)tensor * 2048 * 128; const float* pos = p.cmp_pos + tensor * 2048;
    float acc = p.cmp_b1[tensor * 128 + e];
    for (int j = 0; j < 32; ++j) {
        const float* kr = kv_ptr(p, path, b, c * 16 + j, tensor, h);
        for (int d = 0; d < 64; ++d) acc += (kr[d] + pos[j * 64 + d]) * w1[(size_t)(j * 64 + d) * 128 + e];
    }
    const int nc = path ? NC_S : NC_P;
    p.hid[hid_off(path, tensor) + ((size_t)(b * nc + c) * 2 + h) * 128 + e] = gelu_tanh(acc);
}
DEV void b_cmp_out(const P& p, long gid) {
    const int d = (int)(gid % 64); int path, tensor, b, c, h; cmp_decode(gid / 64, path, tensor, b, c, h);
    const int nc = path ? NC_S : NC_P;
    const float* hid = p.hid + hid_off(path, tensor) + ((size_t)(b * nc + c) * 2 + h) * 128;
    const float* w2 = p.cmp_w2 + (size_t)tensor * 128 * 64;
    float acc = p.cmp_b2[tensor * 64 + d];
    for (int e = 0; e < 128; ++e) acc += hid[e] * w2[e * 64 + d];
    p.kcmp[kcmp_off(path, tensor) + ((size_t)(b * nc + c) * 2 + h) * 64 + d] = acc;
}
DEV void b_cmp_attn(const P& p, long gid) {
    const int row = (int)(gid % TOK), head = (int)(gid / TOK), kvh = head >> 2; const Row r = row_info(row);
    const int nc = r.path ? NC_S : NC_P;
    float q[64];
#pragma unroll
    for (int d = 0; d < 64; ++d) q[d] = p.proj[(size_t)row * PROJ + C_Q + head * 64 + d] * 0.125f;
    int nv = r.pos >= 31 ? (r.pos - 31) / 16 + 1 : 0; if (nv > nc) nv = nc;
    const float* kc = p.kcmp + kcmp_off(r.path, 0) + (size_t)r.b * nc * 128 + kvh * 64;
    const float* vc = p.kcmp + kcmp_off(r.path, 1) + (size_t)r.b * nc * 128 + kvh * 64;
    float m = -3.0e38f;
    for (int c = 0; c < nv; ++c) { const float s = dot64(q, kc + (size_t)c * 128) + p.rel_bias[rel_bucket(r.pos - (c * 16 + 31)) * 8 + head]; m = fmaxf(m, s); }
    float l = 0.f; float acc[64];
#pragma unroll
    for (int d = 0; d < 64; ++d) acc[d] = 0.f;
    for (int c = 0; c < nv; ++c) {
        const float s = dot64(q, kc + (size_t)c * 128) + p.rel_bias[rel_bucket(r.pos - (c * 16 + 31)) * 8 + head];
        const float e = expf(s - m); l += e; axpy64(acc, 1.0f, e, vc + (size_t)c * 128);
    }
    const float inv = nv > 0 ? 1.0f / l : 0.f;
#pragma unroll
    for (int d = 0; d < 64; ++d) p.oc[(size_t)row * 512 + head * 64 + d] = acc[d] * inv;
    p.ml[((size_t)row * 8 + head) * 2 + 0] = m; p.ml[((size_t)row * 8 + head) * 2 + 1] = inv;
}
DEV void b_imp(const P& p, long gid) {
    const int j = (int)(gid % NSB_MAX), kvh = (int)((gid / NSB_MAX) % 2), row = (int)(gid / (2 * NSB_MAX)); const Row r = row_info(row);
    const int nc = r.path ? NC_S : NC_P, nsb = r.path ? NSB_S : NSB_P;
    if (j >= nsb) return;
    float sc;
    if (j == r.pos / 64 || j == 0) sc = POSBIG;
    else if (j * 64 > r.pos) sc = NEGBIG;
    else {
        sc = 0.f;
        const float* kc = p.kcmp + kcmp_off(r.path, 0) + (size_t)r.b * nc * 128 + kvh * 64;
        for (int g = 0; g < 4; ++g) {
            const int head = kvh * 4 + g;
            const float m = p.ml[((size_t)row * 8 + head) * 2], inv = p.ml[((size_t)row * 8 + head) * 2 + 1];
            const float* qp = p.proj + (size_t)row * PROJ + C_Q + head * 64;
            for (int c = 4 * j - 1; c <= 4 * j + 3; ++c) {
                if (c < 0 || c >= nc || c * 16 + 31 > r.pos) continue;
                float s = 0.f; for (int d = 0; d < 64; ++d) s += qp[d] * 0.125f * kc[(size_t)c * 128 + d];
                s += p.rel_bias[rel_bucket(r.pos - (c * 16 + 31)) * 8 + head];
                sc += expf(s - m) * inv;
            }
        }
    }
    p.imp[((size_t)row * 2 + kvh) * NSB_MAX + j] = sc;
}
DEV void b_topk(const P& p, long gid) {
    const int kvh = (int)(gid % 2), row = (int)(gid / 2); const Row r = row_info(row);
    const int ncb = r.pos / 64 + 1;
    const float* sc = p.imp + ((size_t)row * 2 + kvh) * NSB_MAX;
    float pv = 3.0e38f; int pj = -1;
    for (int it = 0; it < 16; ++it) {
        float bv = -3.0e38f; int bj = -1;
        for (int j = 0; j < ncb; ++j) {
            const float v = sc[j];
            const bool after = (v < pv) || (v == pv && j > pj);
            if (after && (bj < 0 || v > bv)) { bv = v; bj = j; }
        }
        p.idx[((size_t)row * 2 + kvh) * 16 + it] = bj;
        if (bj < 0) { pv = -3.0e38f; pj = 1 << 30; } else { pv = bv; pj = bj; }
    }
}
DEV void b_sel_win(const P& p, long gid) {
    const int row = (int)(gid % TOK), head = (int)(gid / TOK), kvh = head >> 2; const Row r = row_info(row);
    float q[64];
#pragma unroll
    for (int d = 0; d < 64; ++d) q[d] = p.proj[(size_t)row * PROJ + C_Q + head * 64 + d] * 0.125f;
    float m = -3.0e38f, l = 0.f; float acc[64];
#pragma unroll
    for (int d = 0; d < 64; ++d) acc[d] = 0.f;
    for (int it = 0; it < 16; ++it) {
        const int j = p.idx[((size_t)row * 2 + kvh) * 16 + it];
        if (j < 0) continue;
        for (int s = 0; s < 64; ++s) {
            const int kpos = j * 64 + s; if (kpos > r.pos) break;
            const float* kr = kv_ptr(p, r.path, r.b, kpos, 2, kvh); const float* vr = kv_ptr(p, r.path, r.b, kpos, 3, kvh);
            const float sc = dot64(q, kr) + p.rel_bias[rel_bucket(r.pos - kpos) * 8 + head];
            const float mn = fmaxf(m, sc), a = expf(m - mn), e = expf(sc - mn);
            l = l * a + e; m = mn; axpy64(acc, a, e, vr);
        }
    }
    const float g0 = sigmoidf_(p.proj[(size_t)row * PROJ + C_GATE + head * 3 + 0]), g1 = sigmoidf_(p.proj[(size_t)row * PROJ + C_GATE + head * 3 + 1]),
                g2 = sigmoidf_(p.proj[(size_t)row * PROJ + C_GATE + head * 3 + 2]);
    { const float inv = 1.0f / l;
#pragma unroll
      for (int d = 0; d < 64; ++d) p.mixin[(size_t)row * 1024 + head * 64 + d] = g0 * p.oc[(size_t)row * 512 + head * 64 + d] + g1 * acc[d] * inv; }
    m = -3.0e38f; l = 0.f;
#pragma unroll
    for (int d = 0; d < 64; ++d) acc[d] = 0.f;
    int k0 = r.pos - 511; if (r.path == 0 && k0 < 0) k0 = 0;
    for (int kp = k0; kp <= r.pos; ++kp) {
        const float* kr;
        if (r.path == 0) kr = p.proj + (size_t)(r.b * SEQ + kp) * PROJ + C_KVW + kvh * 64;
        else if (kp < PAST) kr = p.cache_win + ((size_t)r.b * WBS + (kp - (PAST - WBS))) * 256 + kvh * 64;
        else kr = p.proj + (size_t)(TOKP + r.b * DS + (kp - PAST)) * PROJ + C_KVW + kvh * 64;
        const float* vr = kr + 128;
        const float sc = dot64(q, kr) + p.rel_bias[rel_bucket(r.pos - kp) * 8 + head];
        const float mn = fmaxf(m, sc), a = expf(m - mn), e = expf(sc - mn);
        l = l * a + e; m = mn; axpy64(acc, a, e, vr);
    }
    { const float inv = 1.0f / l;
#pragma unroll
      for (int d = 0; d < 64; ++d) p.mixb[(size_t)row * 1024 + head * 64 + d] = to_act(p.mixin[(size_t)row * 1024 + head * 64 + d] + g2 * acc[d] * inv); }
}
DEV void b_conv(const P& p, long gid) {
    const int c = (int)(gid % 1024), row = (int)(gid / 1024); const Row r = row_info(row);
    float acc = p.conv_b[c];
#pragma unroll
    for (int j = 0; j < 4; ++j) {
        const int tt = r.t - 3 + j; float v;
        if (tt >= 0) v = p.proj[(size_t)(row - 3 + j) * PROJ + C_MQK + c];
        else v = r.path ? p.state_conv[((size_t)r.b * 3 + (r.t + j)) * 1024 + c] : 0.f;
        acc += v * p.conv_w[j * 1024 + c];
    }
    float o = siluf_(acc); if (c >= 512) o *= 0.08838834764831845f;
    p.qk[(size_t)row * 1024 + c] = o;
#ifndef CPU_EMU
    p.qkb[(size_t)row * 1024 + c] = to_act(o);
#endif
}
DEV void b_gates(const P& p, long gid) {
    const int h = (int)(gid % 4), sq = (int)(gid / 4); const int path = sq < BATCH ? 0 : 1, b = path ? sq - BATCH : sq;
    const int T = path ? DS : SEQ, CL = path ? DS : CLP, r0 = seq_row0(path, b);
    float m = path ? p.state_m[b * 4 + h] : 0.f, bs = 0.f;
    for (int t = 0; t < T; ++t) {
        if (t % CL == 0) bs = 0.f;
        const size_t row = r0 + t;
        const float ig = p.proj[row * PROJ + C_MIF + h], lf = logsigmoidf_(p.proj[row * PROJ + C_MIF + 4 + h]);
        bs += lf; m = fmaxf(lf + m, ig);
        p.gb[row * 4 + h] = bs; p.gm[row * 4 + h] = m;
    }
    if (path) p.o_ms[b * 4 + h] = m; else p.o_mp[b * 4 + h] = m;
}
DEV void chunk_info(int ch, int& path, int& b, int& c, int& r0, int& cl) {
    if (ch < BATCH * NCKP) { path = 0; b = ch / NCKP; c = ch % NCKP; r0 = b * SEQ + c * CLP; cl = CLP; }
    else { path = 1; b = ch - BATCH * NCKP; c = 0; r0 = TOKP + b * DS; cl = DS; }
}
DEV float chunk_mprev(const P& p, int path, int b, int c, int r0, int h) {
    if (c > 0) return p.gm[(size_t)(r0 - 1) * 4 + h];
    return path ? p.state_m[b * 4 + h] : 0.f;
}
DEV void b_scan2(const P& p, long gid) {
    const int v = (int)(gid % 128), d = (int)((gid / 128) % 128), h = (int)((gid / 16384) % 4), sq = (int)(gid / 65536);
    const int path = sq < BATCH ? 0 : 1, b = path ? sq - BATCH : sq, nck = path ? 1 : NCKP, ch0 = path ? BATCH * NCKP + b : b * NCKP;
    float C = path ? p.state_C[(((size_t)b * 4 + h) * 128 + d) * 128 + v] : 0.f;
    float n = path ? p.state_n[((size_t)b * 4 + h) * 128 + d] : 0.f;
    const float* __restrict__ dC = p.dC + (((size_t)ch0 * 4 + h) * 128 + d) * 128 + v; float* __restrict__ cp = p.cprev + (((size_t)ch0 * 4 + h) * 128 + d) * 128 + v;
    const float* __restrict__ dn = p.dn + ((size_t)ch0 * 4 + h) * 128 + d; float* __restrict__ np_ = p.nprev + ((size_t)ch0 * 4 + h) * 128 + d;
    const float* __restrict__ cm = p.cmap + ((size_t)ch0 * 4 + h) * 2; const float* __restrict__ mp = p.mprev + (size_t)ch0 * 4 + h;
    float mpv = mp[0];
#pragma unroll 8
    for (int c = 0; c < nck; ++c) {
        const float L = cm[(size_t)c * 8], I = cm[(size_t)c * 8 + 1], mnew = fmaxf(mpv + L, I), decay = expf(L + mpv - mnew);
        const float t = dC[(size_t)c * 65536]; cp[(size_t)c * 65536] = C; C = decay * C + t;
        if (v == 0) { const float tn = dn[(size_t)c * 512]; np_[(size_t)c * 512] = n; n = decay * n + tn; }
        mpv = mnew;
    }
    const size_t oi = (((size_t)b * 4 + h) * 128 + d) * 128 + v;
    if (path) p.o_Cs[oi] = C; else p.o_Cp[oi] = C;
    if (v == 0) { const size_t ni = ((size_t)b * 4 + h) * 128 + d; if (path) p.o_ns[ni] = n; else p.o_np[ni] = n; }
}
DEV void b_dC(const P& p, long gid) {
    const int v = (int)(gid % 128), d = (int)((gid / 128) % 128), h = (int)((gid / 16384) % 4), ch = (int)(gid / 65536);
    int path, b, c, r0, cl; chunk_info(ch, path, b, c, r0, cl);
    const float bend = p.gb[(size_t)(r0 + cl - 1) * 4 + h], mnew = p.gm[(size_t)(r0 + cl - 1) * 4 + h];
    float acc = 0.f, accn = 0.f;
    for (int s = 0; s < cl; ++s) {
        const size_t row = r0 + s;
        const float wk = expf(bend - p.gb[row * 4 + h] + p.proj[row * PROJ + C_MIF + h] - mnew);
        const float kk = p.qk[row * 1024 + 512 + h * 128 + d];
        acc += wk * kk * p.proj[row * PROJ + C_MV + h * 128 + v]; accn += wk * kk;
    }
    p.dC[gid] = acc;
    if (v == 0) p.dn[((size_t)ch * 4 + h) * 128 + d] = accn;
}
DEV void b_scan(const P& p, long gid) {
    const int v = (int)(gid % 128), d = (int)((gid / 128) % 128), h = (int)((gid / 16384) % 4), sq = (int)(gid / 65536);
    const int path = sq < BATCH ? 0 : 1, b = path ? sq - BATCH : sq, nck = path ? 1 : NCKP;
    float C = path ? p.state_C[(((size_t)b * 4 + h) * 128 + d) * 128 + v] : 0.f;
    float n = path ? p.state_n[((size_t)b * 4 + h) * 128 + d] : 0.f;
    for (int c = 0; c < nck; ++c) {
        const int ch = path ? BATCH * NCKP + b : b * NCKP + c; int pp, bb, cc, r0, cl; chunk_info(ch, pp, bb, cc, r0, cl);
        const float bend = p.gb[(size_t)(r0 + cl - 1) * 4 + h], mnew = p.gm[(size_t)(r0 + cl - 1) * 4 + h], mprev = chunk_mprev(p, path, b, c, r0, h);
        const float decay = expf(bend + mprev - mnew);
        const size_t ci = (((size_t)ch * 4 + h) * 128 + d) * 128 + v;
        const float t = p.dC[ci]; p.dC[ci] = C; C = decay * C + t;
        if (v == 0) { const size_t ni = ((size_t)ch * 4 + h) * 128 + d; const float tn = p.dn[ni]; p.dn[ni] = n; n = decay * n + tn; }
    }
    const size_t oi = (((size_t)b * 4 + h) * 128 + d) * 128 + v;
    if (path) p.o_Cs[oi] = C; else p.o_Cp[oi] = C;
    if (v == 0) { const size_t ni = ((size_t)b * 4 + h) * 128 + d; if (path) p.o_ns[ni] = n; else p.o_np[ni] = n; }
}
DEV void b_S(const P& p, long gid) {
    const int s = (int)(gid % 64), h = (int)((gid / 64) % 4), row = (int)(gid / 256); const Row r = row_info(row);
    const int cl = r.path ? DS : CLP, tl = r.t % cl, rs = row - tl + s;
    float o = 0.f;
    if (s <= tl) {
        const float* qp = p.qk + (size_t)row * 1024 + h * 128; const float* kp = p.qk + (size_t)rs * 1024 + 512 + h * 128;
        float dt = 0.f; for (int d = 0; d < 128; ++d) dt += qp[d] * kp[d];
        o = dt * expf(p.gb[(size_t)row * 4 + h] - p.gb[(size_t)rs * 4 + h] + p.proj[(size_t)rs * PROJ + C_MIF + h] - p.gm[(size_t)row * 4 + h]);
    }
    p.S[gid] = o;
}
DEV void b_hout(const P& p, long gid) {
    const int v = (int)(gid % 128), h = (int)((gid / 128) % 4), row = (int)(gid / 512); const Row r = row_info(row);
    const int cl = r.path ? DS : CLP, tl = r.t % cl, c = r.t / cl, r0 = row - tl;
    const int ch = r.path ? BATCH * NCKP + r.b : r.b * NCKP + c;
    const float mt = p.gm[(size_t)row * 4 + h], inter = expf(p.gb[(size_t)row * 4 + h] + chunk_mprev(p, r.path, r.b, c, r0, h) - mt);
    const float* Sr = p.S + ((size_t)row * 4 + h) * 64;
    float num = 0.f, den = 0.f;
    for (int s = 0; s <= tl; ++s) { num += Sr[s] * p.proj[(size_t)(r0 + s) * PROJ + C_MV + h * 128 + v]; den += Sr[s]; }
    const float* qp = p.qk + (size_t)row * 1024 + h * 128;
    const float* Cp = p.cprev + ((size_t)ch * 4 + h) * 16384; const float* np_ = p.nprev + ((size_t)ch * 4 + h) * 128;
    float qc = 0.f, qn = 0.f;
    for (int d = 0; d < 128; ++d) { qc += qp[d] * Cp[d * 128 + v]; qn += qp[d] * np_[d]; }
    num += inter * qc; den += inter * qn;
    const float hv = num / fmaxf(fabsf(den), expf(-mt));
    p.hm_pre[(size_t)row * 512 + h * 128 + v] = sigmoidf_(p.proj[(size_t)row * PROJ + C_MO + h * 128 + v]) * hv;
}
DEV void b_hnorm(const P& p, long gid) {
    const int h = (int)(gid % 4), row = (int)(gid / 4);
    const float* x = p.hm_pre + (size_t)row * 512 + h * 128;
    float ss = 0.f; for (int k = 0; k < 128; ++k) ss += x[k] * x[k];
    const float rr = 1.0f / sqrtf(ss / 128 + 1e-6f);
    for (int k = 0; k < 128; ++k) p.mixb[(size_t)row * 1024 + 512 + h * 128 + k] = to_act(x[k] * rr * p.g_mnorm[h * 128 + k]);
}
DEV void b_post1(const P& p, long gid) {
    const int row = (int)gid; const float* x = xrow(p, row); const float* mx = p.mix + (size_t)row * D;
    float ss = 0.f; for (int k = 0; k < D; ++k) ss += mx[k] * mx[k];
    const float r1 = 1.0f / sqrtf(ss / D + 1e-6f);
    float s2 = 0.f;
    for (int k = 0; k < D; ++k) { const float v = x[k] + mx[k] * r1 * p.g_attn_post[k]; p.x1[(size_t)row * D + k] = v; s2 += v * v; }
    const float r2 = 1.0f / sqrtf(s2 / D + 1e-6f);
    for (int k = 0; k < D; ++k) p.h2b[(size_t)row * D + k] = to_act(p.x1[(size_t)row * D + k] * r2 * p.g_ffn_pre[k]);
}
DEV void b_swiglu(const P& p, long gid) {
    const long row = gid / DFF, c = gid % DFF; p.actb[gid] = to_act(siluf_(p.gate[row * 2 * DFF + c]) * p.gate[row * 2 * DFF + DFF + c]);
}
DEV void b_wt(const float* w, act_t* bt, int K, int N, int col0, long gid) { const int n = (int)(gid % N), k = (int)(gid / N); bt[(size_t)(col0 + n) * K + k] = to_act(w[gid]); }
DEV void b_wt_in(const P& p, long gid) { b_wt(p.w_in, p.bt_in, D, PROJ, 0, gid); }
DEV void b_wt_inpad(const P& p, long gid) { p.bt_in[(size_t)PROJ * D + gid] = to_act(0.f); }
DEV void b_wt_out(const P& p, long gid) { b_wt(p.w_out, p.bt_out, 1024, D, 0, gid); }
DEV void b_wt_gate(const P& p, long gid) { b_wt(p.w_gate, p.bt_gu, D, DFF, 0, gid); }
DEV void b_wt_up(const P& p, long gid) { b_wt(p.w_up, p.bt_gu, D, DFF, DFF, gid); }
DEV void b_wt_down(const P& p, long gid) { b_wt(p.w_down, p.bt_down, DFF, D, 0, gid); }
DEV void b_post2(const P& p, long gid) {
    const int row = (int)gid; const float* fx = p.f + (size_t)row * D;
    float ss = 0.f; for (int k = 0; k < D; ++k) ss += fx[k] * fx[k];
    const float r1 = 1.0f / sqrtf(ss / D + 1e-6f);
    float* y = row < TOKP ? p.o_yp + (size_t)row * D : p.o_ys + (size_t)(row - TOKP) * D;
    for (int k = 0; k < D; ++k) y[k] = p.x1[(size_t)row * D + k] + fx[k] * r1 * p.g_ffn_post[k];
}


constexpr float LOG2E = 1.4426950408889634f;
DEV int clampi3(int x, int lo, int hi) { return x < lo ? lo : (x > hi ? hi : x); }
DEV int perm16(int t) { return (t & ~15) | (t & 3) | ((t & 4) << 1) | ((t & 8) >> 1); }
DEV void b_prep_q(const P& p, long gid) {
    p.qb[gid] = to_act(p.proj[(size_t)(gid / 512) * PROJ + C_Q + (gid % 512)] * (0.125f * LOG2E));
}
DEV void b_prep_kv(const P& p, long gid) {
    const int d = (int)(gid % 64), kvh = (int)((gid / 64) % 2), t = (int)((gid / 128) % SEQ), b = (int)(gid / (128 * (long)SEQ));
    const float* pr = p.proj + (size_t)(b * SEQ + t) * PROJ;
    const size_t bh = (size_t)b * 2 + kvh;
    p.ks[(bh * SEQ + t) * 64 + d] = to_act(pr[C_KVP + 2 * 128 + kvh * 64 + d]);
    p.vst[(bh * 64 + d) * SEQ + perm16(t)] = to_act(pr[C_KVP + 3 * 128 + kvh * 64 + d]);
    p.kw[(bh * SEQ + t) * 64 + d] = to_act(pr[C_KVW + kvh * 64 + d]);
    p.vwt[(bh * 64 + d) * SEQ + perm16(t)] = to_act(pr[C_KVW + 128 + kvh * 64 + d]);
}
constexpr int NCPAD = (NC_P + 64) / 64 * 64, NCSPAD = (NC_S + 64) / 64 * 64;
DEV void b_prep_c(const P& p, long gid) {
    const int d = (int)(gid % 64), c = (int)((gid / 64) % NCPAD), kvh = (int)((gid / (64 * NCPAD)) % 2), b = (int)(gid / (128 * (long)NCPAD));
    const size_t bh = (size_t)b * 2 + kvh;
    float kv = 0.f, vv = 0.f;
    if (c < NC_P) { kv = p.kcmp[kcmp_off(0, 0) + ((size_t)(b * NC_P + c) * 2 + kvh) * 64 + d]; vv = p.kcmp[kcmp_off(0, 1) + ((size_t)(b * NC_P + c) * 2 + kvh) * 64 + d]; }
    p.kc[(bh * NCPAD + c) * 64 + d] = to_act(kv);
    p.vct[(bh * 64 + d) * NCPAD + perm16(c)] = to_act(vv);
}
DEV void b_prep_cs(const P& p, long gid) {
    const int d = (int)(gid % 64), c = (int)((gid / 64) % NCSPAD), kvh = (int)((gid / (64 * NCSPAD)) % 2), b = (int)(gid / (128 * (long)NCSPAD));
    const size_t bh = (size_t)b * 2 + kvh;
    float kv = 0.f, vv = 0.f;
    if (c < NC_S) { kv = p.kcmp[kcmp_off(1, 0) + ((size_t)(b * NC_S + c) * 2 + kvh) * 64 + d]; vv = p.kcmp[kcmp_off(1, 1) + ((size_t)(b * NC_S + c) * 2 + kvh) * 64 + d]; }
    p.kcs[(bh * NCSPAD + c) * 64 + d] = to_act(kv);
    p.vcts[(bh * 64 + d) * NCSPAD + perm16(c)] = to_act(vv);
}


DEV void b_scan3(const P& p, long gid) {
    typedef float f32x4 __attribute__((ext_vector_type(4))); typedef unsigned u32x2 __attribute__((ext_vector_type(2)));
    const int dq = (int)(gid % 32), v = (int)((gid / 32) % 128), h = (int)((gid / 4096) % 4), sq = (int)(gid / 16384);
    const int path = sq < BATCH ? 0 : 1, b = path ? sq - BATCH : sq, nck = path ? 1 : NCKP, ch0 = path ? BATCH * NCKP + b : b * NCKP;
    float C[4], n[4] = {0.f, 0.f, 0.f, 0.f};
#pragma unroll
    for (int e = 0; e < 4; ++e) C[e] = path ? p.state_C[(((size_t)b * 4 + h) * 128 + dq * 4 + e) * 128 + v] : 0.f;
    const bool don = (v == 0);
    if (don && path) { const f32x4 t = *(const f32x4*)(p.state_n + ((size_t)b * 4 + h) * 128 + dq * 4); n[0] = t[0]; n[1] = t[1]; n[2] = t[2]; n[3] = t[3]; }
    const act_t* __restrict__ dC = p.dct + ((size_t)ch0 * 4 + h) * 16384 + v * 128 + dq * 4; act_t* __restrict__ cp = p.cpt + ((size_t)ch0 * 4 + h) * 16384 + v * 128 + dq * 4;
    const float* __restrict__ dn = p.dn + ((size_t)ch0 * 4 + h) * 128 + dq * 4; float* __restrict__ np_ = p.nprev + ((size_t)ch0 * 4 + h) * 128 + dq * 4;
    const float* __restrict__ cm = p.cmap + ((size_t)ch0 * 4 + h) * 2;
    float mpv = p.mprev[(size_t)ch0 * 4 + h];
    constexpr int BT = 8;
    float Lc[BT], Ic[BT], Ln[BT], In[BT]; u32x2 tc[BT], tn_[BT];
#pragma unroll
    for (int i = 0; i < BT; ++i) { const int c = i < nck ? i : nck - 1; Lc[i] = cm[(size_t)c * 8]; Ic[i] = cm[(size_t)c * 8 + 1]; tc[i] = *(const u32x2*)(dC + (size_t)c * 65536); Ln[i] = Lc[i]; In[i] = Ic[i]; tn_[i] = tc[i]; }
    for (int cb = 0; cb < nck; cb += BT) {
        if (cb + BT < nck) {
#pragma unroll
            for (int i = 0; i < BT; ++i) { const int c = cb + BT + i < nck ? cb + BT + i : nck - 1; Ln[i] = cm[(size_t)c * 8]; In[i] = cm[(size_t)c * 8 + 1]; tn_[i] = *(const u32x2*)(dC + (size_t)c * 65536); }
        }
#pragma unroll
        for (int i = 0; i < BT; ++i) {
            const int c = cb + i;
            if (c < nck) {
                const float L = Lc[i], I = Ic[i], mnew = fmaxf(mpv + L, I), decay = expf(L + mpv - mnew);
                const u32x2 t = tc[i];
                u32x2 o; o[0] = pkbf(C[0], C[1]); o[1] = pkbf(C[2], C[3]);
                *(u32x2*)(cp + (size_t)c * 65536) = o;
                C[0] = decay * C[0] + __uint_as_float(t[0] << 16); C[1] = decay * C[1] + __uint_as_float(t[0] & 0xffff0000u);
                C[2] = decay * C[2] + __uint_as_float(t[1] << 16); C[3] = decay * C[3] + __uint_as_float(t[1] & 0xffff0000u);
                if (don) { const f32x4 tn = *(const f32x4*)(dn + (size_t)c * 512); *(f32x4*)(np_ + (size_t)c * 512) = (f32x4){n[0], n[1], n[2], n[3]};
#pragma unroll
                    for (int e = 0; e < 4; ++e) n[e] = decay * n[e] + tn[e]; }
                mpv = mnew;
            }
        }
#pragma unroll
        for (int i = 0; i < BT; ++i) { Lc[i] = Ln[i]; Ic[i] = In[i]; tc[i] = tn_[i]; }
    }
    float* oC = path ? p.o_Cs : p.o_Cp; float* on = path ? p.o_ns : p.o_np;
#pragma unroll
    for (int e = 0; e < 4; ++e) oC[(((size_t)b * 4 + h) * 128 + dq * 4 + e) * 128 + v] = C[e];
    if (don) *(f32x4*)(on + ((size_t)b * 4 + h) * 128 + dq * 4) = (f32x4){n[0], n[1], n[2], n[3]};
}

constexpr int NCH_P = SEQ / 16, NCH_S = PAST / 16;
constexpr int CROWS_P = BATCH * 2 * NCH_P, CROWS_S = DB * 2 * NCH_S;
static_assert(CROWS_P % 256 == 0 && CROWS_S % 256 == 0 && NCH_P == NCPAD && NCH_S == NCSPAD, "compression GEMM shapes");
DEV void b_cmp_const(const P& p, long gid) {
    const int e = (int)(gid % 128), tensor = (int)(gid / 128);
    float acc = p.cmp_b1[tensor * 128 + e];
    for (int k = 0; k < 2048; ++k) acc += p.cmp_pos[tensor * 2048 + k] * p.cmp_w1[((size_t)tensor * 2048 + k) * 128 + e];
    p.cmpc[gid] = acc;
}
DEV void b_w2t(const P& p, long gid) {
    const int e = (int)(gid % 128), d = (int)((gid / 128) % 64), tensor = (int)(gid / 8192);
    p.w2t[gid] = to_act(p.cmp_w2[((size_t)tensor * 128 + e) * 64 + d]);
}
DEV void cmpA_store(act_t* dst, const float* src) {
    typedef float f32x4 __attribute__((ext_vector_type(4))); typedef unsigned u32x4 __attribute__((ext_vector_type(4)));
    const f32x4 a = *(const f32x4*)src, b = *(const f32x4*)(src + 4);
    u32x4 o; o[0] = pkbf(a[0], a[1]); o[1] = pkbf(a[2], a[3]);
    o[2] = pkbf(b[0], b[1]); o[3] = pkbf(b[2], b[3]);
    *(u32x4*)dst = o;
}
DEV void b_cmpA_s(const P& p, long gid) {
    const int q = (int)(gid % 128), cidx = (int)((gid / 128) % NCH_S), h = (int)((gid / (128L * NCH_S)) % 2), b = (int)((gid / (256L * NCH_S)) % DB), tensor = (int)(gid / (256L * NCH_S * DB));
    const int T = 16 * cidx + (q >> 3);
    const float* src = p.cache_kv + ((((size_t)p.page_table[b * NPAGES + T / PAGE] * PAGE + T % PAGE) * 4 + tensor) * 128) + h * 64 + (q & 7) * 8;
    cmpA_store(p.cas + ((size_t)tensor * CROWS_S + (size_t)(b * 2 + h) * NCH_S + cidx) * 1024 + q * 8, src);
}
DEV void b_cmpA_p(const P& p, long gid) {
    const int q = (int)(gid % 128), cidx = (int)((gid / 128) % NCH_P), h = (int)((gid / (128L * NCH_P)) % 2), b = (int)((gid / (256L * NCH_P)) % BATCH), tensor = (int)(gid / (256L * NCH_P * BATCH));
    const int T = 16 * cidx + (q >> 3);
#ifdef CPU_EMU
    const float* src = p.proj + (size_t)(b * SEQ + T) * PROJ + C_KVP + tensor * 128 + h * 64 + (q & 7) * 8;
    cmpA_store(p.cap + ((size_t)tensor * CROWS_P + (size_t)(b * 2 + h) * NCH_P + cidx) * 1024 + q * 8, src);
#else
    typedef unsigned u32x4 __attribute__((ext_vector_type(4)));
    *(u32x4*)(p.cap + ((size_t)tensor * CROWS_P + (size_t)(b * 2 + h) * NCH_P + cidx) * 1024 + q * 8) = *(const u32x4*)(p.kvb + (size_t)(b * SEQ + T) * 512 + tensor * 128 + h * 64 + (q & 7) * 8);
#endif
}

DEV void g_out_winp(const P& p, long gid) {
    typedef float f32x4 __attribute__((ext_vector_type(4)));
    const int c = (int)(gid % 64) * 4, r = (int)((gid / 64) % WBP), b = (int)(gid / (64 * WBP));
    *(f32x4*)(p.o_winp + gid * 4) = *(const f32x4*)(p.kvwf + (size_t)(b * SEQ + SEQ - WBP + r) * 256 + c);
}
DEV void g_out_wins(const P& p, long gid) {
    typedef float f32x4 __attribute__((ext_vector_type(4)));
    const int c = (int)(gid % 64) * 4, r = (int)((gid / 64) % WBS), b = (int)(gid / (64 * WBS));
    const int pr = DS + r;
    *(f32x4*)(p.o_wins + gid * 4) = pr < WBS ? *(const f32x4*)(p.cache_win + ((size_t)b * WBS + pr) * 256 + c) : *(const f32x4*)(p.kvwf + (size_t)(TOKP + b * DS + pr - WBS) * 256 + c);
}
DEV void g_out_conv(const P& p, long gid) {
    const int c = (int)(gid % 1024), j = (int)((gid / 1024) % 3), sq = (int)(gid / 3072);
    (void)c; (void)j; (void)sq;
}
DEV void b_cmp_attn_s(const P& p, long gid) { b_cmp_attn(p, (gid / TOKS) * TOK + TOKP + gid % TOKS); }
DEV void b_imp_s(const P& p, long gid) { b_imp(p, (long)TOKP * 2 * NSB_MAX + gid); }
DEV void b_topk_s(const P& p, long gid) { b_topk(p, (long)TOKP * 2 + gid); }
DEV void b_sel_win_s(const P& p, long gid) { b_sel_win(p, (gid / TOKS) * TOK + TOKP + gid % TOKS); }

#ifndef CPU_EMU
#define XB_TMO      128
#define XB_XCNT(j)  (256  + 64 * (j))
#define XB_XSUB(j)  (1280 + 64 * (j))
#define XB_XGEN(j)  (2304 + 64 * (j))
#define XB_TOP      3328
#define XB_TOPGEN   3392
#define XCD_BAR_WORDS 3456
constexpr int CMPS_CNT_WORD = 3584, WS_ZERO_BYTES = 16384;
#define XB_SPIN_CAP (1u << 22)
#define LAS __attribute__((address_space(3)))
__device__ __forceinline__ unsigned xb_ld(unsigned* p)              { return __hip_atomic_load(p, __ATOMIC_RELAXED, __HIP_MEMORY_SCOPE_AGENT); }
__device__ __forceinline__ unsigned xb_add(unsigned* p, unsigned v) { return __hip_atomic_fetch_add(p, v, __ATOMIC_RELAXED, __HIP_MEMORY_SCOPE_AGENT); }
__device__ __forceinline__ unsigned xb_xcc_id() { return (unsigned)__builtin_amdgcn_s_getreg((3 << 11) | 20) & 0xFu; }
#define XB_SPIN(cond, bar) do { unsigned _sp = 0; while (cond) { __builtin_amdgcn_s_sleep(1); \
    if ((++_sp & 255u) == 0u) { if (xb_ld(&(bar)[XB_TMO])) break; if (_sp > XB_SPIN_CAP) { atomicAdd(&(bar)[XB_TMO], 1u); break; } } } } while (0)
struct XcdBarrier { unsigned* bar; unsigned x; volatile LAS unsigned* st; };
__device__ __forceinline__ XcdBarrier xcd_barrier_post(unsigned* bar, volatile LAS unsigned* st) {
    XcdBarrier b; b.bar = bar; b.x = xb_xcc_id(); b.st = st;
    if (threadIdx.x == 0) (void)xb_add(&bar[XB_XCNT(b.x)], 1u);
    return b;
}
__device__ __forceinline__ void xcd_barrier_complete(unsigned* bar, unsigned x, unsigned& nloc, unsigned& nx) {
    const unsigned G = gridDim.x * gridDim.y * gridDim.z;
    unsigned sum, cnt, mine, sp = 0u;
    for (;;) {
        sum = 0u; cnt = 0u; mine = 0u;
#pragma unroll
        for (unsigned j = 0; j < 16; ++j) { const unsigned c = xb_ld(&bar[XB_XCNT(j)]); sum += c; cnt += (c > 0u) ? 1u : 0u; mine = (j == x) ? c : mine; }
        if (sum == G) break;
        __builtin_amdgcn_s_sleep(1);
        if ((++sp & 255u) == 0u) { if (xb_ld(&bar[XB_TMO])) break; if (sp > XB_SPIN_CAP) { atomicAdd(&bar[XB_TMO], 1u); break; } }
    }
    nloc = mine > 0u ? mine : 1u; nx = cnt > 0u ? cnt : 1u;
}
__device__ __forceinline__ void xcd_barrier(const XcdBarrier& b) {
    asm volatile("s_waitcnt vmcnt(0)" ::: "memory");
    __syncthreads();
    if (threadIdx.x == 0) {
        unsigned* bar = b.bar;
        __builtin_amdgcn_s_waitcnt(0);
        unsigned nloc = b.st[0], nx = b.st[1];
        if (nloc == 0u) { xcd_barrier_complete(bar, b.x, nloc, nx); b.st[0] = nloc; b.st[1] = nx; }
        const unsigned old = xb_add(&bar[XB_XSUB(b.x)], 1u);
        const unsigned gen = old / nloc;
        if (old + 1u == (gen + 1u) * nloc) {
            __builtin_amdgcn_fence(__ATOMIC_RELEASE, "agent");
            asm volatile("s_waitcnt vmcnt(0)" ::: "memory");
            const unsigned og = xb_add(&bar[XB_TOP], 1u);
            const unsigned tg = og / nx;
            if (og + 1u == (tg + 1u) * nx) xb_add(&bar[XB_TOPGEN], 1u);
            else XB_SPIN(xb_ld(&bar[XB_TOPGEN]) == tg, bar);
            __builtin_amdgcn_fence(__ATOMIC_ACQUIRE, "agent");
            xb_add(&bar[XB_XGEN(b.x)], 1u);
            asm volatile("s_waitcnt vmcnt(0)" ::: "memory");
        } else {
            XB_SPIN(xb_ld(&bar[XB_XGEN(b.x)]) == gen, bar);
            __builtin_amdgcn_fence(__ATOMIC_ACQUIRE, "agent");
            asm volatile("s_waitcnt vmcnt(0)" ::: "memory");
        }
    }
    __syncthreads();
}

DEV int fresh_tid() { int t = threadIdx.x; asm volatile("" : "+v"(t)); return t; }
namespace pg8 {
#define PG8_LAS __attribute__((address_space(3)))
typedef unsigned short bf16_t;
typedef short bf16x8 __attribute__((ext_vector_type(8)));
typedef float f32x4 __attribute__((ext_vector_type(4)));
constexpr int BM = 256, BK = 64, HALF = 128, HTB = HALF * BK * 2, STAGE_BYTES = 8 * HTB, NXCD = 8, WGM = 8;
__host__ __device__ __forceinline__ int lds_byte(int r, int c) { const int st = (r >> 4) * 2 + (c >> 5), rr = r & 15, cc = c & 31, ob = rr * 64 + cc * 2; return st * 1024 + (ob ^ (((ob >> 9) & 1) << 5)); }
__host__ __device__ __forceinline__ void stage_rc(int b, int& R, int& C) { const int st = b / 1024, sb = b % 1024, swz = sb ^ (((sb >> 9) & 1) << 5); R = (st >> 1) * 16 + swz / 64; C = (st & 1) * 32 + (swz % 64) / 2; }
__host__ __device__ __forceinline__ int perm32(int rho) { const int n = rho >> 4, i = rho & 15; return 8 * (i >> 2) + 4 * n + (i & 3); }
struct Unit { int pm, pn; };
struct Gemm { const bf16_t* A; const bf16_t* Bt; int M, N, K; int ld = 0; };
struct StaticOrder {
    int nM, nN, nwg, G, c;
    __host__ __device__ void init(int M, int N, int G_, int c_) { nM = M / BM; nN = N / BM; nwg = nM * nN; G = G_; c = c_; }
    __host__ __device__ bool next(int i, Unit& u) const {
        const long L = (long)i * G + c; if (L >= nwg) return false;
        int wgid = (int)L; { const int q = nwg / NXCD, r = nwg % NXCD, xcd = wgid % NXCD, off = wgid / NXCD; wgid = (xcd < r ? xcd * (q + 1) : r * (q + 1) + (xcd - r) * q) + off; }
        const int nig = WGM * nN, gid = wgid / nig, fm = gid * WGM, gsz = (nM - fm) < WGM ? (nM - fm) : WGM;
        u.pm = fm + ((wgid % nig) % gsz); u.pn = (wgid % nig) / gsz; return true;
    }
    __device__ __forceinline__ void a_ready(const Unit&) const {}
    __device__ __forceinline__ void done(const Unit&) const {}
};
struct EpiF32 {
    static constexpr bool PERM = false, AFTER_DRAIN = false;
    float* C; int ldc; const float* bias; int ncols;
    __device__ __forceinline__ void operator()(const f32x4 (&acc)[2][2][4][2], const Unit& u, int wr, int wc, int fr, int fq) const {
        const int row0 = u.pm * BM + wr * 64 + fr, col0 = u.pn * BM + wc * 32 + 4 * fq;
        f32x4 bv[2][2];
#pragma unroll
        for (int bj = 0; bj < 2; ++bj)
#pragma unroll
            for (int n = 0; n < 2; ++n) { const int c = col0 + bj * HALF + n * 16; bv[bj][n] = (bias && c < ncols) ? *(const f32x4*)(bias + c) : (f32x4){0.f, 0.f, 0.f, 0.f}; }
#pragma unroll
        for (int ai = 0; ai < 2; ++ai)
#pragma unroll
            for (int m = 0; m < 4; ++m) { float* rowp = C + (size_t)(row0 + ai * HALF + m * 16) * ldc + col0;
#pragma unroll
                for (int bj = 0; bj < 2; ++bj)
#pragma unroll
                    for (int n = 0; n < 2; ++n) if (col0 + bj * HALF + n * 16 < ncols) *(f32x4*)(rowp + bj * HALF + n * 16) = acc[ai][bj][m][n] + bv[bj][n]; }
    }
};
__host__ __device__ __forceinline__ int remap_in(int n) { return n < 1280 ? n : n < 1304 ? n + 2048 : n < 2840 ? n - 24 : n < 2848 ? n + 512 : n - 32; }
struct EpiProj {
    static constexpr bool PERM = true, AFTER_DRAIN = false;
    const float* bias; bf16_t *qb, *kvb, *kwb, *mqkb, *mvb, *mob; float *okvp, *okvs, *kvwf, *gatef, *mif, *oconvp, *oconvs; float qscale;
    __device__ __forceinline__ static void st8b(bf16_t* d, f32x4 a, f32x4 b) { typedef unsigned u32x4 __attribute__((ext_vector_type(4))); u32x4 o;
        o[0] = pkbf(a[0], a[1]); o[1] = pkbf(a[2], a[3]);
        o[2] = pkbf(b[0], b[1]); o[3] = pkbf(b[2], b[3]); *(u32x4*)d = o; }
    __device__ __forceinline__ static void st8f(float* d, f32x4 a, f32x4 b) { *(f32x4*)d = a; *(f32x4*)(d + 4) = b; }
    __device__ __forceinline__ void operator()(const f32x4 (&acc)[2][2][4][2], const Unit& u, int wr, int wc, int fr, int fq) const {
        static_assert(TOKP % BM == 0 && SEQ % BM == 0 && WBP % BM == 0 && WBP >= 3, "EpiProj panel tests");
        const unsigned row0 = (unsigned)(u.pm * BM + wr * 64 + fr); const int cl = wc * 32 + 8 * fq, pn = u.pn;
        const bool sp = u.pm * BM >= TOKP, winp = sp || ((u.pm * BM) % SEQ) >= SEQ - WBP, convp = sp || ((u.pm * BM) % SEQ) == SEQ - BM;
#define EP_LOOP(BJ, DELTA, ...) { const int c = pn * BM + (BJ) * HALF + cl; const f32x4 b0 = *(const f32x4*)(bias + c + (DELTA)), b1 = *(const f32x4*)(bias + c + (DELTA) + 4); \
        _Pragma("unroll") for (int ai = 0; ai < 2; ++ai) _Pragma("unroll") for (int m = 0; m < 4; ++m) { const unsigned r = row0 + ai * HALF + m * 16; const f32x4 v0 = acc[ai][BJ][m][0] + b0, v1 = acc[ai][BJ][m][1] + b1; __VA_ARGS__ } }
        if (pn < 2) {
            EP_LOOP(0, 0, st8b(qb + (size_t)r * 512 + c, v0 * qscale, v1 * qscale);) EP_LOOP(1, 0, st8b(qb + (size_t)r * 512 + c, v0 * qscale, v1 * qscale);)
        } else if (pn < 4) {
            float* okv = sp ? okvs - (size_t)TOKP * 512 : okvp;
            const bool hb0 = !sp, hb1 = !sp && pn == 2;
            EP_LOOP(0, 0, st8f(okv + (size_t)r * 512 + (c - 512), v0, v1); if (hb0) st8b(kvb + (size_t)r * 512 + (c - 512), v0, v1);)
            EP_LOOP(1, 0, st8f(okv + (size_t)r * 512 + (c - 512), v0, v1); if (hb1) st8b(kvb + (size_t)r * 512 + (c - 512), v0, v1);)
        } else if (pn == 4) {
            EP_LOOP(0, 0, if (!sp) st8b(kwb + (size_t)r * 256 + (c - 1024), v0, v1); if (winp) st8f(kvwf + (size_t)r * 256 + (c - 1024), v0, v1);)
            EP_LOOP(1, 0, st8f(kvwf + (size_t)r * 256 + (c - 1024), v0, v1);)
        } else if (pn < 9) {
#define EP_MQK(BJ) EP_LOOP(BJ, 24, st8b(mqkb + (size_t)r * 1024 + (c - 1280), v0, v1); \
            if (convp) { const int ri = (int)r; const int len = sp ? DS : SEQ, loc = sp ? (ri - TOKP) % DS : ri % SEQ, sq = sp ? (ri - TOKP) / DS : ri / SEQ;     \
                if (loc >= len - 3) st8f((sp ? oconvs : oconvp) + ((size_t)sq * 3 + (loc - (len - 3))) * 1024 + (c - 1280), v0, v1); })
            EP_MQK(0) EP_MQK(1)
#undef EP_MQK
        } else if (pn < 11) {
            EP_LOOP(0, 24, st8b(mvb + (size_t)r * 512 + (c - 2304), v0, v1);) EP_LOOP(1, 24, st8b(mvb + (size_t)r * 512 + (c - 2304), v0, v1);)
        } else if (pn < 13) {
            EP_LOOP(0, 32, st8b(mob + (size_t)r * 512 + (c - 2816), v0, v1);) EP_LOOP(1, 32, st8b(mob + (size_t)r * 512 + (c - 2816), v0, v1);)
        } else if (wc == 0) {
            const int dl = fq < 3 ? -2048 : -512;
            EP_LOOP(0, dl, st8f(fq < 3 ? gatef + (size_t)r * 32 + (c - 3328) : mif + (size_t)r * 8, v0, v1);)
        }
#undef EP_LOOP
    }
};
struct EpiB16 {
    static constexpr bool PERM = true, AFTER_DRAIN = false;
    bf16_t* O; int ldo;
    __device__ __forceinline__ void operator()(const f32x4 (&acc)[2][2][4][2], const Unit& u, int wr, int wc, int fr, int fq) const {
        const int row0 = u.pm * BM + wr * 64 + fr, col0 = u.pn * BM + wc * 32 + 8 * fq;
#pragma unroll
        for (int ai = 0; ai < 2; ++ai)
#pragma unroll
            for (int m = 0; m < 4; ++m) { bf16_t* rowp = O + (size_t)(row0 + ai * HALF + m * 16) * ldo + col0;
#pragma unroll
                for (int bj = 0; bj < 2; ++bj) { const f32x4 a = acc[ai][bj][m][0], b = acc[ai][bj][m][1]; typedef unsigned u32x4 __attribute__((ext_vector_type(4))); u32x4 o;
                    o[0] = pkbf(a[0], a[1]); o[1] = pkbf(a[2], a[3]);
                    o[2] = pkbf(b[0], b[1]); o[3] = pkbf(b[2], b[3]);
                    *(u32x4*)(rowp + bj * HALF) = o; }
            }
    }
};
struct EpiSwiglu {
    static constexpr bool PERM = true, AFTER_DRAIN = false;
    bf16_t* O; int ldo;
    __device__ __forceinline__ void operator()(const f32x4 (&acc)[2][2][4][2], const Unit& u, int wr, int wc, int fr, int fq) const {
        const int row0 = u.pm * BM + wr * 64 + fr, col0 = u.pn * HALF + wc * 32 + 8 * fq;
#pragma unroll
        for (int ai = 0; ai < 2; ++ai)
#pragma unroll
            for (int m = 0; m < 4; ++m) {
                float a[8];
#pragma unroll
                for (int n = 0; n < 2; ++n)
#pragma unroll
                    for (int e = 0; e < 4; ++e) { const float g = acc[ai][0][m][n][e]; a[4 * n + e] = g * fsigmoid_(g) * acc[ai][1][m][n][e]; }
                typedef unsigned u32x4 __attribute__((ext_vector_type(4))); u32x4 o;
#pragma unroll
                for (int e = 0; e < 4; ++e) o[e] = pkbf(a[2 * e], a[2 * e + 1]);
                *(u32x4*)(O + (size_t)(row0 + ai * HALF + m * 16) * ldo + col0) = o;
            }
    }
};
template <class Epi, class Sched>
__device__ __forceinline__ void gemm_phase(PG8_LAS unsigned char* lds, const Gemm g, const Sched& S, const Epi& E) {
    const int tid = fresh_tid(), wid = __builtin_amdgcn_readfirstlane(tid >> 6), lane = tid & 63, wr = wid >> 2, wc = wid & 3, fr = lane & 15, fq = lane >> 4;
    const int K = g.K, nt = K / BK, ld = g.ld ? g.ld : K;
    unsigned voffA[2], voffB[2];
#pragma unroll
    for (int i = 0; i < 2; ++i) { int R, C; stage_rc(tid * 16 + i * 8192, R, C); const int Rb = Epi::PERM ? ((R & ~31) + perm32(R & 31)) : R;
        voffA[i] = (unsigned)(R * ld + C) * 2u; voffB[i] = (unsigned)(Rb * ld + C) * 2u; }
    const size_t kstep = (size_t)(BK * 2);
    const size_t hstep = (size_t)HALF * ld * 2;
    const size_t tstep = 2 * hstep;
    const unsigned ldsw = (unsigned)wid * 1024u;
    const int aoff = lds_byte(wr * 64 + fr, fq * 8), boff = lds_byte(wc * 32 + fr, fq * 8);
#define PG8_SA(b, h) (((b) * 2 + (h)) * HTB)
#define PG8_SB(b, h) ((4 + (b) * 2 + (h)) * HTB)
#define PG8_STAGE(bufoff, gbase, voff) do { _Pragma("unroll") for (int _i = 0; _i < 2; ++_i) \
        __builtin_amdgcn_global_load_lds((const unsigned*)((const char*)(gbase) + (voff)[_i]), (PG8_LAS unsigned*)(lds + (bufoff) + ldsw + _i * 8192), 16, 0, 0); } while (0)
#define PG8_LDA(dst, b, h) do { _Pragma("unroll") for (int m = 0; m < 4; ++m) _Pragma("unroll") for (int k = 0; k < 2; ++k) dst[m][k] = *(const PG8_LAS bf16x8*)(lds + PG8_SA(b, h) + aoff + m * 2048 + k * 1024); } while (0)
#define PG8_LDB(dst, b, h) do { _Pragma("unroll") for (int n = 0; n < 2; ++n) _Pragma("unroll") for (int k = 0; k < 2; ++k) dst[n][k] = *(const PG8_LAS bf16x8*)(lds + PG8_SB(b, h) + boff + n * 2048 + k * 1024); } while (0)
#define PG8_MMA(ai, bj, At, Bt) do { __builtin_amdgcn_s_setprio(1); _Pragma("unroll") for (int m = 0; m < 4; ++m) _Pragma("unroll") for (int n = 0; n < 2; ++n) _Pragma("unroll") for (int k = 0; k < 2; ++k) \
        acc[ai][bj][m][n] = __builtin_amdgcn_mfma_f32_16x16x32_bf16(Bt[n][k], At[m][k], acc[ai][bj][m][n], 0, 0, 0); __builtin_amdgcn_s_setprio(0); } while (0)
#define PG8_WAIT_V(n) asm volatile("s_waitcnt vmcnt(" #n ")" ::: "memory")
#define PG8_WAIT_L(n) asm volatile("s_waitcnt lgkmcnt(" #n ")" ::: "memory")
#define PG8_BAR __builtin_amdgcn_s_barrier()
#define PG8_SCHED __builtin_amdgcn_sched_barrier(0)
    Unit cur, nxt; int ui = 0;
    if (!S.next(0, cur)) return;
    f32x4 acc[2][2][4][2];
#pragma unroll
    for (int a = 0; a < 2; ++a)
#pragma unroll
        for (int b = 0; b < 2; ++b)
#pragma unroll
            for (int m = 0; m < 4; ++m)
#pragma unroll
                for (int n = 0; n < 2; ++n) acc[a][b][m][n] = (f32x4){0.f, 0.f, 0.f, 0.f};
    bf16x8 At[4][2], B0[2][2], B1[2][2];
    const char* cA = (const char*)g.A + (size_t)cur.pm * tstep; const char* cB = (const char*)g.Bt + (size_t)cur.pn * tstep;
    S.a_ready(cur);
    PG8_STAGE(PG8_SB(0, 0), cB, voffB); PG8_STAGE(PG8_SA(0, 0), cA, voffA); PG8_STAGE(PG8_SB(0, 1), cB + hstep, voffB); PG8_STAGE(PG8_SA(0, 1), cA + hstep, voffA);
    if (wr == 1) PG8_BAR;
    PG8_WAIT_V(4); PG8_BAR;
    PG8_STAGE(PG8_SB(1, 0), cB + kstep, voffB); PG8_STAGE(PG8_SA(1, 0), cA + kstep, voffA); PG8_STAGE(PG8_SB(1, 1), cB + hstep + kstep, voffB);
    PG8_WAIT_V(6); PG8_BAR;
    for (;;) {
        const bool has_next = S.next(ui + 1, nxt);
        const char* nA = has_next ? (const char*)g.A + (size_t)nxt.pm * tstep : cA; const char* nB = has_next ? (const char*)g.Bt + (size_t)nxt.pn * tstep : cB;
        for (int t = 0; t < nt; t += 2) {
            const bool last = (t == nt - 2);
            const char* a1 = cA + (size_t)(t + 1) * kstep;
            const char* a2 = last ? nA : cA + (size_t)(t + 2) * kstep; const char* b2 = last ? nB : cB + (size_t)(t + 2) * kstep;
            const char* a3 = a2 + kstep; const char* b3 = b2 + kstep;
            if (last && has_next) S.a_ready(nxt);
            PG8_LDB(B0, 0, 0); PG8_SCHED; PG8_LDA(At, 0, 0); PG8_STAGE(PG8_SA(1, 1), a1 + hstep, voffA);
            PG8_WAIT_L(8); PG8_BAR; PG8_WAIT_L(0); PG8_MMA(0, 0, At, B0); PG8_BAR; PG8_SCHED;
            PG8_LDB(B1, 0, 1); PG8_STAGE(PG8_SB(0, 0), b2, voffB);
            PG8_BAR; PG8_WAIT_L(0); PG8_MMA(0, 1, At, B1); PG8_BAR;
            PG8_LDA(At, 0, 1); PG8_STAGE(PG8_SA(0, 0), a2, voffA);
            PG8_BAR; PG8_WAIT_L(0); PG8_MMA(1, 0, At, B0); PG8_BAR; PG8_SCHED;
            PG8_STAGE(PG8_SB(0, 1), b2 + hstep, voffB);
            PG8_WAIT_V(6); PG8_BAR; PG8_MMA(1, 1, At, B1); PG8_BAR;
            PG8_LDB(B0, 1, 0); PG8_SCHED; PG8_LDA(At, 1, 0); PG8_STAGE(PG8_SA(0, 1), a2 + hstep, voffA);
            PG8_WAIT_L(8); PG8_BAR; PG8_WAIT_L(0); PG8_MMA(0, 0, At, B0); PG8_BAR; PG8_SCHED;
            PG8_LDB(B1, 1, 1); PG8_STAGE(PG8_SB(1, 0), b3, voffB);
            PG8_BAR; PG8_WAIT_L(0); PG8_MMA(0, 1, At, B1); PG8_BAR;
            PG8_LDA(At, 1, 1); PG8_STAGE(PG8_SA(1, 0), a3, voffA);
            PG8_BAR; PG8_WAIT_L(0); PG8_MMA(1, 0, At, B0); PG8_BAR; PG8_SCHED;
            PG8_STAGE(PG8_SB(1, 1), b3 + hstep, voffB);
            PG8_WAIT_V(6); PG8_BAR; PG8_MMA(1, 1, At, B1); PG8_BAR;
        }
        E(acc, cur, wr, wc, fr, fq); S.done(cur);
        if (!has_next) break;
#pragma unroll
        for (int a = 0; a < 2; ++a)
#pragma unroll
            for (int b = 0; b < 2; ++b)
#pragma unroll
                for (int m = 0; m < 4; ++m)
#pragma unroll
                    for (int n = 0; n < 2; ++n) acc[a][b][m][n] = (f32x4){0.f, 0.f, 0.f, 0.f};
        cur = nxt; cA = nA; cB = nB; ++ui;
    }
    PG8_WAIT_V(0);
    if (wr == 0) PG8_BAR;
    PG8_BAR;
#undef PG8_SA
#undef PG8_SB
#undef PG8_STAGE
#undef PG8_LDA
#undef PG8_LDB
#undef PG8_MMA
#undef PG8_WAIT_V
#undef PG8_WAIT_L
#undef PG8_BAR
#undef PG8_SCHED
}
}


constexpr int NTHR_ = 512;
namespace att {
typedef short bf16x8 __attribute__((ext_vector_type(8)));
typedef float f32x16 __attribute__((ext_vector_type(16)));
typedef __bf16 bf16v2 __attribute__((ext_vector_type(2)));
typedef float f32v2 __attribute__((ext_vector_type(2)));
constexpr int PADF = 64, TS = PADF + 1024, TW = PADF + 512 + 64;
constexpr int IMPS = 129;
constexpr int L_TAB = 0, L_TABW = 17408, L_IMP = 27648, L_MASK = 60672, L_K = 61696, L_V = 78080, L_ML = 94464;
#define MFMA32(a, b, c) __builtin_amdgcn_mfma_f32_32x32x16_bf16((a), (b), (c), 0, 0, 0)
DEV unsigned pk2(float lo, float hi) { f32v2 v = {lo, hi}; bf16v2 r = __builtin_convertvector(v, bf16v2); return __builtin_bit_cast(unsigned, r); }
DEV bf16x8 pack8(const f32x16& x, int s) {
    typedef unsigned u32x4 __attribute__((ext_vector_type(4)));
    u32x4 q; q[0] = pk2(x[8 * s], x[8 * s + 1]); q[1] = pk2(x[8 * s + 2], x[8 * s + 3]); q[2] = pk2(x[8 * s + 4], x[8 * s + 5]); q[3] = pk2(x[8 * s + 6], x[8 * s + 7]);
    return __builtin_bit_cast(bf16x8, q);
}
DEV float xmax32(float x) { const auto r = __builtin_amdgcn_permlane32_swap(__float_as_uint(x), __float_as_uint(x), false, false); return fmaxf(__uint_as_float(r[0]), __uint_as_float(r[1])); }
constexpr float DEFER_THR = 8.0f;
struct Ctx {
    PG8_LAS unsigned char* lds; int tid, lane, l32, h, g, half, xr; int t, t0, tok; bf16x8 qf[4];
};
struct Acc { f32x16 o0, o1; float m, l; };
DEV void acc_init(Acc& a) {
#pragma unroll
    for (int i = 0; i < 16; ++i) { a.o0[i] = 0.f; a.o1[i] = 0.f; }
    a.m = -1e30f; a.l = 0.f;
}
typedef unsigned u32x4 __attribute__((ext_vector_type(4)));
DEV u32x4 tile_load(const act_t* base, size_t row_stride, int tid) { const int row = tid >> 3, ch = tid & 7; return *(const u32x4*)(base + (size_t)row * row_stride + ch * 8); }
DEV void tile_store(PG8_LAS unsigned char* buf, u32x4 v, int tid) { const int row = tid >> 3, ch = tid & 7; *(PG8_LAS u32x4*)(buf + row * 128 + ((ch ^ (row & 7)) << 4)) = v; }
DEV bf16x8 frag(const PG8_LAS unsigned char* buf, int row, int ch, int xr) { return *(const PG8_LAS bf16x8*)(buf + row * 128 + ((ch ^ xr) << 4)); }

template <int MODE>
DEV void attend(const Ctx& c, Acc& a, const act_t* Kb, size_t kstride, const act_t* Vtb, size_t vstride, int jlo, int jhi, int jd, unsigned m0, unsigned m1, unsigned m2, unsigned m3, float mfin, float invl) {
    PG8_LAS unsigned char* lds = c.lds;
    const PG8_LAS float* tab = (MODE == 3) ? (const PG8_LAS float*)(lds + L_TABW) + c.g * TW : (const PG8_LAS float*)(lds + L_TAB) + c.g * TS;
    u32x4 kreg = tile_load(Kb + (size_t)jlo * 64 * kstride, kstride, c.tid), vreg = {0u, 0u, 0u, 0u};
    if (MODE != 0) vreg = tile_load(Vtb + (size_t)jlo * 64, vstride, c.tid);
    tile_store(lds + L_K, kreg, c.tid); if (MODE != 0) tile_store(lds + L_V, vreg, c.tid);
    __syncthreads();
    int cur = 0;
    for (int j = jlo; j <= jhi; ++j) {
        const bool more = j < jhi;
        if (more) { kreg = tile_load(Kb + (size_t)(j + 1) * 64 * kstride, kstride, c.tid); if (MODE != 0) vreg = tile_load(Vtb + (size_t)(j + 1) * 64, vstride, c.tid); }
        const PG8_LAS unsigned char* kb = lds + L_K + cur * 8192; const PG8_LAS unsigned char* vb = lds + L_V + cur * 8192;
        f32x16 s0, s1;
#pragma unroll
        for (int i = 0; i < 16; ++i) { s0[i] = 0.f; s1[i] = 0.f; }
#pragma unroll
        for (int ks = 0; ks < 4; ++ks) { s0 = MFMA32(frag(kb, c.l32, 2 * ks + c.h, c.xr), c.qf[ks], s0); s1 = MFMA32(frag(kb, 32 + c.l32, 2 * ks + c.h, c.xr), c.qf[ks], s1); }
        bool sel = true;
        if (MODE == 2) { const unsigned w = (j < 32) ? m0 : (j < 64) ? m1 : (j < 96) ? m2 : m3; sel = (w >> (j & 31)) & 1u; }
        const bool far = (MODE == 2) ? (64 * j <= c.t0 - 853) : (MODE <= 1) ? (16 * (64 * j + 63) + 31 + 790 <= c.t0) : false;
        float cf = 0.f;
        if (far) cf = tab[PADF + 1023];
        else if (MODE >= 2) {
            const PG8_LAS float* tp = tab + (PADF + c.t - j * 64 - 4 * c.h);
            float tb[32];
#pragma unroll
            for (int i = 0; i < 32; ++i) tb[i] = tp[-((i >> 4) * 32 + (i & 3) + 8 * ((i & 15) >> 2))];
#pragma unroll
            for (int i = 0; i < 16; ++i) { s0[i] += tb[i]; s1[i] += tb[16 + i]; }
        } else {
#pragma unroll
            for (int kt = 0; kt < 2; ++kt)
#pragma unroll
                for (int i = 0; i < 16; ++i) {
                    const int kidx = j * 64 + kt * 32 + (i & 3) + 8 * (i >> 2) + 4 * c.h;
                    const int dist = c.t - 16 * kidx - 31;
                    const int ix = PADF + clampi3(dist, -1, 1023);
                    if (kt) s1[i] += tab[ix]; else s0[i] += tab[ix];
                }
        }
        if (MODE == 1) {
            const float mr = mfin - cf;
#pragma unroll
            for (int i = 0; i < 16; ++i) { s0[i] = __builtin_amdgcn_exp2f(s0[i] - mr) * invl; s1[i] = __builtin_amdgcn_exp2f(s1[i] - mr) * invl; }
            PG8_LAS float* imp = (PG8_LAS float*)(lds + L_IMP) + c.tok * IMPS;
#pragma unroll
            for (int kt = 0; kt < 2; ++kt)
#pragma unroll
                for (int i = 0; i < 4; ++i) {
                    const float p0 = kt ? s1[4 * i] : s0[4 * i], p1 = kt ? s1[4 * i + 1] : s0[4 * i + 1], p2 = kt ? s1[4 * i + 2] : s0[4 * i + 2], p3 = kt ? s1[4 * i + 3] : s0[4 * i + 3];
                    float gs = (p0 + p1) + (p2 + p3), ps = p3;
                    gs += __shfl_xor(gs, 8); ps += __shfl_xor(ps, 8); gs += __shfl_xor(gs, 16); ps += __shfl_xor(ps, 16);
                    const int jb = (j * 64 + kt * 32 + 8 * i + 4 * c.h) >> 2;
                    if (c.l32 < 8) { imp[jb] += gs; }
                    if (c.l32 < 8 && jb + 1 < 128) { imp[jb + 1] += ps; }
                }
        } else {
            float mx = s0[0];
#pragma unroll
            for (int i = 1; i < 16; ++i) mx = fmaxf(mx, s0[i]);
#pragma unroll
            for (int i = 0; i < 16; ++i) mx = fmaxf(mx, s1[i]);
            mx = xmax32(mx) + cf;
            if (MODE == 2 && !sel) mx = -INFINITY;
            const bool grow = mx > a.m + DEFER_THR;
            if (__any(grow)) {
                const float mn = grow ? mx : a.m, alpha = __builtin_amdgcn_exp2f(a.m - mn);
                a.m = mn; a.l *= alpha;
                if (MODE != 0) {
#pragma unroll
                    for (int i = 0; i < 16; ++i) { a.o0[i] *= alpha; a.o1[i] *= alpha; }
                }
            }
            const float mref = (MODE == 2 && !sel) ? 1e30f : a.m - cf;
            float ls = 0.f;
#pragma unroll
            for (int i = 0; i < 16; ++i) { s0[i] = __builtin_amdgcn_exp2f(s0[i] - mref); s1[i] = __builtin_amdgcn_exp2f(s1[i] - mref); ls += s0[i] + s1[i]; }
            a.l += ls;
        }
        if (MODE != 0) {
#pragma unroll
            for (int kt = 0; kt < 2; ++kt)
#pragma unroll
                for (int sp = 0; sp < 2; ++sp) {
                    const bf16x8 pf = pack8(kt ? s1 : s0, sp);
                    a.o0 = MFMA32(frag(vb, c.l32, kt * 4 + 2 * sp + c.h, c.xr), pf, a.o0);
                    a.o1 = MFMA32(frag(vb, 32 + c.l32, kt * 4 + 2 * sp + c.h, c.xr), pf, a.o1);
                }
        }
        if (more) { tile_store(lds + L_K + (cur ^ 1) * 8192, kreg, c.tid); if (MODE != 0) tile_store(lds + L_V + (cur ^ 1) * 8192, vreg, c.tid); }
        __syncthreads();
        cur ^= 1;
    }
}

DEV void topk_pair(PG8_LAS unsigned char* lds, int tokL, int jd, int lane) {
    const int hf = lane >> 5, l = lane & 31, tk = tokL + hf;
    const PG8_LAS float* imp = (const PG8_LAS float*)(lds + L_IMP) + tk * IMPS;
    PG8_LAS unsigned* mk = (PG8_LAS unsigned*)(lds + L_MASK) + tk * 4;
    const unsigned hsh = hf * 32;
    if (jd + 1 <= 16) { const unsigned bb = (unsigned)(__ballot(l <= jd) >> hsh); if (l == 0) { mk[0] = bb; mk[1] = 0u; mk[2] = 0u; mk[3] = 0u; } return; }
    unsigned v[4]; bool cd[4];
#pragma unroll
    for (int k = 0; k < 4; ++k) { const int j = l + 32 * k; cd[k] = j >= 1 && j < jd; v[k] = cd[k] ? __float_as_uint(imp[j]) : 0u; }
    const int K = 14; unsigned thr = 0u;
    for (int bit = 30; bit >= 0; --bit) {
        const unsigned cand = thr | (1u << bit); int cnt = 0;
#pragma unroll
        for (int k = 0; k < 4; ++k) cnt += __popc((unsigned)(__ballot(cd[k] && v[k] >= cand) >> hsh));
        if (cnt >= K) thr = cand;
    }
    int ngt = 0;
#pragma unroll
    for (int k = 0; k < 4; ++k) ngt += __popc((unsigned)(__ballot(cd[k] && v[k] > thr) >> hsh));
    const int need = K - ngt; const unsigned below = (1u << l) - 1u; int before = 0;
#pragma unroll
    for (int k = 0; k < 4; ++k) { const int j = l + 32 * k; const unsigned eq = (unsigned)(__ballot(cd[k] && v[k] == thr) >> hsh);
        const bool sl = (j == 0) || (j == jd) || (cd[k] && (v[k] > thr || (v[k] == thr && before + __popc(eq & below) < need)));
        before += __popc(eq);
        const unsigned bb = (unsigned)(__ballot(sl) >> hsh);
        if (l == 0) mk[k] = bb; }
}

DEV void topk_oct(PG8_LAS unsigned char* lds, int tok0, int jd, int lane) {
    const int hf = lane >> 5, l = lane & 31; const unsigned hsh = hf * 32;
    PG8_LAS unsigned* mk0 = (PG8_LAS unsigned*)(lds + L_MASK) + (tok0 + hf) * 4;
    if (jd + 1 <= 16) { const unsigned bb = (unsigned)(__ballot(l <= jd) >> hsh);
        if (l == 0) {
#pragma unroll
            for (int pr = 0; pr < 4; ++pr) { mk0[pr * 8] = bb; mk0[pr * 8 + 1] = 0u; mk0[pr * 8 + 2] = 0u; mk0[pr * 8 + 3] = 0u; } }
        return; }
    bool cd[4]; unsigned v[4][4];
#pragma unroll
    for (int k = 0; k < 4; ++k) { const int j = l + 32 * k; cd[k] = j >= 1 && j < jd; }
#pragma unroll
    for (int pr = 0; pr < 4; ++pr) { const PG8_LAS float* imp = (const PG8_LAS float*)(lds + L_IMP) + (tok0 + 2 * pr + hf) * IMPS;
#pragma unroll
        for (int k = 0; k < 4; ++k) v[pr][k] = cd[k] ? __float_as_uint(imp[l + 32 * k]) : 0u; }
    const int K = 14; unsigned thr[4] = {0u, 0u, 0u, 0u};
    for (int bit = 30; bit >= 0; --bit) {
#pragma unroll
        for (int pr = 0; pr < 4; ++pr) {
            const unsigned cand = thr[pr] | (1u << bit); int cnt = 0;
#pragma unroll
            for (int k = 0; k < 4; ++k) cnt += __popc((unsigned)(__ballot(cd[k] && v[pr][k] >= cand) >> hsh));
            if (cnt >= K) thr[pr] = cand;
        }
    }
#pragma unroll
    for (int pr = 0; pr < 4; ++pr) {
        int ngt = 0;
#pragma unroll
        for (int k = 0; k < 4; ++k) ngt += __popc((unsigned)(__ballot(cd[k] && v[pr][k] > thr[pr]) >> hsh));
        const int need = K - ngt; const unsigned below = (1u << l) - 1u; int before = 0;
#pragma unroll
        for (int k = 0; k < 4; ++k) { const int j = l + 32 * k; const unsigned eq = (unsigned)(__ballot(cd[k] && v[pr][k] == thr[pr]) >> hsh);
            const bool sl = (j == 0) || (j == jd) || (cd[k] && (v[pr][k] > thr[pr] || (v[pr][k] == thr[pr] && before + __popc(eq & below) < need)));
            before += __popc(eq);
            const unsigned bb = (unsigned)(__ballot(sl) >> hsh);
            if (l == 0) mk0[pr * 8 + k] = bb; }
    }
}

DEV void unit(const P& p, PG8_LAS unsigned char* lds, int b, int kvh, int tile, bool build_tab) {
    Ctx c; c.lds = lds; c.tid = fresh_tid(); c.lane = c.tid & 63; c.l32 = c.lane & 31; c.h = c.lane >> 5; c.xr = c.l32 & 7;
    const int wid = __builtin_amdgcn_readfirstlane(c.tid >> 6); c.g = wid & 3; c.half = wid >> 2;
    c.t0 = tile * 64; c.t = c.t0 + c.half * 32 + c.l32;
    const int head = kvh * 4 + c.g, jd = tile; const size_t row = (size_t)b * SEQ + c.t;
#pragma unroll
    for (int s = 0; s < 4; ++s) c.qf[s] = *(const bf16x8*)(p.qb + row * 512 + head * 64 + 16 * s + 8 * c.h);
    const float g0 = sigmoidf_(p.gatef[row * 32 + head * 3]), g1 = sigmoidf_(p.gatef[row * 32 + head * 3 + 1]), g2 = sigmoidf_(p.gatef[row * 32 + head * 3 + 2]);
    __syncthreads();
    if (build_tab) {
    for (int i = c.tid; i < 4 * TS; i += NTHR_) { const int gg = i / TS, dd = i % TS - PADF; ((PG8_LAS float*)(lds + L_TAB))[i] = dd < 0 ? -INFINITY : p.rel_bias[rel_bucket(dd) * 8 + kvh * 4 + gg] * LOG2E; }
    for (int i = c.tid; i < 4 * TW; i += NTHR_) { const int gg = i / TW, dd = i % TW - PADF; ((PG8_LAS float*)(lds + L_TABW))[i] = (dd < 0 || dd >= 512) ? -INFINITY : p.rel_bias[rel_bucket(dd) * 8 + kvh * 4 + gg] * LOG2E; }
    }
    for (int i = c.tid; i < 64 * IMPS; i += NTHR_) ((PG8_LAS float*)(lds + L_IMP))[i] = 0.f;
    __syncthreads();
    const size_t bh = (size_t)b * 2 + kvh;
    const act_t* Kc = p.kc + bh * NCPAD * 64; const act_t* Vct = p.vct + bh * 64 * NCPAD;
    const act_t* Ks = p.kvb + (size_t)b * SEQ * 512 + 256 + kvh * 64; const act_t* Vst = p.vst + bh * 64 * SEQ;
    const act_t* Kw = p.kwb + (size_t)b * SEQ * 256 + kvh * 64;       const act_t* Vwt = p.vwt + bh * 64 * SEQ;
    const int cjhi = ((c.t0 + 32) / 16) / 64;
    c.tok = c.half * 32 + c.l32;
    Acc a; acc_init(a);
    attend<0>(c, a, Kc, 64, Vct, NCPAD, 0, cjhi, jd, 0, 0, 0, 0, 0.f, 0.f);
    {
        const float lt0 = a.l + __shfl_xor(a.l, 32);
        PG8_LAS float* ml = (PG8_LAS float*)(lds + L_ML);
        if (c.h == 0) { ml[(c.tok * 4 + c.g) * 2] = a.m; ml[(c.tok * 4 + c.g) * 2 + 1] = lt0 > 0.f ? 1.0f / lt0 : 0.f; }
    }
    __syncthreads();
    typedef float f32x4 __attribute__((ext_vector_type(4)));
    {
        Ctx c2 = c; c2.g = c.l32 >> 3; c2.tok = wid * 8 + (c.l32 & 7); c2.t = c.t0 + c2.tok;
        const int head2 = kvh * 4 + c2.g; const size_t row2 = (size_t)b * SEQ + c2.t;
#pragma unroll
        for (int s2 = 0; s2 < 4; ++s2) c2.qf[s2] = *(const bf16x8*)(p.qb + row2 * 512 + head2 * 64 + 16 * s2 + 8 * c.h);
        const PG8_LAS float* ml = (const PG8_LAS float*)(lds + L_ML);
        const float mfin = ml[(c2.tok * 4 + c2.g) * 2], invl = ml[(c2.tok * 4 + c2.g) * 2 + 1];
        const float g0b = sigmoidf_(p.gatef[row2 * 32 + head2 * 3]);
        acc_init(a);
        attend<1>(c2, a, Kc, 64, Vct, NCPAD, 0, cjhi, jd, 0, 0, 0, 0, mfin, invl);
        float* tr2 = p.oc + row2 * 512 + head2 * 64 + 4 * c.h;
#pragma unroll
        for (int i = 0; i < 4; ++i) {
            *(f32x4*)(tr2 + 8 * i) = (f32x4){g0b * a.o0[4 * i], g0b * a.o0[4 * i + 1], g0b * a.o0[4 * i + 2], g0b * a.o0[4 * i + 3]};
            *(f32x4*)(tr2 + 32 + 8 * i) = (f32x4){g0b * a.o1[4 * i], g0b * a.o1[4 * i + 1], g0b * a.o1[4 * i + 2], g0b * a.o1[4 * i + 3]};
        }
        __builtin_amdgcn_fence(__ATOMIC_RELEASE, "workgroup");
    }
    float* trow = p.oc + row * 512 + head * 64 + 4 * c.h;
    float lt;
    topk_oct(lds, wid * 8, jd, c.lane);
    __syncthreads();
    const PG8_LAS unsigned* mk = (const PG8_LAS unsigned*)(lds + L_MASK) + (c.half * 32 + c.l32) * 4;
    const unsigned m0 = mk[0], m1 = mk[1], m2 = mk[2], m3 = mk[3];
    acc_init(a);
    attend<2>(c, a, Ks, 512, Vst, SEQ, 0, jd, jd, m0, m1, m2, m3, 0.f, 0.f);
    lt = a.l + __shfl_xor(a.l, 32);
    { const float sc = g1 / lt;
#pragma unroll
      for (int i = 0; i < 4; ++i) {
          f32x4 u = *(f32x4*)(trow + 8 * i), v = *(f32x4*)(trow + 32 + 8 * i);
#pragma unroll
          for (int r = 0; r < 4; ++r) { u[r] += sc * a.o0[4 * i + r]; v[r] += sc * a.o1[4 * i + r]; }
          *(f32x4*)(trow + 8 * i) = u; *(f32x4*)(trow + 32 + 8 * i) = v;
      } }
    acc_init(a);
    attend<3>(c, a, Kw, 256, Vwt, SEQ, jd >= 8 ? jd - 8 : 0, jd, jd, 0, 0, 0, 0, 0.f, 0.f);
    lt = a.l + __shfl_xor(a.l, 32);
    act_t* orow = p.mixb + row * 1024 + head * 64;
    { const float sc = g2 / lt;
      typedef unsigned u32x2 __attribute__((ext_vector_type(2)));
#pragma unroll
      for (int i = 0; i < 4; ++i) {
          f32x4 u = *(f32x4*)(trow + 8 * i), v = *(f32x4*)(trow + 32 + 8 * i);
#pragma unroll
          for (int r = 0; r < 4; ++r) { u[r] += sc * a.o0[4 * i + r]; v[r] += sc * a.o1[4 * i + r]; }
          u32x2 w0; w0[0] = pk2(u[0], u[1]); w0[1] = pk2(u[2], u[3]); *(u32x2*)(orow + 8 * i + 4 * c.h) = w0;
          u32x2 w1; w1[0] = pk2(v[0], v[1]); w1[1] = pk2(v[2], v[3]); *(u32x2*)(orow + 32 + 8 * i + 4 * c.h) = w1;
      } }
}
}


namespace atts {
using att::bf16x8; using att::f32x16; using att::Acc; using att::acc_init; using att::pack8; using att::pk2; using att::frag;
typedef float f32x4 __attribute__((ext_vector_type(4)));
typedef unsigned u32x4 __attribute__((ext_vector_type(4)));
constexpr int TABN = 856;
constexpr int L_TAB = 131088, L_MASK = L_TAB + 4 * TABN * 4;
constexpr int L_IMP = 0, IMPW = 321;
constexpr int L_XCH = 0;
static_assert(L_MASK + 8 * 12 * 4 <= 147440 && NSB_S <= 288 && NSB_S > 256 && NC_S + 1 == NCSPAD, "sample attention LDS map / shapes");
struct Cs { PG8_LAS unsigned char* lds; int lane, l32, h, xr, wid, i, g, t; const PG8_LAS float* tabp; const act_t* qp; };
DEV bf16x8 qfrag(const Cs& c, int ks) { return *(const bf16x8*)(c.qp + 16 * ks); }

template <int MODE>
DEV void smath(const Cs& c, Acc& a, f32x16& s0, f32x16& s1, int kbase, bool sel, float mfin, float invl) {
#pragma unroll
    for (int kt = 0; kt < 2; ++kt)
#pragma unroll
        for (int r = 0; r < 16; ++r) {
            const int kidx = kbase + kt * 32 + (r & 3) + 8 * (r >> 2) + 4 * c.h;
            const int dist = (MODE <= 1) ? c.t - 16 * kidx - 31 : c.t - kidx;
            int ix = clampi3(dist + 1, 0, TABN - 1);
            if (MODE == 3) ix = dist >= 512 ? 0 : ix;
            if (kt) s1[r] += c.tabp[ix]; else s0[r] += c.tabp[ix];
        }
    if (MODE == 1) {
#pragma unroll
        for (int r = 0; r < 16; ++r) { s0[r] = __builtin_amdgcn_exp2f(s0[r] - mfin) * invl; s1[r] = __builtin_amdgcn_exp2f(s1[r] - mfin) * invl; }
        return;
    }
    float mx = s0[0];
#pragma unroll
    for (int r = 1; r < 16; ++r) mx = fmaxf(mx, s0[r]);
#pragma unroll
    for (int r = 0; r < 16; ++r) mx = fmaxf(mx, s1[r]);
    mx = att::xmax32(mx);
    if (MODE == 2 && !sel) mx = -INFINITY;
    const bool grow = mx > a.m + att::DEFER_THR;
    if (__any(grow)) {
        const float mn = grow ? mx : a.m, alpha = __builtin_amdgcn_exp2f(a.m - mn);
        a.m = mn; a.l *= alpha;
        if (MODE != 0) {
#pragma unroll
            for (int r = 0; r < 16; ++r) { a.o0[r] *= alpha; a.o1[r] *= alpha; }
        }
    }
    const float mref = (MODE == 2 && !sel) ? 1e30f : a.m;
    float ls = 0.f;
#pragma unroll
    for (int r = 0; r < 16; ++r) { s0[r] = __builtin_amdgcn_exp2f(s0[r] - mref); s1[r] = __builtin_amdgcn_exp2f(s1[r] - mref); ls += s0[r] + s1[r]; }
    a.l += ls;
}
DEV void stage_rows(PG8_LAS unsigned char* kt_, PG8_LAS unsigned char* vt_, const float* krow0, const float* vrow0, const float* krow1, const float* vrow1, int l32, int hh) {
#pragma unroll
    for (int ps = 0; ps < 2; ++ps) {
        const float* kr = ps ? krow1 : krow0; const float* vr = ps ? vrow1 : vrow0; const int row = ps * 32 + l32;
        {
            f32x4 kv[8];
#pragma unroll
            for (int q = 0; q < 8; ++q) kv[q] = kr ? *(const f32x4*)(kr + hh * 32 + q * 4) : (f32x4){0.f, 0.f, 0.f, 0.f};
#pragma unroll
            for (int q = 0; q < 4; ++q) { u32x4 o; o[0] = pk2(kv[2 * q][0], kv[2 * q][1]); o[1] = pk2(kv[2 * q][2], kv[2 * q][3]); o[2] = pk2(kv[2 * q + 1][0], kv[2 * q + 1][1]); o[3] = pk2(kv[2 * q + 1][2], kv[2 * q + 1][3]);
                *(PG8_LAS u32x4*)(kt_ + row * 128 + (((hh * 4 + q) ^ (row & 7)) << 4)) = o; }
        }
        __builtin_amdgcn_sched_barrier(0);
        {
            f32x4 vv[8];
#pragma unroll
            for (int q = 0; q < 8; ++q) vv[q] = vr ? *(const f32x4*)(vr + hh * 32 + q * 4) : (f32x4){0.f, 0.f, 0.f, 0.f};
            const int pos = perm16(row);
#pragma unroll
            for (int q = 0; q < 8; ++q)
#pragma unroll
                for (int e = 0; e < 4; ++e) { const int d = hh * 32 + q * 4 + e; *(PG8_LAS unsigned short*)(vt_ + d * 128 + (((pos >> 3) ^ (d & 7)) << 4) + (pos & 7) * 2) = to_act(vv[q][e]); }
        }
        __builtin_amdgcn_sched_barrier(0);
    }
}
template <class KF, class VF>
DEV void stage_rows_c(PG8_LAS unsigned char* kt_, PG8_LAS unsigned char* vt_, KF kf, VF vf, int lane) {
    typedef unsigned u32x2 __attribute__((ext_vector_type(2)));
    const int lr = lane >> 4, lp = lane & 15;
#pragma unroll
    for (int hf = 0; hf < 2; ++hf) {
        f32x4 kv[8], vv[8];
#pragma unroll
        for (int q = 0; q < 8; ++q) { const int key = (hf * 8 + q) * 4 + lr; const float* kr = kf(key); const float* vr = vf(key);
            kv[q] = kr ? __builtin_nontemporal_load((const f32x4*)(kr + lp * 4)) : (f32x4){0.f, 0.f, 0.f, 0.f}; vv[q] = vr ? __builtin_nontemporal_load((const f32x4*)(vr + lp * 4)) : (f32x4){0.f, 0.f, 0.f, 0.f}; }
#pragma unroll
        for (int q = 0; q < 8; ++q) { const int key = (hf * 8 + q) * 4 + lr;
            u32x2 o; o[0] = pk2(kv[q][0], kv[q][1]); o[1] = pk2(kv[q][2], kv[q][3]);
            *(PG8_LAS u32x2*)(kt_ + key * 128 + (((lp >> 1) ^ (key & 7)) << 4) + (lp & 1) * 8) = o;
            const int pos = perm16(key);
#pragma unroll
            for (int e = 0; e < 4; ++e) { const int d = lp * 4 + e; *(PG8_LAS unsigned short*)(vt_ + d * 128 + (((pos >> 3) ^ (d & 7)) << 4) + (pos & 7) * 2) = to_act(vv[q][e]); }
        }
        __builtin_amdgcn_sched_barrier(0);
    }
}
DEV void qk_lds(const Cs& c, const PG8_LAS unsigned char* kb, f32x16& s0, f32x16& s1, const bf16x8 (&qf)[4]) {
#pragma unroll
    for (int r = 0; r < 16; ++r) { s0[r] = 0.f; s1[r] = 0.f; }
#pragma unroll
    for (int ks = 0; ks < 4; ++ks) { s0 = MFMA32(frag(kb, c.l32, 2 * ks + c.h, c.xr), qf[ks], s0); s1 = MFMA32(frag(kb, 32 + c.l32, 2 * ks + c.h, c.xr), qf[ks], s1); }
}
DEV void pv_lds(const Cs& c, const PG8_LAS unsigned char* vb, Acc& a, const f32x16& s0, const f32x16& s1) {
#pragma unroll
    for (int kt = 0; kt < 2; ++kt)
#pragma unroll
        for (int sp = 0; sp < 2; ++sp) { const bf16x8 pf = pack8(kt ? s1 : s0, sp);
            a.o0 = MFMA32(frag(vb, c.l32, kt * 4 + 2 * sp + c.h, c.xr), pf, a.o0); a.o1 = MFMA32(frag(vb, 32 + c.l32, kt * 4 + 2 * sp + c.h, c.xr), pf, a.o1); }
}
template <bool NORM = true>
DEV void merge(const Cs& c, Acc& a, float gate) {
    PG8_LAS float* x = (PG8_LAS float*)(c.lds + L_XCH);
    const float lp = a.l + __shfl_xor(a.l, 32);
    __syncthreads();
    PG8_LAS float* mine = x + (c.wid * 64 + c.lane) * 34;
    mine[0] = a.m; mine[1] = lp;
#pragma unroll
    for (int r = 0; r < 16; ++r) { mine[2 + r] = a.o0[r]; mine[18 + r] = a.o1[r]; }
    __syncthreads();
    float M = -1e30f;
#pragma unroll
    for (int w = 0; w < 8; ++w) M = fmaxf(M, x[(w * 64 + c.lane) * 34]);
    float L = 0.f;
#pragma unroll
    for (int r = 0; r < 16; ++r) { a.o0[r] = 0.f; a.o1[r] = 0.f; }
#pragma unroll 1
    for (int w = 0; w < 8; ++w) { const PG8_LAS float* q = x + (w * 64 + c.lane) * 34; const float sc = __builtin_amdgcn_exp2f(q[0] - M); L += q[1] * sc;
#pragma unroll
        for (int r = 0; r < 16; ++r) { a.o0[r] += sc * q[2 + r]; a.o1[r] += sc * q[18 + r]; } }
    if (NORM) { const float f = L > 0.f ? gate / L : 0.f;
#pragma unroll
        for (int r = 0; r < 16; ++r) { a.o0[r] *= f; a.o1[r] *= f; } }
    a.m = M; a.l = L;
}
constexpr int NPART = 4;
DEV void unit(const P& p, PG8_LAS unsigned char* lds, int b, int kvh, int part) {
    Cs c; c.lds = lds; const int tid = fresh_tid(); c.lane = tid & 63; c.l32 = c.lane & 31; c.h = c.lane >> 5; c.xr = c.l32 & 7;
    c.wid = __builtin_amdgcn_readfirstlane(tid >> 6); c.i = c.l32 & 7; c.g = c.l32 >> 3; c.t = PAST + c.i;
    const int head = kvh * 4 + c.g; const size_t row = (size_t)TOKP + b * DS + c.i;
    c.qp = p.qb + row * 512 + head * 64 + 8 * c.h;
    const float g0 = sigmoidf_(p.gatef[row * 32 + head * 3]), g1 = sigmoidf_(p.gatef[row * 32 + head * 3 + 1]), g2 = sigmoidf_(p.gatef[row * 32 + head * 3 + 2]);
    __syncthreads();
    for (int k = tid; k < 4 * TABN; k += NTHR_) { const int e = k % TABN; ((PG8_LAS float*)(lds + L_TAB))[k] = e == 0 ? -INFINITY : p.rel_bias[rel_bucket(e - 1) * 8 + kvh * 4 + k / TABN] * LOG2E; }
    for (int k = tid; k < 8 * IMPW; k += NTHR_) ((PG8_LAS float*)(lds + L_IMP))[k] = 0.f;
    __syncthreads();
    c.tabp = (const PG8_LAS float*)(lds + L_TAB) + c.g * TABN;
    const size_t bh = (size_t)b * 2 + kvh;
    const act_t* Kc = p.kcs + bh * NCSPAD * 64; const act_t* Vct = p.vcts + bh * 64 * NCSPAD;
    constexpr int NCB = NCSPAD / 64;
    Acc a; acc_init(a); f32x16 s0, s1;
    static_assert(NCB == 16, "each wave owns compressed key blocks wid and wid + 8");
    bf16x8 kf[2][8];
#pragma unroll
    for (int bl = 0; bl < 2; ++bl)
#pragma unroll
        for (int ks = 0; ks < 4; ++ks) { const int jb = c.wid + 8 * bl;
            kf[bl][2 * ks] = *(const bf16x8*)(Kc + (size_t)(jb * 64 + c.l32) * 64 + 16 * ks + 8 * c.h); kf[bl][2 * ks + 1] = *(const bf16x8*)(Kc + (size_t)(jb * 64 + 32 + c.l32) * 64 + 16 * ks + 8 * c.h); }
#pragma unroll
    for (int bl = 0; bl < 2; ++bl) { const int jb = c.wid + 8 * bl;
#pragma unroll
        for (int r = 0; r < 16; ++r) { s0[r] = 0.f; s1[r] = 0.f; }
#pragma unroll
        for (int ks = 0; ks < 4; ++ks) { const bf16x8 qf = qfrag(c, ks); s0 = MFMA32(kf[bl][2 * ks], qf, s0); s1 = MFMA32(kf[bl][2 * ks + 1], qf, s1); }
        smath<0>(c, a, s0, s1, jb * 64, true, 0.f, 0.f);
    }
    merge(c, a, 1.0f);
    const float mfin = a.m, invl = a.l > 0.f ? 1.0f / a.l : 0.f;
    __syncthreads();
    for (int k = tid; k < 8 * IMPW; k += NTHR_) ((PG8_LAS float*)(lds + L_IMP))[k] = 0.f;
    __syncthreads();
    acc_init(a);
    bf16x8 vf[2][8];
#pragma unroll
    for (int bl = 0; bl < 2; ++bl)
#pragma unroll
        for (int q = 0; q < 4; ++q) { const int jb = c.wid + 8 * bl;
            vf[bl][2 * q] = *(const bf16x8*)(Vct + (size_t)c.l32 * NCSPAD + jb * 64 + 16 * q + 8 * c.h); vf[bl][2 * q + 1] = *(const bf16x8*)(Vct + (size_t)(32 + c.l32) * NCSPAD + jb * 64 + 16 * q + 8 * c.h); }
#pragma unroll
    for (int bl = 0; bl < 2; ++bl) { const int jb = c.wid + 8 * bl;
#pragma unroll
        for (int r = 0; r < 16; ++r) { s0[r] = 0.f; s1[r] = 0.f; }
#pragma unroll
        for (int ks = 0; ks < 4; ++ks) { const bf16x8 qf = qfrag(c, ks); s0 = MFMA32(kf[bl][2 * ks], qf, s0); s1 = MFMA32(kf[bl][2 * ks + 1], qf, s1); }
        smath<1>(c, a, s0, s1, jb * 64, true, mfin, invl);
        PG8_LAS float* imp = (PG8_LAS float*)(lds + L_IMP) + c.i * IMPW;
#pragma unroll
        for (int kt = 0; kt < 2; ++kt)
#pragma unroll
            for (int q = 0; q < 4; ++q) {
                const float p0 = kt ? s1[4 * q] : s0[4 * q], p1 = kt ? s1[4 * q + 1] : s0[4 * q + 1], p2 = kt ? s1[4 * q + 2] : s0[4 * q + 2], p3 = kt ? s1[4 * q + 3] : s0[4 * q + 3];
                const int jbk = (jb * 64 + kt * 32 + 8 * q + 4 * c.h) >> 2;
                __hip_atomic_fetch_add(imp + jbk, (p0 + p1) + (p2 + p3), __ATOMIC_RELAXED, __HIP_MEMORY_SCOPE_WORKGROUP);
                __hip_atomic_fetch_add(imp + jbk + 1, p3, __ATOMIC_RELAXED, __HIP_MEMORY_SCOPE_WORKGROUP);
            }
#pragma unroll
        for (int kt = 0; kt < 2; ++kt)
#pragma unroll
            for (int sp = 0; sp < 2; ++sp) { const bf16x8 pf = pack8(kt ? s1 : s0, sp);
                a.o0 = MFMA32(vf[bl][2 * (kt * 2 + sp)], pf, a.o0);
                a.o1 = MFMA32(vf[bl][2 * (kt * 2 + sp) + 1], pf, a.o1); }
    }
    __syncthreads();
    {
        const PG8_LAS float* imp = (const PG8_LAS float*)(lds + L_IMP) + c.wid * IMPW; constexpr int jd = NSB_S - 1, K = 14;
        unsigned v[5]; bool cd[5];
#pragma unroll
        for (int k = 0; k < 5; ++k) { const int j = c.lane + 64 * k; cd[k] = j >= 1 && j < jd; v[k] = cd[k] ? __float_as_uint(imp[j]) : 0u; }
        unsigned thr = 0u;
        for (int bit = 30; bit >= 0; --bit) { const unsigned cand = thr | (1u << bit); int cnt = 0;
#pragma unroll
            for (int k = 0; k < 5; ++k) cnt += __popcll(__ballot(cd[k] && v[k] >= cand));
            if (cnt >= K) thr = cand; }
        int ngt = 0;
#pragma unroll
        for (int k = 0; k < 5; ++k) ngt += __popcll(__ballot(cd[k] && v[k] > thr));
        const int need = K - ngt; const unsigned long long below = (1ull << c.lane) - 1ull; int before = 0;
        PG8_LAS unsigned* mk = (PG8_LAS unsigned*)(lds + L_MASK) + c.wid * 12;
#pragma unroll
        for (int k = 0; k < 5; ++k) { const int j = c.lane + 64 * k; const unsigned long long eq = __ballot(cd[k] && v[k] == thr);
            const bool sl = (j == 0) || (j == jd) || (cd[k] && (v[k] > thr || (v[k] == thr && before + __popcll(eq & below) < need)));
            before += __popcll(eq);
            const unsigned long long bb = __ballot(sl);
            if (c.lane == 0) { mk[2 * k] = (unsigned)bb; mk[2 * k + 1] = (unsigned)(bb >> 32); } }
    }
    { a.m = 0.f; a.l = 0.5f; }
    merge(c, a, g0 * 8.0f);
    float* trow = p.oc + row * 512 + head * 64 + 4 * c.h;
    if (c.wid == 0 && part == 0) {
#pragma unroll
        for (int q = 0; q < 4; ++q) { *(f32x4*)(trow + 8 * q) = (f32x4){a.o0[4 * q], a.o0[4 * q + 1], a.o0[4 * q + 2], a.o0[4 * q + 3]}; *(f32x4*)(trow + 32 + 8 * q) = (f32x4){a.o1[4 * q], a.o1[4 * q + 1], a.o1[4 * q + 2], a.o1[4 * q + 3]}; }
    }
    __syncthreads();
    const PG8_LAS unsigned* mkAll = (const PG8_LAS unsigned*)(lds + L_MASK);
    PG8_LAS unsigned char* kt_ = lds + c.wid * 16384; PG8_LAS unsigned char* vt_ = kt_ + 8192;
    const int hh = c.h;
    bf16x8 qfs[4];
#pragma unroll
    for (int ks = 0; ks < 4; ++ks) qfs[ks] = qfrag(c, ks);
    acc_init(a);
    {
        int cnt = 0;
        for (int wd = 0; wd < 9; ++wd) {
            unsigned un = 0u;
#pragma unroll
            for (int tk = 0; tk < 8; ++tk) un |= mkAll[tk * 12 + wd];
            un = __builtin_amdgcn_readfirstlane(un);
            const unsigned mine = mkAll[c.i * 12 + wd];
            while (un) {
                const int bit = __builtin_ctz(un); un &= un - 1u; const int j = wd * 32 + bit;
                if (((cnt++) % (8 * NPART)) != part * 8 + c.wid) continue;
                if (j < PAST / 64) {
                    const float* blk = p.cache_kv + (((size_t)p.page_table[b * NPAGES + (j * 64) / PAGE] * PAGE + (j * 64) % PAGE) * 4) * 128 + kvh * 64;
                    stage_rows_c(kt_, vt_, [&](int key) { return blk + (size_t)key * 512 + 2 * 128; }, [&](int key) { return blk + (size_t)key * 512 + 3 * 128; }, c.lane);
                } else {
                    const float* blk = p.o_kvs + (size_t)(b * DS) * 512 + kvh * 64;
                    stage_rows_c(kt_, vt_, [&](int key) { return key < DS ? blk + (size_t)key * 512 + 2 * 128 : (const float*)nullptr; }, [&](int key) { return key < DS ? blk + (size_t)key * 512 + 3 * 128 : (const float*)nullptr; }, c.lane);
                }
                __builtin_amdgcn_wave_barrier();
                qk_lds(c, kt_, s0, s1, qfs);
                smath<2>(c, a, s0, s1, j * 64, (mine >> bit) & 1u, 0.f, 0.f);
                pv_lds(c, vt_, a, s0, s1);
                __builtin_amdgcn_wave_barrier();
            }
        }
    }
    merge<false>(c, a, 1.0f);
    float* sp = p.spart + ((((size_t)(b * 2 + kvh) * NPART + part) * 2 + 0) * 64 + c.lane) * 34;
    if (c.wid == 0) { sp[0] = a.m; sp[1] = a.l;
#pragma unroll
        for (int r = 0; r < 16; ++r) { sp[2 + r] = a.o0[r]; sp[18 + r] = a.o1[r]; } }
    __syncthreads();
    acc_init(a);
    for (int wj = part * 8 + c.wid; wj < 9; wj += 8 * NPART) {
        {
            auto wrow = [&](int key) -> const float* { const int w = wj * 64 + key;
                return w < WBS ? p.cache_win + ((size_t)b * WBS + w) * 256 + kvh * 64 : w < WBS + DS ? p.kvwf + (size_t)(TOKP + b * DS + w - WBS) * 256 + kvh * 64 : (const float*)nullptr; };
            stage_rows_c(kt_, vt_, [&](int key) { return wrow(key); }, [&](int key) { const float* r = wrow(key); return r ? r + 128 : r; }, c.lane);
        }
        __builtin_amdgcn_wave_barrier();
        qk_lds(c, kt_, s0, s1, qfs);
        smath<3>(c, a, s0, s1, PAST - WBS + wj * 64, true, 0.f, 0.f);
        pv_lds(c, vt_, a, s0, s1);
        __builtin_amdgcn_wave_barrier();
    }
    merge<false>(c, a, 1.0f);
    if (c.wid == 0) { float* sw = sp + 64 * 34; sw[0] = a.m; sw[1] = a.l;
#pragma unroll
        for (int r = 0; r < 16; ++r) { sw[2 + r] = a.o0[r]; sw[18 + r] = a.o1[r]; } }
    __syncthreads();
}
DEV void finish(const P& p, int gw, int nw, int lane) {
    typedef unsigned u32x2 __attribute__((ext_vector_type(2)));
    for (int u = gw; u < DB * 2; u += nw) {
        const int b = u >> 1, kvh = u & 1, l32 = lane & 31, hh = lane >> 5, i = l32 & 7, g = l32 >> 3, head = kvh * 4 + g; const size_t row = (size_t)TOKP + b * DS + i;
        const float gs = sigmoidf_(p.gatef[row * 32 + head * 3 + 1]), gwn = sigmoidf_(p.gatef[row * 32 + head * 3 + 2]);
        float tot[32]; const float* trow = p.oc + row * 512 + head * 64 + 4 * hh;
#pragma unroll
        for (int q = 0; q < 4; ++q) { const f32x4 x = *(const f32x4*)(trow + 8 * q), y = *(const f32x4*)(trow + 32 + 8 * q);
#pragma unroll
            for (int e = 0; e < 4; ++e) { tot[4 * q + e] = x[e]; tot[16 + 4 * q + e] = y[e]; } }
#pragma unroll 1
        for (int br = 0; br < 2; ++br) {
            const float* base = p.spart + (((size_t)u * NPART) * 2 + br) * 64 * 34 + (size_t)lane * 34;
            float M = -1e30f;
#pragma unroll
            for (int pt = 0; pt < NPART; ++pt) M = fmaxf(M, base[(size_t)pt * 2 * 64 * 34]);
            float L = 0.f, acc[32];
#pragma unroll
            for (int r = 0; r < 32; ++r) acc[r] = 0.f;
#pragma unroll
            for (int pt = 0; pt < NPART; ++pt) { const float* q = base + (size_t)pt * 2 * 64 * 34; const float sc = __builtin_amdgcn_exp2f(q[0] - M); L += q[1] * sc;
#pragma unroll
                for (int r = 0; r < 32; ++r) acc[r] += sc * q[2 + r]; }
            const float f = (br ? gwn : gs) / L;
#pragma unroll
            for (int r = 0; r < 32; ++r) tot[r] += f * acc[r];
        }
        act_t* orow = p.mixb + row * 1024 + head * 64;
#pragma unroll
        for (int q = 0; q < 4; ++q) {
            u32x2 w0; w0[0] = att::pk2(tot[4 * q], tot[4 * q + 1]); w0[1] = att::pk2(tot[4 * q + 2], tot[4 * q + 3]); *(u32x2*)(orow + 8 * q + 4 * hh) = w0;
            u32x2 w1; w1[0] = att::pk2(tot[16 + 4 * q], tot[16 + 4 * q + 1]); w1[1] = att::pk2(tot[16 + 4 * q + 2], tot[16 + 4 * q + 3]); *(u32x2*)(orow + 32 + 8 * q + 4 * hh) = w1;
        }
    }
}
}


namespace mls {
using att::bf16x8; using att::f32x16; using att::pack8; using att::pk2;
typedef float f32x4 __attribute__((ext_vector_type(4)));
typedef unsigned u32x4 __attribute__((ext_vector_type(4)));
typedef unsigned u32x2 __attribute__((ext_vector_type(2)));
constexpr int L_Q = 0, L_K = 16384, L_VT = 32768, L_KWT = 49152, L_CT = 65536, L_G = 98304;
constexpr int G_WK = 0, G_IBL = 64, G_BML = 128, G_INT = 192, G_EMT = 256, G_NP = 320, G_SSQ = 448;
DEV PG8_LAS float* gf(PG8_LAS unsigned char* lds) { return (PG8_LAS float*)(lds + L_G); }
DEV bf16x8 frag256(const PG8_LAS unsigned char* buf, int row, int ch) { return *(const PG8_LAS bf16x8*)(buf + row * 256 + ((ch ^ (row & 15)) << 4)); }
DEV bf16x8 frag128(const PG8_LAS unsigned char* buf, int row, int ch) { return *(const PG8_LAS bf16x8*)(buf + row * 128 + ((ch ^ (row & 7)) << 4)); }
DEV float bf2f(unsigned short u) { return __uint_as_float((unsigned)u << 16); }
DEV void put_t(PG8_LAS unsigned char* img, int s, int c0, const float* f, float scale) {
    const int pos = perm16(s);
#pragma unroll
    for (int e = 0; e < 8; ++e) { const int c = c0 + e; *(PG8_LAS unsigned short*)(img + c * 128 + (((pos >> 3) ^ (c & 7)) << 4) + (pos & 7) * 2) = to_act(f[e] * scale); }
}
DEV void stage_vT(const P& p, PG8_LAS unsigned char* lds, int r0, int cl, int h, int tid) {
#pragma unroll
    for (int i = 0; i < 2; ++i) { const int it = tid + 512 * i, srow = it >> 4, ch = it & 15; float f[8];
        if (srow < cl) { const u32x4 raw = *(const u32x4*)(p.mvb + (size_t)(r0 + srow) * 512 + h * 128 + ch * 8);
#pragma unroll
            for (int e = 0; e < 4; ++e) { f[2 * e] = __uint_as_float(raw[e] << 16); f[2 * e + 1] = __uint_as_float(raw[e] & 0xffff0000u); } }
        else {
#pragma unroll
            for (int e = 0; e < 8; ++e) f[e] = 0.f; }
        put_t(lds + L_VT, srow, ch * 8, f, 1.0f); }
}
struct PreA { u32x4 k[2], v[2]; float bs, ig, mp; };
DEV void load_a(const P& p, int u, int tid, PreA& r) {
    const int ch = u >> 2, h = u & 3; int path, b, c, r0, cl; chunk_info(ch, path, b, c, r0, cl);
    const act_t* kb = p.qkb + (size_t)r0 * 1024 + 512 + h * 128; const act_t* vb = p.mvb + (size_t)r0 * 512 + h * 128;
#pragma unroll
    for (int i = 0; i < 2; ++i) { const unsigned it = tid + 512 * i, srow = it >> 4, chk = it & 15; r.k[i] = (u32x4){0u, 0u, 0u, 0u}; r.v[i] = (u32x4){0u, 0u, 0u, 0u};
        if ((int)srow < cl) { r.k[i] = *(const u32x4*)(kb + (srow * 1024u + chk * 8u)); r.v[i] = *(const u32x4*)(vb + (srow * 512u + chk * 8u)); } }
    const int lane = tid & 63; const bool act = tid < 64 && lane < cl; const unsigned lr = act ? lane : 0;
    r.bs = act ? (p.gb + (size_t)r0 * 4 + h)[lr * 4u] : 0.f; r.ig = act ? (p.mif + (size_t)r0 * 8 + h)[lr * 8u] : 0.f; r.mp = p.mprev[(size_t)ch * 4 + h];
}
DEV void unpack8(const u32x4 raw, float* f) {
#pragma unroll
    for (int e = 0; e < 4; ++e) { f[2 * e] = __uint_as_float(raw[e] << 16); f[2 * e + 1] = __uint_as_float(raw[e] & 0xffff0000u); }
}
DEV void phase_a(const P& p, PG8_LAS unsigned char* lds) {
    const int tid = fresh_tid(), lane = tid & 63, l32 = lane & 31, hh = lane >> 5, wid = __builtin_amdgcn_readfirstlane(tid >> 6);
    PG8_LAS float* G = gf(lds);
    int u = blockIdx.x; if (u >= NCHUNK * 4) return;
    PreA r; load_a(p, u, tid, r);
    for (; u < NCHUNK * 4; u += gridDim.x) {
        const int ch = u >> 2, h = u & 3; int path, b, c, r0, cl; chunk_info(ch, path, b, c, r0, cl);
        __syncthreads();
        if (wid == 0) {
            const bool act = lane < cl;
            float pm = act ? r.ig - r.bs : -INFINITY;
#pragma unroll
            for (int o = 32; o; o >>= 1) pm = fmaxf(pm, __shfl_xor(pm, o));
            const float bend = __shfl(r.bs, cl - 1), mnew = bend + fmaxf(r.mp, pm);
            G[G_WK + lane] = act ? expf(bend - r.bs + r.ig - mnew) : 0.f;
        }
        __syncthreads();
#pragma unroll
        for (int i = 0; i < 2; ++i) { const int it = tid + 512 * i, srow = it >> 4, chk = it & 15; float f[8];
            unpack8(r.k[i], f); put_t(lds + L_KWT, srow, chk * 8, f, G[G_WK + srow]);
            unpack8(r.v[i], f); put_t(lds + L_VT, srow, chk * 8, f, 1.0f); }
        __syncthreads();
        if (u + (int)gridDim.x < NCHUNK * 4) load_a(p, u + gridDim.x, tid, r);
        const int dt = wid & 3;
        f32x16 acc[2];
#pragma unroll
        for (int j = 0; j < 2; ++j)
#pragma unroll
            for (int q = 0; q < 16; ++q) acc[j][q] = 0.f;
#pragma unroll
        for (int ks = 0; ks < 4; ++ks) { const bf16x8 af = frag128(lds + L_KWT, dt * 32 + l32, 2 * ks + hh);
#pragma unroll
            for (int j = 0; j < 2; ++j) acc[j] = MFMA32(af, frag128(lds + L_VT, ((wid >> 2) * 2 + j) * 32 + l32, 2 * ks + hh), acc[j]); }
        act_t* out = p.dct + ((size_t)ch * 4 + h) * 16384;
#pragma unroll
        for (int j = 0; j < 2; ++j) { const int vp = ((wid >> 2) * 2 + j) * 32 + l32;
#pragma unroll
            for (int q = 0; q < 4; ++q) { u32x2 o; o[0] = pk2(acc[j][4 * q], acc[j][4 * q + 1]); o[1] = pk2(acc[j][4 * q + 2], acc[j][4 * q + 3]); *(u32x2*)(out + (size_t)vp * 128 + dt * 32 + 8 * q + 4 * hh) = o; } }
        if (tid < 128) { float sn = 0.f;
#pragma unroll
            for (int cq = 0; cq < 8; ++cq) { const bf16x8 v = frag128(lds + L_KWT, tid, cq);
#pragma unroll
                for (int e = 0; e < 8; ++e) sn += bf2f((unsigned short)v[e]); }
            p.dn[((size_t)ch * 4 + h) * 128 + tid] = sn; }
    }
}
struct PreB { u32x4 q[2], k[2], v[2], ct[4]; float bs, ig, mp, np; };
DEV void load_b(const P& p, int u, int tid, PreB& r) {
    const int ch = u >> 2, h = u & 3; int path, b, c, r0, cl; chunk_info(ch, path, b, c, r0, cl);
    const act_t* qb_ = p.qkb + (size_t)r0 * 1024 + h * 128; const act_t* vb = p.mvb + (size_t)r0 * 512 + h * 128; const act_t* cb = p.cpt + ((size_t)ch * 4 + h) * 16384;
#pragma unroll
    for (int i = 0; i < 2; ++i) { const unsigned it = tid + 512 * i, srow = it >> 4, chk = it & 15; r.q[i] = (u32x4){0u, 0u, 0u, 0u}; r.k[i] = r.q[i]; r.v[i] = r.q[i];
        if ((int)srow < cl) { r.q[i] = *(const u32x4*)(qb_ + (srow * 1024u + chk * 8u)); r.k[i] = *(const u32x4*)(qb_ + (srow * 1024u + chk * 8u + 512u)); r.v[i] = *(const u32x4*)(vb + (srow * 512u + chk * 8u)); } }
#pragma unroll
    for (int i = 0; i < 4; ++i) { const unsigned it = tid + 512 * i; r.ct[i] = *(const u32x4*)(cb + it * 8u); }
    const int lane = tid & 63; const bool act = tid < 64 && lane < cl; const unsigned lr = act ? lane : 0;
    r.bs = act ? (p.gb + (size_t)r0 * 4 + h)[lr * 4u] : 0.f; r.ig = act ? (p.mif + (size_t)r0 * 8 + h)[lr * 8u] : 0.f; r.mp = p.mprev[(size_t)ch * 4 + h];
    r.np = (tid >= 64 && tid < 192) ? (p.nprev + ((size_t)ch * 4 + h) * 128)[(unsigned)(tid - 64)] : 0.f;
}
DEV void phase_b(const P& p, PG8_LAS unsigned char* lds) {
    const int tid = fresh_tid(), lane = tid & 63, l32 = lane & 31, hh = lane >> 5, wid = __builtin_amdgcn_readfirstlane(tid >> 6);
    PG8_LAS float* G = gf(lds);
    int u = blockIdx.x; if (u >= NCHUNK * 4) return;
    PreB r; load_b(p, u, tid, r);
    const int vt = wid & 3, tt = wid >> 2, tl = tt * 32 + l32;
    for (; u < NCHUNK * 4; u += gridDim.x) {
        const int ch = u >> 2, h = u & 3; int path, b, c, r0, cl; chunk_info(ch, path, b, c, r0, cl);
        int tlo = tl, l32o = l32; asm volatile("" : "+v"(tlo), "+v"(l32o));
        const bool live = tl < cl;
        const int head_col = h * 128 + vt * 32 + 4 * hh;
        u32x2 mor[4];
#pragma unroll
        for (int q = 0; q < 4; ++q) mor[q] = *(const u32x2*)((p.mob + (size_t)r0 * 512) + ((unsigned)(live ? tl : 0) * 512u + head_col + 8 * q));
        __syncthreads();
        if (wid == 0) {
            const bool act = lane < cl;
            float pm = act ? r.ig - r.bs : -INFINITY;
#pragma unroll
            for (int o = 1; o < 64; o <<= 1) { const float t = __shfl_up(pm, o); if (lane >= o) pm = fmaxf(pm, t); }
            const float mt = r.bs + fmaxf(r.mp, pm);
            G[G_IBL + lane] = act ? (r.ig - r.bs) * LOG2E : -INFINITY; G[G_BML + lane] = (r.bs - mt) * LOG2E; G[G_INT + lane] = act ? expf(r.bs + r.mp - mt) : 0.f; G[G_EMT + lane] = expf(-mt);
        }
        if (tid >= 64 && tid < 192) G[G_NP + tid - 64] = r.np;
#pragma unroll
        for (int i = 0; i < 2; ++i) { const int it = tid + 512 * i, srow = it >> 4, chk = it & 15; float f[8];
            *(PG8_LAS u32x4*)(lds + L_Q + srow * 256 + ((chk ^ (srow & 15)) << 4)) = r.q[i]; *(PG8_LAS u32x4*)(lds + L_K + srow * 256 + ((chk ^ (srow & 15)) << 4)) = r.k[i];
            unpack8(r.v[i], f); put_t(lds + L_VT, srow, chk * 8, f, 1.0f); }
#pragma unroll
        for (int i = 0; i < 4; ++i) { const int it = tid + 512 * i, vrow = it >> 4, chk = it & 15; *(PG8_LAS u32x4*)(lds + L_CT + vrow * 256 + ((chk ^ (vrow & 15)) << 4)) = r.ct[i]; }
        __syncthreads();
        if (u + (int)gridDim.x < NCHUNK * 4) load_b(p, u + gridDim.x, tid, r);
        f32x16 o1;
        const float inter = G[G_INT + tlo];
        {
            f32x16 o2;
#pragma unroll
            for (int q = 0; q < 16; ++q) o2[q] = 0.f;
#pragma unroll
            for (int ks = 0; ks < 8; ++ks) o2 = MFMA32(frag256(lds + L_CT, vt * 32 + l32o, 2 * ks + hh), frag256(lds + L_Q, tlo, 2 * ks + hh), o2);
#pragma unroll
            for (int q = 0; q < 16; ++q) o1[q] = inter * o2[q];
        }
        const float bml = G[G_BML + tl]; float den = 0.f;
#pragma unroll 1
        for (int st = 0; st < 2; ++st) {
            f32x16 sc;
#pragma unroll
            for (int q = 0; q < 16; ++q) sc[q] = 0.f;
#pragma unroll
            for (int ks = 0; ks < 8; ++ks) sc = MFMA32(frag256(lds + L_K, st * 32 + l32o, 2 * ks + hh), frag256(lds + L_Q, tlo, 2 * ks + hh), sc);
#pragma unroll
            for (int q = 0; q < 16; ++q) { const int sidx = st * 32 + (q & 3) + 8 * (q >> 2) + 4 * hh;
                const float w = __builtin_amdgcn_exp2f(bml + G[G_IBL + sidx] + (sidx <= tlo ? 0.f : -INFINITY));
                sc[q] *= w; den += sc[q]; }
#pragma unroll
            for (int sp = 0; sp < 2; ++sp) o1 = MFMA32(frag128(lds + L_VT, vt * 32 + l32o, st * 4 + 2 * sp + hh), pack8(sc, sp), o1);
        }
        float qn = 0.f;
#pragma unroll 2
        for (int cq = 0; cq < 8; ++cq) { const bf16x8 qv = frag256(lds + L_Q, tlo, hh * 8 + cq);
#pragma unroll
            for (int e = 0; e < 8; ++e) qn += bf2f((unsigned short)qv[e]) * G[G_NP + hh * 64 + cq * 8 + e]; }
        den += __shfl_xor(den, 32); qn += __shfl_xor(qn, 32);
        den += inter * qn;
        const float inv = 1.0f / fmaxf(fabsf(den), G[G_EMT + tl]);
        float ss = 0.f;
#pragma unroll
        for (int q = 0; q < 4; ++q) {
            const float mo[4] = {__uint_as_float(mor[q][0] << 16), __uint_as_float(mor[q][0] & 0xffff0000u), __uint_as_float(mor[q][1] << 16), __uint_as_float(mor[q][1] & 0xffff0000u)};
#pragma unroll
            for (int e = 0; e < 4; ++e) { const float hv = o1[4 * q + e] * inv * fsigmoid_(mo[e]); o1[4 * q + e] = hv; ss += hv * hv; } }
        ss += __shfl_xor(ss, 32);
        if (hh == 0) G[G_SSQ + (tt * 4 + vt) * 32 + l32] = ss;
        __syncthreads();
        const float tot = G[G_SSQ + (tt * 4 + 0) * 32 + l32] + G[G_SSQ + (tt * 4 + 1) * 32 + l32] + G[G_SSQ + (tt * 4 + 2) * 32 + l32] + G[G_SSQ + (tt * 4 + 3) * 32 + l32];
        const float rr = 1.0f / sqrtf(tot / 128 + 1e-6f);
        if (live) {
#pragma unroll
            for (int q = 0; q < 4; ++q) { const f32x4 g = *(const f32x4*)(p.g_mnorm + head_col + 8 * q);
                u32x2 o; o[0] = pk2(o1[4 * q] * rr * g[0], o1[4 * q + 1] * rr * g[1]); o[1] = pk2(o1[4 * q + 2] * rr * g[2], o1[4 * q + 3] * rr * g[3]);
                *(u32x2*)((p.mixb + (size_t)r0 * 1024 + 512) + ((unsigned)tl * 1024u + head_col + 8 * q)) = o; }
        }
    }
}
}

namespace coop {
typedef float f32x4 __attribute__((ext_vector_type(4)));
typedef unsigned u32x2 __attribute__((ext_vector_type(2)));
typedef unsigned u32x4 __attribute__((ext_vector_type(4)));
DEV float wave_sum(float v) {
#pragma unroll
    for (int o = 32; o; o >>= 1) v += __shfl_xor(v, o);
    return v;
}
DEV unsigned pk2(float lo, float hi) { return pkbf(lo, hi); }
DEV f32x4 ldb4(const act_t* q) { const u32x2 r = *(const u32x2*)q; return (f32x4){__uint_as_float(r[0] << 16), __uint_as_float(r[0] & 0xffff0000u), __uint_as_float(r[1] << 16), __uint_as_float(r[1] & 0xffff0000u)}; }
DEV f32x4 cvb4(u32x2 r) { return (f32x4){__uint_as_float(r[0] << 16), __uint_as_float(r[0] & 0xffff0000u), __uint_as_float(r[1] << 16), __uint_as_float(r[1] & 0xffff0000u)}; }
static_assert(D == 1024, "wave-per-row helpers assume d_model 1024 (16 floats per lane)");
DEV void rmsnorm_in(const P& p, int gw, int nw, int lane) {
    f32x4 gv[4];
#pragma unroll
    for (int i = 0; i < 4; ++i) gv[i] = *(const f32x4*)(p.g_attn_pre + i * 256 + lane * 4);
    int row = gw; if (row >= TOK) return;
    f32x4 v[4], nv[4];
#pragma unroll
    for (int i = 0; i < 4; ++i) v[i] = *(const f32x4*)(xrow(p, row) + i * 256 + lane * 4);
    for (; row < TOK; row += nw) {
        const int nr = row + nw < TOK ? row + nw : row;
#pragma unroll
        for (int i = 0; i < 4; ++i) nv[i] = *(const f32x4*)(xrow(p, nr) + i * 256 + lane * 4);
        float ss = 0.f;
#pragma unroll
        for (int i = 0; i < 4; ++i) ss += v[i][0] * v[i][0] + v[i][1] * v[i][1] + v[i][2] * v[i][2] + v[i][3] * v[i][3];
        const float r = 1.0f / sqrtf(wave_sum(ss) / D + 1e-6f);
#pragma unroll
        for (int i = 0; i < 4; ++i) { const f32x4 g = gv[i];
            u32x2 o; o[0] = pk2(v[i][0] * r * g[0], v[i][1] * r * g[1]); o[1] = pk2(v[i][2] * r * g[2], v[i][3] * r * g[3]); *(u32x2*)(p.hb + (size_t)row * D + i * 256 + lane * 4) = o; }
#pragma unroll
        for (int i = 0; i < 4; ++i) v[i] = nv[i];
    }
}
DEV void post1(const P& p, int lo, int hi, int gw, int nw, int lane) {
    int row = lo + gw; if (row >= hi) return;
    f32x4 v[4], xv[4], nv[4], nx[4], ga[4], gf[4];
#pragma unroll
    for (int i = 0; i < 4; ++i) { ga[i] = *(const f32x4*)(p.g_attn_post + i * 256 + lane * 4); gf[i] = *(const f32x4*)(p.g_ffn_pre + i * 256 + lane * 4); }
#pragma unroll
    for (int i = 0; i < 4; ++i) { v[i] = ldb4(p.mixh + (size_t)row * D + i * 256 + lane * 4); xv[i] = *(const f32x4*)(xrow(p, row) + i * 256 + lane * 4); }
    for (; row < hi; row += nw) {
        const int nr = row + nw < hi ? row + nw : row;
#pragma unroll
        for (int i = 0; i < 4; ++i) { nv[i] = ldb4(p.mixh + (size_t)nr * D + i * 256 + lane * 4); nx[i] = *(const f32x4*)(xrow(p, nr) + i * 256 + lane * 4); }
        float ss = 0.f;
#pragma unroll
        for (int i = 0; i < 4; ++i) ss += v[i][0] * v[i][0] + v[i][1] * v[i][1] + v[i][2] * v[i][2] + v[i][3] * v[i][3];
        const float r1 = 1.0f / sqrtf(wave_sum(ss) / D + 1e-6f); float s2 = 0.f;
#pragma unroll
        for (int i = 0; i < 4; ++i) { const f32x4 g = ga[i];
            v[i] = xv[i] + v[i] * r1 * g; *(f32x4*)(p.x1 + (size_t)row * D + i * 256 + lane * 4) = v[i]; s2 += v[i][0] * v[i][0] + v[i][1] * v[i][1] + v[i][2] * v[i][2] + v[i][3] * v[i][3]; }
        const float r2 = 1.0f / sqrtf(wave_sum(s2) / D + 1e-6f);
#pragma unroll
        for (int i = 0; i < 4; ++i) { const f32x4 g = gf[i];
            u32x2 o; o[0] = pk2(v[i][0] * r2 * g[0], v[i][1] * r2 * g[1]); o[1] = pk2(v[i][2] * r2 * g[2], v[i][3] * r2 * g[3]); *(u32x2*)(p.h2b + (size_t)row * D + i * 256 + lane * 4) = o; }
#pragma unroll
        for (int i = 0; i < 4; ++i) { v[i] = nv[i]; xv[i] = nx[i]; }
    }
}
template <bool TWO>
DEV void post2(const P& p, int lo, int hi, int gw, int nw, int lane) {
    int row = lo + gw; if (row >= hi) return;
    f32x4 v[4], xv[4], nv[4], nx[4], gp[4];
#pragma unroll
    for (int i = 0; i < 4; ++i) gp[i] = *(const f32x4*)(p.g_ffn_post + i * 256 + lane * 4);
#pragma unroll
    for (int i = 0; i < 4; ++i) { v[i] = ldb4(p.fh + (size_t)row * D + i * 256 + lane * 4); if (TWO) v[i] += ldb4(p.fh2 + (size_t)(row - TOKP) * D + i * 256 + lane * 4); xv[i] = *(const f32x4*)(p.x1 + (size_t)row * D + i * 256 + lane * 4); }
    for (; row < hi; row += nw) {
        const int nr = row + nw < hi ? row + nw : row;
#pragma unroll
        for (int i = 0; i < 4; ++i) { nv[i] = ldb4(p.fh + (size_t)nr * D + i * 256 + lane * 4); if (TWO) nv[i] += ldb4(p.fh2 + (size_t)(nr - TOKP) * D + i * 256 + lane * 4); nx[i] = *(const f32x4*)(p.x1 + (size_t)nr * D + i * 256 + lane * 4); }
        float ss = 0.f;
#pragma unroll
        for (int i = 0; i < 4; ++i) ss += v[i][0] * v[i][0] + v[i][1] * v[i][1] + v[i][2] * v[i][2] + v[i][3] * v[i][3];
        const float r1 = 1.0f / sqrtf(wave_sum(ss) / D + 1e-6f);
        float* y = row < TOKP ? p.o_yp + (size_t)row * D : p.o_ys + (size_t)(row - TOKP) * D;
#pragma unroll
        for (int i = 0; i < 4; ++i) { const f32x4 g = gp[i]; *(f32x4*)(y + i * 256 + lane * 4) = xv[i] + v[i] * r1 * g; }
#pragma unroll
        for (int i = 0; i < 4; ++i) { v[i] = nv[i]; xv[i] = nx[i]; }
    }
}
DEV void hnorm(const P& p, int gw, int nw, int lane) {
    for (int row = gw; row < TOK; row += nw) {
        const float* x = p.hm_pre + (size_t)row * 512 + lane * 8; const f32x4 a = *(const f32x4*)x, b = *(const f32x4*)(x + 4);
        float ss = a[0] * a[0] + a[1] * a[1] + a[2] * a[2] + a[3] * a[3] + b[0] * b[0] + b[1] * b[1] + b[2] * b[2] + b[3] * b[3];
#pragma unroll
        for (int o = 8; o; o >>= 1) ss += __shfl_xor(ss, o);
        const float rr = 1.0f / sqrtf(ss / 128 + 1e-6f);
        const f32x4 g0 = *(const f32x4*)(p.g_mnorm + lane * 8), g1 = *(const f32x4*)(p.g_mnorm + lane * 8 + 4);
        u32x4 o; o[0] = pk2(a[0] * rr * g0[0], a[1] * rr * g0[1]); o[1] = pk2(a[2] * rr * g0[2], a[3] * rr * g0[3]); o[2] = pk2(b[0] * rr * g1[0], b[1] * rr * g1[1]); o[3] = pk2(b[2] * rr * g1[2], b[3] * rr * g1[3]);
        *(u32x4*)(p.mixb + (size_t)row * 1024 + 512 + lane * 8) = o;
    }
}
constexpr int WT_BYTES = 64 * 65 * 4;
template <bool PERM, int MAP = 0>
DEV void transpose_tile_w(PG8_LAS float* tl, const float* src, size_t lds_, int nr, int nc, act_t* dst, size_t ldd, int lane, int nbase = 0) {
#pragma unroll
    for (int i = 0; i < 16; ++i) { const int r = (lane >> 4) + 4 * i, c = (lane & 15) * 4;
        f32x4 v = {0.f, 0.f, 0.f, 0.f};
        if (r < nr && c < nc) v = *(const f32x4*)(src + (size_t)r * lds_ + c);
        tl[r * 65 + c] = v[0]; tl[r * 65 + c + 1] = v[1]; tl[r * 65 + c + 2] = v[2]; tl[r * 65 + c + 3] = v[3]; }
    __builtin_amdgcn_wave_barrier();
#pragma unroll
    for (int i = 0; i < 8; ++i) { const int c = (lane >> 3) + 8 * i, rb = (lane & 7) * 8;
        if (c < nc && rb < nr) {
            float v[8];
#pragma unroll
            for (int e = 0; e < 8; ++e) { const int pos = rb + e, r = PERM ? ((pos & ~15) | (pos & 3) | ((pos & 4) << 1) | ((pos & 8) >> 1)) : pos; v[e] = tl[r * 65 + c]; }
            u32x4 o; o[0] = pk2(v[0], v[1]); o[1] = pk2(v[2], v[3]); o[2] = pk2(v[4], v[5]); o[3] = pk2(v[6], v[7]);
            const int cd = MAP == 0 ? c : MAP == 3 ? pg8::remap_in(nbase + c) : (c + (MAP == 2 ? 128 : 0));
            *(u32x4*)(dst + (size_t)cd * ldd + rb) = o;
        } }
    __builtin_amdgcn_wave_barrier();
}
template <int MAP = 0>
DEV void weight_t(PG8_LAS float* lds0, const float* w, int K, int N, act_t* bt, int row0, int tid) {
    const int tk = K / 64, tn = (N + 63) / 64, wv = tid >> 6, lane = tid & 63; PG8_LAS float* tl = lds0 + wv * (WT_BYTES / 4);
    for (int t = (int)blockIdx.x * (NTHR_ / 64) + wv; t < tk * tn; t += (int)gridDim.x * (NTHR_ / 64)) { const int k0 = (t / tn) * 64, n0 = (t % tn) * 64;
        transpose_tile_w<false, MAP>(tl, w + (size_t)k0 * N + n0, N, 64, N - n0 < 64 ? N - n0 : 64, bt + (size_t)(row0 + (MAP == 3 ? 0 : MAP ? 256 * (n0 / 128) + (n0 % 128) : n0)) * K + k0, K, lane, n0); }
}
DEV void prep_prompt(const P& p, PG8_LAS float* lds0, int tid) {
    constexpr int NT = SEQ / 64; const int wv = tid >> 6, lane = tid & 63; PG8_LAS float* tl = lds0 + wv * (WT_BYTES / 4);
    for (int u = (int)blockIdx.x * (NTHR_ / 64) + wv; u < BATCH * 2 * NT * 2; u += (int)gridDim.x * (NTHR_ / 64)) {
        const int which = u & 1, tt = (u >> 1) % NT, bh = (u >> 1) / NT, b = bh >> 1, kvh = bh & 1;
        const float* src = which ? p.kvwf + (size_t)(b * SEQ + tt * 64) * 256 + 128 + kvh * 64 : p.o_kvp + (size_t)(b * SEQ + tt * 64) * 512 + 3 * 128 + kvh * 64;
        act_t* dst = (which ? p.vwt : p.vst) + (size_t)bh * 64 * SEQ + tt * 64;
        transpose_tile_w<true>(tl, src, which ? 256 : 512, 64, 64, dst, SEQ, lane);
    }
}
DEV void conv_rows(const P& p, int gw, int nw, int lane) {
    const int c0 = lane * 16;
    f32x4 wv[4][4], bv[4];
#pragma unroll
    for (int q = 0; q < 4; ++q) { bv[q] = *(const f32x4*)(p.conv_b + c0 + 4 * q);
#pragma unroll
        for (int j = 0; j < 4; ++j) wv[j][q] = *(const f32x4*)(p.conv_w + j * 1024 + c0 + 4 * q); }
    int row = gw; if (row >= TOK) return;
    u32x4 ta[4], tb[4], na[4], nb[4];
    auto ldt = [&](int rw, u32x4 (&A)[4], u32x4 (&B)[4]) {
        const int t = row_info(rw).t;
#pragma unroll
        for (int j = 0; j < 4; ++j) {
            if (t - 3 + j >= 0) { A[j] = *(const u32x4*)(p.mqkb + (size_t)(rw - 3 + j) * 1024 + c0); B[j] = *(const u32x4*)(p.mqkb + (size_t)(rw - 3 + j) * 1024 + c0 + 8); }
            else { A[j] = (u32x4){0u, 0u, 0u, 0u}; B[j] = (u32x4){0u, 0u, 0u, 0u}; } }
    };
    ldt(row, ta, tb);
    for (; row < TOK; row += nw) {
        const int nr = row + nw < TOK ? row + nw : row;
        ldt(nr, na, nb);
        const Row r = row_info(row);
        float acc[16];
#pragma unroll
        for (int q = 0; q < 4; ++q) { acc[4 * q] = bv[q][0]; acc[4 * q + 1] = bv[q][1]; acc[4 * q + 2] = bv[q][2]; acc[4 * q + 3] = bv[q][3]; }
#pragma unroll
        for (int j = 0; j < 4; ++j) { const int tt = r.t - 3 + j; float v[16];
#pragma unroll
            for (int e = 0; e < 4; ++e) { v[2 * e] = __uint_as_float(ta[j][e] << 16); v[2 * e + 1] = __uint_as_float(ta[j][e] & 0xffff0000u); v[8 + 2 * e] = __uint_as_float(tb[j][e] << 16); v[8 + 2 * e + 1] = __uint_as_float(tb[j][e] & 0xffff0000u); }
            if (tt < 0 && r.path) { const float* src = p.state_conv + ((size_t)r.b * 3 + (r.t + j)) * 1024 + c0;
#pragma unroll
                for (int q = 0; q < 4; ++q) { const f32x4 t = *(const f32x4*)(src + 4 * q); v[4 * q] = t[0]; v[4 * q + 1] = t[1]; v[4 * q + 2] = t[2]; v[4 * q + 3] = t[3]; } }
#pragma unroll
            for (int q = 0; q < 4; ++q) {
#pragma unroll
                for (int e = 0; e < 4; ++e) acc[4 * q + e] += v[4 * q + e] * wv[j][q][e]; } }
        const float sc = c0 >= 512 ? 0.08838834764831845f : 1.0f;
        u32x4 o[2];
#pragma unroll
        for (int q = 0; q < 4; ++q) { float v[4];
#pragma unroll
            for (int e = 0; e < 4; ++e) v[e] = acc[4 * q + e] * fsigmoid_(acc[4 * q + e]) * sc;
            o[q >> 1][(q & 1) * 2] = pk2(v[0], v[1]); o[q >> 1][(q & 1) * 2 + 1] = pk2(v[2], v[3]); }
        *(u32x4*)(p.qkb + (size_t)row * 1024 + c0) = o[0]; *(u32x4*)(p.qkb + (size_t)row * 1024 + c0 + 8) = o[1];
#pragma unroll
        for (int j = 0; j < 4; ++j) { ta[j] = na[j]; tb[j] = nb[j]; }
    }
}
DEV void out_kv_rows(const P& p, int gw, int nw, int lane) {
    for (int row = gw; row < TOK; row += nw) {
        const float* src = p.proj + (size_t)row * PROJ + C_KVP + lane * 8; float* dst = (row < TOKP ? p.o_kvp + (size_t)row * 512 : p.o_kvs + (size_t)(row - TOKP) * 512) + lane * 8;
        const f32x4 a = *(const f32x4*)src, b = *(const f32x4*)(src + 4); *(f32x4*)dst = a; *(f32x4*)(dst + 4) = b;
    }
}
DEV void cmpA_rows_s(const P& p, int gw, int nw, int lane) {
    const int j = lane >> 2, qd = lane & 3;
    for (int r = gw; r < 2 * CROWS_S; r += nw) {
        const int cidx = r % NCH_S, bh = (r / NCH_S) % (DB * 2), tensor = r / CROWS_S, b = bh >> 1, h = bh & 1, T = 16 * cidx + j;
        const float* src = p.cache_kv + ((((size_t)p.page_table[b * NPAGES + T / PAGE] * PAGE + T % PAGE) * 4 + tensor) * 128) + h * 64 + qd * 16;
        f32x4 v[4];
#pragma unroll
        for (int q = 0; q < 4; ++q) v[q] = *(const f32x4*)(src + 4 * q);
        u32x4 o0, o1; o0[0] = pk2(v[0][0], v[0][1]); o0[1] = pk2(v[0][2], v[0][3]); o0[2] = pk2(v[1][0], v[1][1]); o0[3] = pk2(v[1][2], v[1][3]);
        o1[0] = pk2(v[2][0], v[2][1]); o1[1] = pk2(v[2][2], v[2][3]); o1[2] = pk2(v[3][0], v[3][1]); o1[3] = pk2(v[3][2], v[3][3]);
        act_t* dst = p.cas + (size_t)r * 1024 + j * 64 + qd * 16; *(u32x4*)dst = o0; *(u32x4*)(dst + 8) = o1;
    }
}

DEV void cmp_const_w(const P& p, int gw, int nw, int lane) {
    for (int u = gw; u < 256; u += nw) {
        const int e = u % 128, tensor = u / 128; float acc = 0.f;
#pragma unroll 8
        for (int k = lane; k < 2048; k += 64) acc += p.cmp_pos[tensor * 2048 + k] * p.cmp_w1[((size_t)tensor * 2048 + k) * 128 + e];
        acc = wave_sum(acc);
        if (lane == 0) p.cmpc[u] = acc + p.cmp_b1[tensor * 128 + e];
    }
}
DEV void gates1(const P& p, int gw, int nw, int lane) {
    for (int ch = gw; ch < NCHUNK; ch += nw) {
        int path, b, c, r0, cl; chunk_info(ch, path, b, c, r0, cl);
        const bool act = lane < cl; const size_t row = r0 + (act ? lane : 0);
        const f32x4 iv4 = *(const f32x4*)(p.mif + row * 8), fv4 = *(const f32x4*)(p.mif + row * 8 + 4);
        float bs[4], ig[4];
#pragma unroll
        for (int h = 0; h < 4; ++h) { ig[h] = act ? iv4[h] : 0.f; bs[h] = act ? logsigmoidf_(fv4[h]) : 0.f; }
#pragma unroll
        for (int o = 1; o < 64; o <<= 1) {
#pragma unroll
            for (int h = 0; h < 4; ++h) { const float t = __shfl_up(bs[h], o); if (lane >= o) bs[h] += t; } }
        float bend[4], iv[4];
#pragma unroll
        for (int h = 0; h < 4; ++h) { bend[h] = __shfl(bs[h], cl - 1); iv[h] = act ? ig[h] + bend[h] - bs[h] : -INFINITY; }
#pragma unroll
        for (int o = 32; o; o >>= 1) {
#pragma unroll
            for (int h = 0; h < 4; ++h) iv[h] = fmaxf(iv[h], __shfl_xor(iv[h], o)); }
        if (act) *(f32x4*)(p.gb + row * 4) = (f32x4){bs[0], bs[1], bs[2], bs[3]};
        if (lane < 4) { const float be = lane == 0 ? bend[0] : lane == 1 ? bend[1] : lane == 2 ? bend[2] : bend[3], im = lane == 0 ? iv[0] : lane == 1 ? iv[1] : lane == 2 ? iv[2] : iv[3];
            p.cmap[((size_t)ch * 4 + lane) * 2] = be; p.cmap[((size_t)ch * 4 + lane) * 2 + 1] = im; }
    }
}
DEV void gates2(const P& p, int gw, int nw, int lane) {
    for (int u = gw; u < NSEQ * 4; u += nw) {
        const int h = u & 3, sq = u >> 2, path = sq < BATCH ? 0 : 1, b = path ? sq - BATCH : sq, nck = path ? 1 : NCKP, ch0 = path ? BATCH * NCKP + b : b * NCKP;
        const float m0 = path ? p.state_m[b * 4 + h] : 0.f;
        const int c0 = 2 * lane, c1 = 2 * lane + 1;
        float L0 = 0.f, I0 = -INFINITY, L1 = 0.f, I1 = -INFINITY;
        if (c0 < nck) { L0 = p.cmap[((size_t)(ch0 + c0) * 4 + h) * 2]; I0 = p.cmap[((size_t)(ch0 + c0) * 4 + h) * 2 + 1]; }
        if (c1 < nck) { L1 = p.cmap[((size_t)(ch0 + c1) * 4 + h) * 2]; I1 = p.cmap[((size_t)(ch0 + c1) * 4 + h) * 2 + 1]; }
        float L = L0 + L1, I = fmaxf(I0 + L1, I1);
#pragma unroll
        for (int o = 1; o < 64; o <<= 1) { const float pl = __shfl_up(L, o), pi = __shfl_up(I, o); if (lane >= o) { I = fmaxf(pi + L, I); L = pl + L; } }
        float eL = __shfl_up(L, 1), eI = __shfl_up(I, 1); if (lane == 0) { eL = 0.f; eI = -INFINITY; }
        const float mb0 = fmaxf(m0 + eL, eI), mb1 = fmaxf(mb0 + L0, I0);
        if (c0 < nck) p.mprev[(size_t)(ch0 + c0) * 4 + h] = mb0;
        if (c1 < nck) p.mprev[(size_t)(ch0 + c1) * 4 + h] = mb1;
        const float mfin = __shfl(fmaxf(m0 + L, I), 63);
        if (lane == 0) { if (path) p.o_ms[b * 4 + h] = mfin; else p.o_mp[b * 4 + h] = mfin; }
    }
}
DEV void gates3(const P& p, int gw, int nw, int lane) {
    for (int u = gw; u < NCHUNK * 4; u += nw) {
        const int h = u & 3, ch = u >> 2; int path, b, c, r0, cl; chunk_info(ch, path, b, c, r0, cl);
        const bool act = lane < cl; const size_t row = r0 + (act ? lane : 0);
        const float bs = act ? p.gb[row * 4 + h] : 0.f; float pm = act ? p.proj[row * PROJ + C_MIF + h] - bs : -INFINITY;
#pragma unroll
        for (int o = 1; o < 64; o <<= 1) { const float t = __shfl_up(pm, o); if (lane >= o) pm = fmaxf(pm, t); }
        if (act) p.gm[row * 4 + h] = bs + fmaxf(p.mprev[(size_t)ch * 4 + h], pm);
    }
}

DEV void cmp_combine(const P& p, int path, int gw, int nw, int lane, PG8_LAS unsigned char* wl) {
    typedef short bf16x8 __attribute__((ext_vector_type(8))); typedef float f32x16 __attribute__((ext_vector_type(16)));
    const int lr = lane >> 4, lp = lane & 15;
    const int nch = path ? NCH_S : NCH_P, nb = path ? DB : BATCH; const act_t* C = path ? p.ccs : p.ccp; const size_t crows = path ? CROWS_S : CROWS_P;
    act_t* kc = path ? p.kcs : p.kc; act_t* vct = path ? p.vcts : p.vct;
    const int l32 = lane & 31, hh = lane >> 5, upr = nch / 32;
    for (int u = gw; u < 2 * nb * 2 * upr; u += nw) {
        const int c0 = (u % upr) * 32, bh = (u / upr) % (nb * 2), tensor = u / (upr * nb * 2), c = c0 + l32;
        f32x16 o0, o1;
#pragma unroll
        for (int r = 0; r < 16; ++r) { o0[r] = 0.f; o1[r] = 0.f; }
        f32x4 cc0 = *(const f32x4*)(p.cmpc + tensor * 128 + lp * 8), cc1 = *(const f32x4*)(p.cmpc + tensor * 128 + lp * 8 + 4);
        u32x4 la[8], hb[8];
#pragma unroll
        for (int q = 0; q < 8; ++q) { const int cr = c0 + 4 * q + lr; const bool lv = cr < nch - 1;
            const act_t* lo = C + ((size_t)tensor * crows + (size_t)bh * nch + (lv ? cr : 0)) * 256 + lp * 8;
            la[q] = *(const u32x4*)lo; hb[q] = *(const u32x4*)(lo + 256 + 128); }
        bf16x8 wf[8][2];
#pragma unroll
        for (int ks = 0; ks < 8; ++ks) { const int e0 = 16 * ks + 8 * hh;
            wf[ks][0] = *(const bf16x8*)(p.w2t + ((size_t)tensor * 64 + l32) * 128 + e0); wf[ks][1] = *(const bf16x8*)(p.w2t + ((size_t)tensor * 64 + 32 + l32) * 128 + e0); }
#pragma unroll
        for (int q = 0; q < 8; ++q) { const int ri = 4 * q + lr; const bool lv = c0 + ri < nch - 1;
            float hv[8];
#pragma unroll
            for (int e = 0; e < 4; ++e) {
                const float a = (e & 1) ? __uint_as_float(la[q][e >> 1] & 0xffff0000u) : __uint_as_float(la[q][e >> 1] << 16), bq = (e & 1) ? __uint_as_float(hb[q][e >> 1] & 0xffff0000u) : __uint_as_float(hb[q][e >> 1] << 16);
                const float a2 = (e & 1) ? __uint_as_float(la[q][2 + (e >> 1)] & 0xffff0000u) : __uint_as_float(la[q][2 + (e >> 1)] << 16), b2 = (e & 1) ? __uint_as_float(hb[q][2 + (e >> 1)] & 0xffff0000u) : __uint_as_float(hb[q][2 + (e >> 1)] << 16);
                hv[e] = gelu_tanh(lv ? a + bq + cc0[e] : 0.f); hv[4 + e] = gelu_tanh(lv ? a2 + b2 + cc1[e] : 0.f); }
            u32x4 o; o[0] = pk2(hv[0], hv[1]); o[1] = pk2(hv[2], hv[3]); o[2] = pk2(hv[4], hv[5]); o[3] = pk2(hv[6], hv[7]);
            *(PG8_LAS u32x4*)(wl + ri * 256 + ((lp ^ (ri & 15)) << 4)) = o; }
        __builtin_amdgcn_wave_barrier();
#pragma unroll
        for (int ks = 0; ks < 8; ++ks) {
            const bf16x8 af = *(const PG8_LAS bf16x8*)(wl + l32 * 256 + (((2 * ks + hh) ^ (l32 & 15)) << 4));
            o0 = __builtin_amdgcn_mfma_f32_32x32x16_bf16(af, wf[ks][0], o0, 0, 0, 0);
            o1 = __builtin_amdgcn_mfma_f32_32x32x16_bf16(af, wf[ks][1], o1, 0, 0, 0);
        }
        __builtin_amdgcn_wave_barrier();
        const float bb0 = p.cmp_b2[tensor * 64 + l32], bb1 = p.cmp_b2[tensor * 64 + 32 + l32];
#pragma unroll
        for (int q = 0; q < 4; ++q) {
            const int cb = c0 + 8 * q + 4 * hh;
            float v0[4], v1[4];
#pragma unroll
            for (int e = 0; e < 4; ++e) { const bool lv = cb + e < nch - 1; v0[e] = lv ? o0[4 * q + e] + bb0 : 0.f; v1[e] = lv ? o1[4 * q + e] + bb1 : 0.f; }
            if (tensor == 0) {
#pragma unroll
                for (int e = 0; e < 4; ++e) { kc[((size_t)bh * nch + cb + e) * 64 + l32] = to_act(v0[e]); kc[((size_t)bh * nch + cb + e) * 64 + 32 + l32] = to_act(v1[e]); }
            } else {
                const int pos = perm16(cb);
                u32x2 w0; w0[0] = pk2(v0[0], v0[1]); w0[1] = pk2(v0[2], v0[3]); *(u32x2*)(vct + ((size_t)bh * 64 + l32) * nch + pos) = w0;
                u32x2 w1; w1[0] = pk2(v1[0], v1[1]); w1[1] = pk2(v1[2], v1[3]); *(u32x2*)(vct + ((size_t)bh * 64 + 32 + l32) * nch + pos) = w1;
            }
        }
    }
}
DEV void cmp_combine_s(const P& p, int gw, int nw, int lane, PG8_LAS unsigned char* wl) { cmp_combine(p, 1, gw, nw, lane, wl); }
DEV void cmp_combine_p(const P& p, int gw, int nw, int lane, PG8_LAS unsigned char* wl) { cmp_combine(p, 0, gw, nw, lane, wl); }
}

constexpr int NTHR = 512, LDS_BYTES = 147456, LDS_BAR_OFF = 147440;
DEV void run_gemm_proj(PG8_LAS unsigned char* lds, const P& p) {
    pg8::Gemm g{p.hb, p.bt_in, TOK, PROJP, D}; pg8::StaticOrder S; S.init(TOK, PROJP, (int)gridDim.x, (int)blockIdx.x);
    pg8::EpiProj E{p.b_in, p.qb, p.kvb, p.kwb, p.mqkb, p.mvb, p.mob, p.o_kvp, p.o_kvs, p.kvwf, p.gatef, p.mif, p.o_convp, p.o_convs, 0.125f * LOG2E};
    pg8::gemm_phase<pg8::EpiProj, pg8::StaticOrder>(lds, g, S, E);
}
DEV void run_gemm_b16(PG8_LAS unsigned char* lds, const act_t* A, const act_t* Bt, int M, int N, int K, act_t* O, int ldo, int rot = 0, int ld = 0) {
    pg8::Gemm g{A, Bt, M, N, K, ld}; pg8::StaticOrder S; S.init(M, N, (int)gridDim.x, ((int)blockIdx.x + (int)gridDim.x - rot) % (int)gridDim.x);
    pg8::EpiB16 E{O, ldo};
    pg8::gemm_phase<pg8::EpiB16, pg8::StaticOrder>(lds, g, S, E);
}
DEV void run_gemm_swiglu(PG8_LAS unsigned char* lds, const act_t* A, const act_t* Bt, int M, int N, int K, act_t* O, int ldo) {
    pg8::Gemm g{A, Bt, M, N, K}; pg8::StaticOrder S; S.init(M, N, (int)gridDim.x, (int)blockIdx.x);
    pg8::EpiSwiglu E{O, ldo};
    pg8::gemm_phase<pg8::EpiSwiglu, pg8::StaticOrder>(lds, g, S, E);
}
DEV void run_gemm(PG8_LAS unsigned char* lds, const act_t* A, const act_t* Bt, int M, int N, int K, float* C, int ldc, const float* bias, int ncols, int rot = 0) {
    pg8::Gemm g{A, Bt, M, N, K}; pg8::StaticOrder S; S.init(M, N, (int)gridDim.x, ((int)blockIdx.x + (int)gridDim.x - rot) % (int)gridDim.x);
    pg8::EpiF32 E{C, ldc, bias, ncols};
    pg8::gemm_phase<pg8::EpiF32, pg8::StaticOrder>(lds, g, S, E);
}


namespace cmps {
using att::bf16x8; using att::f32x16; using att::tile_load; using att::tile_store; using att::frag;
typedef float f32x4 __attribute__((ext_vector_type(4)));
typedef unsigned u32x4 __attribute__((ext_vector_type(4)));
typedef unsigned u32x2 __attribute__((ext_vector_type(2)));
constexpr int NUNIT = 2 * CROWS_S / 256, L_A = 65536, L_Q = 131072;
static_assert(NCH_S % 32 == 0 && CROWS_S % 256 == 0 && 16 * NCH_S <= PAST && PAGE == 128, "sample compression shapes");
DEV void unit(const P& p, PG8_LAS unsigned char* lds, int u) {
    const int tid = fresh_tid(), lane = tid & 63, l32 = lane & 31, h = lane >> 5, wid = __builtin_amdgcn_readfirstlane(tid >> 6), xr = l32 & 7;
    const int tensor = u / (CROWS_S / 256), r0 = (u % (CROWS_S / 256)) * 256 + wid * 32;
    const int bh = r0 / NCH_S, cidx0 = r0 % NCH_S, b = bh >> 1, kvh = bh & 1;
    const int lr = lane >> 4, lp = lane & 15;
    const float* pbase[4];
#pragma unroll
    for (int pg = 0; pg < 4; ++pg) pbase[pg] = p.cache_kv + ((size_t)p.page_table[b * NPAGES + (cidx0 >> 3) + pg] * PAGE * 4 + tensor) * 128 + kvh * 64;
    const unsigned voff = (unsigned)(16 * lr) * 512u + (unsigned)lp * 4u;
    const act_t* wsrc = p.btc + (size_t)tensor * 256 * 1024;
    PG8_LAS unsigned char* abuf = lds + L_A + wid * 8192;
    f32x16 acc[8];
#pragma unroll
    for (int ct = 0; ct < 8; ++ct)
#pragma unroll
        for (int i = 0; i < 16; ++i) acc[ct][i] = 0.f;
    f32x4 xa[8]; u32x4 wreg[4];
#define CMPS_LDA(J) _Pragma("unroll") for (int q = 0; q < 8; ++q) xa[q] = __builtin_nontemporal_load((const f32x4*)(pbase[q >> 1] + voff + (size_t)((q & 1) * 64 + (J)) * 512))
#define CMPS_STA(BUF) _Pragma("unroll") for (int q = 0; q < 8; ++q) { const int ri = 4 * q + lr; u32x2 o; o[0] = pkbf(xa[q][0], xa[q][1]); o[1] = pkbf(xa[q][2], xa[q][3]); \
        *(PG8_LAS u32x2*)(abuf + (BUF) * 4096 + ri * 128 + ((((lp >> 1) ^ (ri & 7))) << 4) + (lp & 1) * 8) = o; }
#pragma unroll
    for (int q = 0; q < 4; ++q) wreg[q] = tile_load(wsrc + (size_t)q * 64 * 1024, 1024, tid);
    CMPS_LDA(0);
#pragma unroll
    for (int q = 0; q < 4; ++q) tile_store(lds + q * 8192, wreg[q], tid);
    CMPS_STA(0);
    CMPS_LDA(1);
    __syncthreads();
    int cur = 0;
#pragma unroll 1
    for (int j = 0; j < 16; ++j) {
        const bool more = j < 15;
        if (more) {
#pragma unroll
            for (int q = 0; q < 4; ++q) wreg[q] = tile_load(wsrc + (size_t)q * 64 * 1024 + (j + 1) * 64, 1024, tid);
        }
        const PG8_LAS unsigned char* wb = lds + cur * 32768; const PG8_LAS unsigned char* ab = abuf + cur * 4096;
#pragma unroll
        for (int ks = 0; ks < 4; ++ks) {
            const bf16x8 af = frag(ab, l32, 2 * ks + h, xr);
            bf16x8 wf[8];
#pragma unroll
            for (int ct = 0; ct < 8; ++ct) wf[ct] = frag(wb, ct * 32 + l32, 2 * ks + h, xr);
#pragma unroll
            for (int ct = 0; ct < 8; ++ct) acc[ct] = MFMA32(wf[ct], af, acc[ct]);
        }
        if (more) {
#pragma unroll
            for (int q = 0; q < 4; ++q) tile_store(lds + (cur ^ 1) * 32768 + q * 8192, wreg[q], tid);
            CMPS_STA(cur ^ 1);
            if (j + 2 < 16) { CMPS_LDA(j + 2); }
        }
        asm volatile("s_waitcnt lgkmcnt(0)" ::: "memory"); __builtin_amdgcn_s_barrier(); asm volatile("" ::: "memory");
        cur ^= 1;
    }
#undef CMPS_LDA
#undef CMPS_STA
    act_t* orow = p.ccs + ((size_t)tensor * CROWS_S + r0 + l32) * 256 + 4 * h;
#pragma unroll
    for (int ct = 0; ct < 8; ++ct)
#pragma unroll
        for (int q = 0; q < 4; ++q) { u32x2 w; w[0] = pkbf(acc[ct][4 * q], acc[ct][4 * q + 1]); w[1] = pkbf(acc[ct][4 * q + 2], acc[ct][4 * q + 3]); *(u32x2*)(orow + ct * 32 + 8 * q) = w; }
}
DEV void phase(const P& p, PG8_LAS unsigned char* lds, unsigned* counter) {
    for (;;) {
        if (threadIdx.x == 0) *(PG8_LAS unsigned*)(lds + L_Q) = atomicAdd(counter, 1u);
        __syncthreads();
        const int u = (int)*(const volatile PG8_LAS unsigned*)(lds + L_Q);
        __syncthreads();
        if (u >= NUNIT) break;
        unit(p, lds, u);
    }
}
}


namespace cmpp {
using att::bf16x8; using att::f32x16; using att::tile_load; using att::tile_store; using att::frag;
typedef unsigned u32x4 __attribute__((ext_vector_type(4)));
typedef unsigned u32x2 __attribute__((ext_vector_type(2)));
constexpr int NUNIT = 2 * (CROWS_P / 256) * 4;
static_assert(NCH_P % 32 == 0 && CROWS_P % 256 == 0 && 16 * NCH_P <= SEQ, "prompt compression shapes");
DEV void unit(const P& p, PG8_LAS unsigned char* lds, int u) {
    const int tid = fresh_tid(), lane = tid & 63, l32 = lane & 31, h = lane >> 5, wid = __builtin_amdgcn_readfirstlane(tid >> 6), xr = l32 & 7;
    const int nq = u & 3, rb = (u >> 2) % (CROWS_P / 256), tensor = u / (4 * (CROWS_P / 256)), r0 = rb * 256 + wid * 32;
    const int bh = r0 / NCH_P, cidx0 = r0 % NCH_P, b = bh >> 1, kvh = bh & 1;
    const int lr = lane >> 3, lc = lane & 7;
    const act_t* abase = p.kvb + ((size_t)b * SEQ + 16 * (cidx0 + lr)) * 512 + tensor * 128 + kvh * 64 + lc * 8;
    const act_t* wsrc = p.btc + ((size_t)tensor * 256 + nq * 64) * 1024;
    PG8_LAS unsigned char* abuf = lds + 16384 + wid * 8192;
    f32x16 acc[2];
#pragma unroll
    for (int ct = 0; ct < 2; ++ct)
#pragma unroll
        for (int i = 0; i < 16; ++i) acc[ct][i] = 0.f;
    u32x4 xa[4], wreg;
#define CMPP_LDA(J) _Pragma("unroll") for (int q = 0; q < 4; ++q) xa[q] = *(const u32x4*)(abase + (size_t)(128 * q + (J)) * 512)
#define CMPP_STA(BUF) _Pragma("unroll") for (int q = 0; q < 4; ++q) { const int ri = 8 * q + lr; *(PG8_LAS u32x4*)(abuf + (BUF) * 4096 + ri * 128 + ((lc ^ (ri & 7)) << 4)) = xa[q]; }
    wreg = tile_load(wsrc, 1024, tid);
    CMPP_LDA(0);
    __syncthreads();
    tile_store(lds, wreg, tid);
    CMPP_STA(0);
    CMPP_LDA(1);
    __syncthreads();
    int cur = 0;
#pragma unroll 1
    for (int j = 0; j < 16; ++j) {
        const bool more = j < 15;
        if (more) { wreg = tile_load(wsrc + (j + 1) * 64, 1024, tid); }
        const PG8_LAS unsigned char* wb = lds + cur * 8192; const PG8_LAS unsigned char* ab = abuf + cur * 4096;
#pragma unroll
        for (int ks = 0; ks < 4; ++ks) { const bf16x8 af = frag(ab, l32, 2 * ks + h, xr);
#pragma unroll
            for (int ct = 0; ct < 2; ++ct) acc[ct] = MFMA32(frag(wb, ct * 32 + l32, 2 * ks + h, xr), af, acc[ct]); }
        if (more) { tile_store(lds + (cur ^ 1) * 8192, wreg, tid); CMPP_STA(cur ^ 1); if (j + 2 < 16) { CMPP_LDA(j + 2); } }
        asm volatile("s_waitcnt lgkmcnt(0)" ::: "memory"); __builtin_amdgcn_s_barrier(); asm volatile("" ::: "memory");
        cur ^= 1;
    }
#undef CMPP_LDA
#undef CMPP_STA
    act_t* orow = p.ccp + ((size_t)tensor * CROWS_P + r0 + l32) * 256 + nq * 64 + 4 * h;
#pragma unroll
    for (int ct = 0; ct < 2; ++ct)
#pragma unroll
        for (int q = 0; q < 4; ++q) { u32x2 w; w[0] = pkbf(acc[ct][4 * q], acc[ct][4 * q + 1]); w[1] = pkbf(acc[ct][4 * q + 2], acc[ct][4 * q + 3]); *(u32x2*)(orow + ct * 32 + 8 * q) = w; }
}
}

struct MP { P p; unsigned* bar; };
#define PH(F, total) do { const int _tid = fresh_tid(); const long _t = (total); for (long gid = (long)blockIdx.x * NTHR + _tid; gid < _t; gid += (long)gridDim.x * NTHR) F(p, gid); } while (0)
#define COOP(fn) do { const int _tid = fresh_tid(); fn(p, (int)blockIdx.x * (NTHR / 64) + (_tid >> 6), (int)gridDim.x * (NTHR / 64), _tid & 63); } while (0)
#define BAR() xcd_barrier(xb)
__global__ void __launch_bounds__(NTHR, 2) k_mega(MP mp) {
    extern __shared__ __attribute__((aligned(16))) unsigned char shm[];
    PG8_LAS unsigned char* lds = (PG8_LAS unsigned char*)shm;
    const P& p = mp.p;
    if (threadIdx.x < 4) ((PG8_LAS unsigned*)(lds + LDS_BAR_OFF))[threadIdx.x] = 0u;
    __syncthreads();
    XcdBarrier xb = xcd_barrier_post(mp.bar, (volatile LAS unsigned*)(lds + LDS_BAR_OFF));
    PG8_LAS float* tl = (PG8_LAS float*)lds;
#ifndef DUP_MASK
#define DUP_MASK 0
#endif
#define REP(bit) for (int _rep = 0; _rep < 1 + 4 * ((DUP_MASK >> (bit)) & 1); ++_rep)
    REP(0) {
    COOP(coop::rmsnorm_in);
    __syncthreads();
    coop::weight_t<3>(tl, p.w_in, D, PROJ, p.bt_in, 0, fresh_tid()); PH(b_wt_inpad, (long)(PROJP - PROJ) * D);
    coop::weight_t(tl, p.w_out, 1024, D, p.bt_out, 0, fresh_tid());
    coop::weight_t<1>(tl, p.w_gate, D, DFF, p.bt_gu, 0, fresh_tid()); coop::weight_t<2>(tl, p.w_up, D, DFF, p.bt_gu, 0, fresh_tid());
    coop::weight_t(tl, p.w_down, DFF, D, p.bt_down, 0, fresh_tid());
    for (int ts = 0; ts < 2; ++ts) {
        coop::weight_t(tl, p.cmp_w1 + (size_t)ts * 2048 * 128, 1024, 128, p.btc + (size_t)ts * 256 * 1024, 0, fresh_tid());
        coop::weight_t(tl, p.cmp_w1 + (size_t)ts * 2048 * 128 + 1024 * 128, 1024, 128, p.btc + (size_t)ts * 256 * 1024, 128, fresh_tid());
    }
    COOP(coop::cmp_const_w); PH(b_w2t, 2 * 64 * 128);
    __syncthreads();
    }
    BAR();
    REP(2) {
    run_gemm_proj(lds, p);
    }
    cmps::phase(p, lds, mp.bar + CMPS_CNT_WORD);
    BAR();
    REP(4) {
    COOP(coop::gates1);
    PH(g_out_winp, (long)BATCH * WBP * 64); PH(g_out_wins, (long)DB * WBS * 64);
    COOP(coop::conv_rows);
    __syncthreads(); coop::prep_prompt(p, tl, fresh_tid()); __syncthreads();
    }
    REP(5) { const int t_ = fresh_tid(); __syncthreads(); coop::cmp_combine_s(p, (int)blockIdx.x * (NTHR / 64) + (t_ >> 6), (int)gridDim.x * (NTHR / 64), t_ & 63, lds + (t_ >> 6) * 8192); __syncthreads(); }
    BAR();
    REP(16) { COOP(coop::gates2); }
    REP(9) {
    for (int u = (int)gridDim.x - 1 - (int)blockIdx.x; u < DB * 2 * atts::NPART; u += gridDim.x) atts::unit(p, lds, (u / atts::NPART) >> 1, (u / atts::NPART) & 1, u % atts::NPART);
    }
    REP(17) { for (int u = (int)blockIdx.x - 64; u >= 0 && u < cmpp::NUNIT; u += (int)gridDim.x) cmpp::unit(p, lds, u); }
    BAR();
    REP(18) { const int t_ = fresh_tid(); __syncthreads(); coop::cmp_combine_p(p, (int)blockIdx.x * (NTHR / 64) + (t_ >> 6), (int)gridDim.x * (NTHR / 64), t_ & 63, lds + (t_ >> 6) * 8192); __syncthreads(); }
    REP(19) { const int t_ = fresh_tid(); const int g_ = ((int)blockIdx.x - ((int)gridDim.x - 8)) * (NTHR / 64) + (t_ >> 6); if (g_ >= 0) atts::finish(p, g_, 8 * (NTHR / 64), t_ & 63); }
    REP(6) {
    mls::phase_a(p, lds);
    }
    BAR();
    REP(7) { PH(b_scan3, (long)NSEQ * 16384); }
    BAR();
    REP(8) {
    mls::phase_b(p, lds);
    }
    REP(10) {
        constexpr int NT = SEQ / 64, NU = BATCH * 2 * NT;
        int tab_kvh = -1;
        for (int u = blockIdx.x; u < NU; u += gridDim.x) {
            const int k = u / (int)gridDim.x, per = (int)gridDim.x, lin = u % per;
            constexpr int NC8 = BATCH * 2;
            const int slot = lin / NC8, nslot = per / NC8;
            const int idx = k * per + ((k & 1) ? (nslot - 1 - slot) : slot) * NC8 + lin % NC8;
            if (idx < NU) { att::unit(p, lds, (idx % NC8) >> 1, idx & 1, idx / NC8, (idx & 1) != tab_kvh); tab_kvh = idx & 1; }
        }
    }
    BAR();
    constexpr int NSW = 4;
    const bool sw = (int)blockIdx.x < NSW; const int wgw = ((int)blockIdx.x - NSW) * (NTHR / 64), wnw = ((int)gridDim.x - NSW) * (NTHR / 64);
    REP(11) { run_gemm_b16(lds, p.mixb, p.bt_out, TOKP, D, 1024, p.mixh, D); }
    BAR();
    REP(12) {
        if (sw) run_gemm_b16(lds, p.mixb + (size_t)TOKP * 1024, p.bt_out, TOKS, D, 1024, p.mixh + (size_t)TOKP * D, D);
        else { const int t_ = fresh_tid(); coop::post1(p, 0, TOKP, wgw + (t_ >> 6), wnw, t_ & 63); }
    }
    BAR();
    REP(13) {
        { const int t_ = fresh_tid(); coop::post1(p, TOKP, TOK, (int)blockIdx.x * (NTHR / 64) + (t_ >> 6), (int)gridDim.x * (NTHR / 64), t_ & 63); }
        run_gemm_swiglu(lds, p.h2b, p.bt_gu, TOKP, 2 * DFF, D, p.actb, DFF);
    }
    BAR();
    REP(14) {
        run_gemm_swiglu(lds, p.h2b + (size_t)TOKP * D, p.bt_gu, TOKS, 2 * DFF, D, p.actb + (size_t)TOKP * DFF, DFF);
        run_gemm_b16(lds, p.actb, p.bt_down, TOKP, D, DFF, p.fh, D);
    }
    BAR();
    REP(15) {
        static_assert((DFF / 2) % 128 == 0, "K-half of the down projection");
        if ((int)blockIdx.x < NSW) run_gemm_b16(lds, p.actb + (size_t)TOKP * DFF, p.bt_down, TOKS, D, DFF / 2, p.fh + (size_t)TOKP * D, D, 0, DFF);
        else if ((int)blockIdx.x < 2 * NSW) run_gemm_b16(lds, p.actb + (size_t)TOKP * DFF + DFF / 2, p.bt_down + DFF / 2, TOKS, D, DFF / 2, p.fh2, D, NSW, DFF);
        else { const int t_ = fresh_tid(); coop::post2<false>(p, 0, TOKP, ((int)blockIdx.x - 2 * NSW) * (NTHR / 64) + (t_ >> 6), ((int)gridDim.x - 2 * NSW) * (NTHR / 64), t_ & 63); }
    }
    BAR();
    { const int t_ = fresh_tid(); coop::post2<true>(p, TOKP, TOK, (int)blockIdx.x * (NTHR / 64) + (t_ >> 6), (int)gridDim.x * (NTHR / 64), t_ & 63); }
}
#else
#define RUN(F, total) do { long _t = (total); _Pragma("omp parallel for schedule(dynamic, 64)") for (long g = 0; g < _t; ++g) F(p, g); } while (0)
static void cpu_gemm(const float* A, const float* B, const float* bias, float* C, int M, int N, int K) {
#pragma omp parallel for
    for (int m = 0; m < M; ++m) {
        for (int n = 0; n < N; ++n) C[(size_t)m * N + n] = bias ? bias[n] : 0.f;
        for (int k = 0; k < K; ++k) { const float a = A[(size_t)m * K + k]; for (int n = 0; n < N; ++n) C[(size_t)m * N + n] += a * B[(size_t)k * N + n]; }
    }
}
#define GEMM(A, B, bias, C, M, N, K) cpu_gemm(A, B, bias, C, M, N, K)
#endif
}

extern "C" void kernel_launch(void* const* d_in, const int* in_sizes, int n_in, void* d_out, int out_size, void* d_ws, size_t ws_size, hipStream_t stream) {
    P p{};
    p.x_prompt = (const float*)d_in[0]; p.x_sample = (const float*)d_in[1]; p.cache_kv = (const float*)d_in[2]; p.cache_win = (const float*)d_in[3];
    p.state_conv = (const float*)d_in[4]; p.state_C = (const float*)d_in[5]; p.state_n = (const float*)d_in[6]; p.state_m = (const float*)d_in[7];
    p.page_table = (const int*)d_in[8]; p.rel_bias = (const float*)d_in[9]; p.g_attn_pre = (const float*)d_in[10]; p.w_in = (const float*)d_in[11];
    p.b_in = (const float*)d_in[12]; p.cmp_pos = (const float*)d_in[13]; p.cmp_w1 = (const float*)d_in[14]; p.cmp_b1 = (const float*)d_in[15];
    p.cmp_w2 = (const float*)d_in[16]; p.cmp_b2 = (const float*)d_in[17]; p.conv_w = (const float*)d_in[18]; p.conv_b = (const float*)d_in[19];
    p.g_mnorm = (const float*)d_in[20]; p.w_out = (const float*)d_in[21]; p.g_attn_post = (const float*)d_in[22]; p.g_ffn_pre = (const float*)d_in[23];
    p.w_gate = (const float*)d_in[24]; p.w_up = (const float*)d_in[25]; p.w_down = (const float*)d_in[26]; p.g_ffn_post = (const float*)d_in[27];
    float* o = (float*)d_out;
    p.o_yp = o; o += (size_t)TOKP * D; p.o_ys = o; o += (size_t)TOKS * D; p.o_kvp = o; o += (size_t)TOKP * 512; p.o_kvs = o; o += (size_t)TOKS * 512;
    p.o_winp = o; o += (size_t)BATCH * WBP * 256; p.o_wins = o; o += (size_t)DB * WBS * 256; p.o_convp = o; o += (size_t)BATCH * 3072; p.o_convs = o; o += (size_t)DB * 3072;
    p.o_Cp = o; o += (size_t)BATCH * 65536; p.o_Cs = o; o += (size_t)DB * 65536; p.o_np = o; o += (size_t)BATCH * 512; p.o_ns = o; o += (size_t)DB * 512;
    p.o_mp = o; o += BATCH * 4; p.o_ms = o; o += DB * 4;
    float* w = (float*)d_ws + 4096;
    auto take = [&](size_t n) { float* r = w; w += (n + 63) / 64 * 64; return r; };
#ifdef CPU_EMU
    p.h = take((size_t)TOK * D); p.proj = take((size_t)TOK * PROJ); p.hid = take((size_t)(CMPROWS_P + CMPROWS_S) * 128); p.kcmp = take((size_t)(CMPROWS_P + CMPROWS_S) * 64);
    p.ml = take((size_t)TOK * 16); p.imp = take((size_t)TOK * 2 * NSB_MAX); p.idx = (int*)take((size_t)TOK * 32);
    p.mixin = take((size_t)TOK * 1024); p.qk = take((size_t)TOK * 1024); p.gm = take((size_t)TOK * 4);
    p.dC = take((size_t)NCHUNK * 65536); p.S = take((size_t)TOK * 256); p.hm_pre = take((size_t)TOK * 512);
    p.h2 = take((size_t)TOK * D); p.gate = take((size_t)TOK * 2 * DFF); p.up = p.gate; p.cprev = nullptr;
#endif
    p.oc = take((size_t)TOK * 512); p.gb = take((size_t)TOK * 4); p.dn = take((size_t)NCHUNK * 512);
    p.mix = take((size_t)TOK * D); p.x1 = take((size_t)TOK * D); p.f = take((size_t)TOK * D);
    auto takeb = [&](size_t n) { return (act_t*)take((n * sizeof(act_t) + 3) / 4); };
    p.hb = takeb((size_t)TOK * D); p.mixb = takeb((size_t)TOK * 1024); p.h2b = takeb((size_t)TOK * D); p.actb = takeb((size_t)TOK * DFF);
    p.qb = takeb((size_t)TOK * 512); p.kcs = takeb((size_t)DB * 2 * NCSPAD * 64); p.vcts = takeb((size_t)DB * 2 * NCSPAD * 64); p.vst = takeb((size_t)TOKP * 128); p.vwt = takeb((size_t)TOKP * 128);
    p.kc = takeb((size_t)BATCH * 2 * NCPAD * 64); p.vct = takeb((size_t)BATCH * 2 * NCPAD * 64);
    p.cmap = take((size_t)NCHUNK * 8); p.mprev = take((size_t)NCHUNK * 4); p.nprev = take((size_t)NCHUNK * 512);
    p.kvb = takeb((size_t)TOK * 512); p.kwb = takeb((size_t)TOK * 256); p.kvwf = take((size_t)TOK * 256); p.gatef = take((size_t)TOK * 32);
    p.mqkb = takeb((size_t)TOK * 1024); p.mvb = takeb((size_t)TOK * 512); p.mif = take((size_t)TOK * 8); p.mob = takeb((size_t)TOK * 512);
    p.mixh = takeb((size_t)TOK * D); p.fh = takeb((size_t)TOK * D); p.fh2 = takeb((size_t)TOKS * D);
    p.w2t = takeb((size_t)2 * 64 * 128);
    p.cas = takeb((size_t)2 * CROWS_S * 1024); p.cap = takeb((size_t)2 * CROWS_P * 1024); p.btc = takeb((size_t)2 * 256 * 1024);
    p.ccs = takeb((size_t)2 * CROWS_S * 256); p.ccp = takeb((size_t)2 * CROWS_P * 256); p.cmpc = take(256);
    p.qkb = takeb((size_t)TOK * 1024); p.dct = takeb((size_t)NCHUNK * 65536); p.cpt = takeb((size_t)NCHUNK * 65536);
    p.spart = take((size_t)DB * 2 * 4 * 2 * 64 * 34);
    p.bt_in = takeb((size_t)PROJP * D); p.bt_out = takeb((size_t)D * 1024); p.bt_gu = takeb((size_t)2 * DFF * D); p.bt_down = takeb((size_t)D * DFF);

#ifdef CPU_EMU
    p.cprev = p.dC; p.nprev = p.dn;
    RUN(b_rmsnorm_in, TOK);
    GEMM(p.hb, p.w_in, p.b_in, p.proj, TOK, PROJ, D);
    RUN(b_out_kv, (long)TOK * 512); RUN(b_out_winp, (long)BATCH * WBP * 256); RUN(b_out_wins, (long)DB * WBS * 256); RUN(b_out_conv, (long)NSEQ * 3072);
    RUN(b_cmp_hid, (CMPROWS_P + CMPROWS_S) * 128); RUN(b_cmp_out, (CMPROWS_P + CMPROWS_S) * 64);
    RUN(b_cmp_attn, (long)8 * TOK); RUN(b_imp, (long)TOK * 2 * NSB_MAX); RUN(b_topk, (long)TOK * 2); RUN(b_sel_win, (long)8 * TOK);
    RUN(b_conv, (long)TOK * 1024); RUN(b_gates, (long)NSEQ * 4); RUN(b_dC, (long)NCHUNK * 65536); RUN(b_scan, (long)NSEQ * 65536);
    RUN(b_S, (long)TOK * 256); RUN(b_hout, (long)TOK * 512); RUN(b_hnorm, (long)TOK * 4);
    GEMM(p.mixb, p.w_out, (const float*)nullptr, p.mix, TOK, D, 1024);
    RUN(b_post1, TOK);
    { float* g2 = p.gate;
      std::vector<float> tg((size_t)TOK * DFF), tu((size_t)TOK * DFF);
      GEMM(p.h2b, p.w_gate, (const float*)nullptr, tg.data(), TOK, DFF, D); GEMM(p.h2b, p.w_up, (const float*)nullptr, tu.data(), TOK, DFF, D);
      for (long r = 0; r < TOK; ++r) for (int c = 0; c < DFF; ++c) { g2[r * 2 * DFF + c] = tg[r * DFF + c]; g2[r * 2 * DFF + DFF + c] = tu[r * DFF + c]; } }
    RUN(b_swiglu, (long)TOK * DFF);
    GEMM(p.actb, p.w_down, (const float*)nullptr, p.f, TOK, D, DFF);
    RUN(b_post2, TOK);
#else
    static int grid = 0;
    if (grid == 0) {
        int dev = 0, cus = 0, per_cu = 0;
        if (hipGetDevice(&dev) != hipSuccess || hipDeviceGetAttribute(&cus, hipDeviceAttributeMultiprocessorCount, dev) != hipSuccess) { grid = -1; return; }
        if (hipFuncSetAttribute((const void*)k_mega, hipFuncAttributeMaxDynamicSharedMemorySize, LDS_BYTES) != hipSuccess) { grid = -1; return; }
        if (hipOccupancyMaxActiveBlocksPerMultiprocessor(&per_cu, (const void*)k_mega, NTHR, LDS_BYTES) != hipSuccess || per_cu < 1) (void)hipGetLastError();
        grid = cus;
    }
    if (grid < 0) return;
    (void)hipMemsetAsync(d_ws, 0, WS_ZERO_BYTES, stream);
    MP mp{}; mp.p = p; mp.bar = (unsigned*)d_ws;
    hipLaunchKernelGGL(k_mega, dim3(grid), dim3(NTHR), LDS_BYTES, stream, mp);
#endif
}
```
